# Optimizing an MI355X kernel written in HIP

```python
import math
import jax, jax.numpy as jnp
from jax import lax
import numpy as np

D_MODEL = 1024
BATCH = 4
SEQ = 4096
DEPTH = 2

GRID_W = 64
CTX_LEN = 256
N_EVEN = (DEPTH + 1) // 2
N_ODD = DEPTH // 2
N_MOD = 6

N_Q_HEADS = 8
N_KV_HEADS = 2
Q_PER_KV = N_Q_HEADS // N_KV_HEADS
HEAD_DIM = 64
ATTN_WIDTH = N_Q_HEADS * HEAD_DIM
KV_WIDTH = N_KV_HEADS * HEAD_DIM
FOURIER_GROUPS = 8
FOURIER_GROUP_W = 64
FOURIER_WIDTH = FOURIER_GROUPS * FOURIER_GROUP_W
KV_START = FOURIER_WIDTH + ATTN_WIDTH
MIX_IN_WIDTH = KV_START + 2 * KV_WIDTH
MIX_OUT_WIDTH = FOURIER_WIDTH + ATTN_WIDTH
WINDOW = 128
BLOCK = 128
ATTN_SCALE = HEAD_DIM ** -0.5
ROPE_BASE = 10000.0
NEG_INF = -1e30

SSM_GROUP_W = 16
SSM_GROUPS = D_MODEL // SSM_GROUP_W
SSM_STATE = 64
DT_MIN = 0.001
DT_MAX = 0.1

FFN_MULT = 256
FFN_HIDDEN = -(-8 * D_MODEL // (3 * FFN_MULT)) * FFN_MULT
RMS_EPS = 1e-6

kernel_name = 'hybrid_fourier_swa_s5_dit_trunk'


def rms_norm(x, g):
    x32 = x.astype(jnp.float32)
    y = x32 * lax.rsqrt(jnp.mean(x32 * x32, axis=-1, keepdims=True) + RMS_EPS)
    return (y * g.astype(jnp.float32)).astype(x.dtype)


def adaln(cond, w, b):
    return jnp.split(jax.nn.silu(cond) @ w + b, N_MOD, axis=-1)


def swiglu(h, w_gate, w_up, w_down):
    return (jax.nn.silu(h @ w_gate) * (h @ w_up)) @ w_down


def axial_rope(rows):
    t_row = jnp.repeat(jnp.arange(rows, dtype=jnp.float32), GRID_W)
    t_col = jnp.tile(jnp.arange(GRID_W, dtype=jnp.float32), rows)
    n_freq = HEAD_DIM // 4
    inv_freq = ROPE_BASE ** (-jnp.arange(n_freq, dtype=jnp.float32) / n_freq)
    ang = jnp.concatenate([t_row[:, None] * inv_freq, t_col[:, None] * inv_freq], axis=-1)
    return jnp.cos(ang), jnp.sin(ang)


def apply_rope(x, cos, sin):
    x32 = x.astype(jnp.float32)
    x1, x2 = x32[..., 0::2], x32[..., 1::2]
    cs, sn = cos[None, :, None, :], sin[None, :, None, :]
    out = jnp.stack([x1 * cs - x2 * sn, x1 * sn + x2 * cs], axis=-1).reshape(x.shape)
    return out.astype(x.dtype)


def fourier_mix(f):
    bn, t, _ = f.shape
    g = f.astype(jnp.float32).reshape(bn, t, FOURIER_GROUPS, FOURIER_GROUP_W)
    y = jnp.fft.fft2(g, axes=(1, 3), norm='ortho').real
    return y.reshape(bn, t, FOURIER_WIDTH).astype(f.dtype)


def sink_column(sink, lead_shape):
    s = sink.astype(jnp.float32).reshape(N_KV_HEADS, Q_PER_KV, 1, 1)
    return jnp.broadcast_to(s, lead_shape + (1,))


def window_attention(q, k, v, kc, vc, sink):
    bn, n_tok = q.shape[:2]
    n_ctx = kc.shape[1]
    nb = n_tok // BLOCK
    qb = q.reshape(bn, nb, BLOCK, N_KV_HEADS, Q_PER_KV, HEAD_DIM)

    def bands(t):
        tp = jnp.pad(t, ((0, 0), (BLOCK, BLOCK), (0, 0), (0, 0)))
        tp = tp.reshape(bn, nb + 2, BLOCK, N_KV_HEADS, HEAD_DIM)
        return jnp.concatenate([tp[:, :-2], tp[:, 1:-1], tp[:, 2:]], axis=2)

    kw, vw = bands(k), bands(v)
    s_win = jnp.einsum('bnqhgd,bnkhd->bnhgqk', qb, kw).astype(jnp.float32) * ATTN_SCALE
    s_ctx = jnp.einsum('bnqhgd,bchd->bnhgqc', qb, kc).astype(jnp.float32) * ATTN_SCALE
    qi = jnp.arange(BLOCK)[:, None]
    kj = jnp.arange(3 * BLOCK)[None, :]
    in_win = jnp.abs(kj - BLOCK - qi) <= WINDOW
    kpos = jnp.arange(nb)[:, None] * BLOCK + kj - BLOCK
    valid = in_win[None] & ((kpos >= 0) & (kpos < n_tok))[:, None, :]
    s_win = jnp.where(valid[None, :, None, None], s_win, NEG_INF)
    logits = jnp.concatenate([sink_column(sink, s_ctx.shape[:-1]), s_ctx, s_win], axis=-1)
    p = jax.nn.softmax(logits, axis=-1)
    p_ctx = p[..., 1:1 + n_ctx].astype(v.dtype)
    p_win = p[..., 1 + n_ctx:].astype(v.dtype)
    o = (jnp.einsum('bnhgqc,bchd->bnqhgd', p_ctx, vc)
         + jnp.einsum('bnhgqk,bnkhd->bnqhgd', p_win, vw))
    return o.reshape(bn, n_tok, ATTN_WIDTH)


def context_attention(qc, kc, vc, sink):
    bn, n_ctx = qc.shape[:2]
    q = qc.reshape(bn, n_ctx, N_KV_HEADS, Q_PER_KV, HEAD_DIM)
    s = jnp.einsum('bqhgd,bkhd->bhgqk', q, kc).astype(jnp.float32) * ATTN_SCALE
    p = jax.nn.softmax(jnp.concatenate([sink_column(sink, s.shape[:-1]), s], axis=-1), axis=-1)
    o = jnp.einsum('bhgqk,bkhd->bqhgd', p[..., 1:].astype(vc.dtype), vc)
    return o.reshape(bn, n_ctx, ATTN_WIDTH)


def fourier_attention_mix(h_lat, h_ctx, w_in, w_out, sink, cos, sin, with_ctx_out):
    bn, n_tok, _ = h_lat.shape
    n_ctx = h_ctx.shape[1]
    p = h_lat @ w_in
    f = p[..., :FOURIER_WIDTH]
    q = p[..., FOURIER_WIDTH:KV_START].reshape(bn, n_tok, N_Q_HEADS, HEAD_DIM)
    k = p[..., KV_START:KV_START + KV_WIDTH].reshape(bn, n_tok, N_KV_HEADS, HEAD_DIM)
    v = p[..., KV_START + KV_WIDTH:].reshape(bn, n_tok, N_KV_HEADS, HEAD_DIM)
    kvc = h_ctx @ w_in[:, KV_START:]
    kc = kvc[..., :KV_WIDTH].reshape(bn, n_ctx, N_KV_HEADS, HEAD_DIM)
    vc = kvc[..., KV_WIDTH:].reshape(bn, n_ctx, N_KV_HEADS, HEAD_DIM)
    q, k = apply_rope(q, cos, sin), apply_rope(k, cos, sin)
    o_lat = jnp.concatenate([fourier_mix(f), window_attention(q, k, v, kc, vc, sink)], axis=-1) @ w_out
    o_ctx = None
    if with_ctx_out:
        pc = h_ctx @ w_in[:, :KV_START]
        qc = pc[..., FOURIER_WIDTH:].reshape(bn, n_ctx, N_Q_HEADS, HEAD_DIM)
        o_ctx = jnp.concatenate([fourier_mix(pc[..., :FOURIER_WIDTH]),
                                 context_attention(qc, kc, vc, sink)], axis=-1) @ w_out
    return o_lat, o_ctx


def s5_discretize(a_re, a_im, log_dt, b_re, b_im):
    a_re, a_im = a_re.astype(jnp.float32), a_im.astype(jnp.float32)
    b_re, b_im = b_re.astype(jnp.float32), b_im.astype(jnp.float32)
    dt = jnp.exp(log_dt.astype(jnp.float32))[:, None]
    mag = jnp.exp(a_re * dt)
    abar_re, abar_im = mag * jnp.cos(a_im * dt), mag * jnp.sin(a_im * dt)
    nr, ni = abar_re - 1.0, abar_im
    den = a_re * a_re + a_im * a_im
    f_re = (nr * a_re + ni * a_im) / den
    f_im = (ni * a_re - nr * a_im) / den
    bbar_re = f_re[..., None] * b_re - f_im[..., None] * b_im
    bbar_im = f_re[..., None] * b_im + f_im[..., None] * b_re
    return abar_re, abar_im, bbar_re, bbar_im


def complex_scan(abar_re, abar_im, bu_re, bu_im, h0):
    if h0 is not None:
        h0_re, h0_im = h0
        bu_re = bu_re.at[0].add(abar_re * h0_re - abar_im * h0_im)
        bu_im = bu_im.at[0].add(abar_re * h0_im + abar_im * h0_re)
    n_t = bu_re.shape[0]
    a_re = jnp.broadcast_to(abar_re, (n_t, 1) + abar_re.shape)
    a_im = jnp.broadcast_to(abar_im, (n_t, 1) + abar_im.shape)

    def combine(e1, e2):
        ar1, ai1, br1, bi1 = e1
        ar2, ai2, br2, bi2 = e2
        return (ar1 * ar2 - ai1 * ai2, ar1 * ai2 + ai1 * ar2,
                ar2 * br1 - ai2 * bi1 + br2, ar2 * bi1 + ai2 * br1 + bi2)

    _, _, h_re, h_im = lax.associative_scan(combine, (a_re, a_im, bu_re, bu_im), axis=0)
    return h_re, h_im


def s5_drive(bbar_re, bbar_im, u):
    return (jnp.einsum('gph,tbgh->tbgp', bbar_re, u), jnp.einsum('gph,tbgh->tbgp', bbar_im, u))


def s5_readout(c_re, c_im, h_re, h_im):
    return jnp.einsum('ghp,tbgp->tbgh', c_re, h_re) - jnp.einsum('ghp,tbgp->tbgh', c_im, h_im)


def s5_glu(y, like, glu_w):
    n_t, bn = y.shape[:2]
    y = y.reshape(n_t, bn, D_MODEL).transpose(1, 0, 2).astype(like.dtype)
    a, g = jnp.split(jax.nn.gelu(y) @ glu_w, 2, axis=-1)
    return a * jax.nn.sigmoid(g)


def s5_mix(h_lat, h_ctx, a_re, a_im, log_dt, b_re, b_im, c_re, c_im, d_skip, glu_w, with_ctx_out):
    bn = h_lat.shape[0]

    def time_major(t):
        return t.astype(jnp.float32).transpose(1, 0, 2).reshape(t.shape[1], bn, SSM_GROUPS, SSM_GROUP_W)

    u_lat, u_ctx = time_major(h_lat), time_major(h_ctx)
    d_g = d_skip.astype(jnp.float32).reshape(SSM_GROUPS, SSM_GROUP_W)
    y_lat = d_g * u_lat
    y_ctx = d_g * u_ctx if with_ctx_out else None
    for direction in range(2):
        abar_re, abar_im, bbar_re, bbar_im = s5_discretize(
            a_re[direction], a_im[direction], log_dt[direction], b_re[direction], b_im[direction])
        cr, ci = c_re[direction].astype(jnp.float32), c_im[direction].astype(jnp.float32)
        seq_ctx = u_ctx if direction == 0 else u_ctx[::-1]
        seq_lat = u_lat if direction == 0 else u_lat[::-1]
        hc_re, hc_im = complex_scan(abar_re, abar_im, *s5_drive(bbar_re, bbar_im, seq_ctx), None)
        hl_re, hl_im = complex_scan(abar_re, abar_im, *s5_drive(bbar_re, bbar_im, seq_lat),
                                    (hc_re[-1], hc_im[-1]))
        yl = s5_readout(cr, ci, hl_re, hl_im)
        y_lat = y_lat + (yl if direction == 0 else yl[::-1])
        if with_ctx_out:
            yc = s5_readout(cr, ci, hc_re, hc_im)
            y_ctx = y_ctx + (yc if direction == 0 else yc[::-1])
    o_lat = s5_glu(y_lat, h_lat, glu_w)
    o_ctx = s5_glu(y_ctx, h_ctx, glu_w) if with_ctx_out else None
    return o_lat, o_ctx


def setup_inputs(seed: int = 0) -> dict:
    key = jax.random.key(seed)
    ks = jax.random.split(key, 23)
    f32 = jnp.float32
    D, F, G, P, H = D_MODEL, FFN_HIDDEN, SSM_GROUPS, SSM_STATE, SSM_GROUP_W

    def nrm(k, shape, std):
        return std * jax.random.normal(k, shape, f32)

    return {
        'x': nrm(ks[0], (BATCH, SEQ, D), 1.0),
        'c': nrm(ks[1], (BATCH, D), 1.0),
        'ctx': nrm(ks[2], (BATCH, CTX_LEN, D), 1.0),
        'c_ctx': nrm(ks[3], (D,), 1.0),
        'mod_w': nrm(ks[4], (DEPTH, D, N_MOD * D), 0.5 * D ** -0.5),
        'mod_b': nrm(ks[5], (DEPTH, N_MOD * D), 0.02),
        'norm_g': 1.0 + nrm(ks[6], (DEPTH, 2, D), 0.02),
        'ffn_w_gate': nrm(ks[7], (DEPTH, D, F), D ** -0.5),
        'ffn_w_up': nrm(ks[8], (DEPTH, D, F), D ** -0.5),
        'ffn_w_down': nrm(ks[9], (DEPTH, F, D), F ** -0.5),
        'mix_w_in': nrm(ks[10], (N_EVEN, D, MIX_IN_WIDTH), D ** -0.5),
        'mix_w_out': nrm(ks[11], (N_EVEN, MIX_OUT_WIDTH, D), MIX_OUT_WIDTH ** -0.5),
        'attn_sink': nrm(ks[12], (N_EVEN, N_Q_HEADS), 0.5),
        'ssm_a_re': -0.5 + nrm(ks[13], (N_ODD, 2, G, P), 0.01),
        'ssm_a_im': jnp.pi * jnp.arange(P, dtype=f32) + nrm(ks[14], (N_ODD, 2, G, P), 0.01),
        'ssm_log_dt': jax.random.uniform(ks[15], (N_ODD, 2, G), f32, math.log(DT_MIN), math.log(DT_MAX)),
        'ssm_b_re': nrm(ks[16], (N_ODD, 2, G, P, H), (2 * H) ** -0.5),
        'ssm_b_im': nrm(ks[17], (N_ODD, 2, G, P, H), (2 * H) ** -0.5),
        'ssm_c_re': nrm(ks[18], (N_ODD, 2, G, H, P), 0.5),
        'ssm_c_im': nrm(ks[19], (N_ODD, 2, G, H, P), 0.5),
        'ssm_d': nrm(ks[20], (N_ODD, D), 1.0),
        'ssm_glu_w': nrm(ks[21], (N_ODD, D, 2 * D), D ** -0.5),
        'final_g': 1.0 + nrm(ks[22], (D,), 0.02),
    }


def reference(x, c, ctx, c_ctx, mod_w, mod_b, norm_g, ffn_w_gate, ffn_w_up, ffn_w_down,
              mix_w_in, mix_w_out, attn_sink, ssm_a_re, ssm_a_im, ssm_log_dt, ssm_b_re, ssm_b_im,
              ssm_c_re, ssm_c_im, ssm_d, ssm_glu_w, final_g):
    rows = x.shape[1] // GRID_W
    cos, sin = axial_rope(rows)
    h, hc = x, ctx
    for layer in range(DEPTH):
        with_ctx_out = layer < DEPTH - 1
        i = layer // 2
        sh1, sc1, g1, sh2, sc2, g2 = [m[:, None, :] for m in adaln(c, mod_w[layer], mod_b[layer])]
        csh1, csc1, cg1, csh2, csc2, cg2 = adaln(c_ctx, mod_w[layer], mod_b[layer])
        n_lat = rms_norm(h, norm_g[layer, 0]) * (1.0 + sc1) + sh1
        n_ctx = rms_norm(hc, norm_g[layer, 0]) * (1.0 + csc1) + csh1
        if layer % 2 == 0:
            o_lat, o_ctx = fourier_attention_mix(n_lat, n_ctx, mix_w_in[i], mix_w_out[i], attn_sink[i],
                                                 cos, sin, with_ctx_out)
        else:
            o_lat, o_ctx = s5_mix(n_lat, n_ctx, ssm_a_re[i], ssm_a_im[i], ssm_log_dt[i], ssm_b_re[i],
                                  ssm_b_im[i], ssm_c_re[i], ssm_c_im[i], ssm_d[i], ssm_glu_w[i],
                                  with_ctx_out)
        h = h + g1 * o_lat
        h = h + g2 * swiglu(rms_norm(h, norm_g[layer, 1]) * (1.0 + sc2) + sh2,
                            ffn_w_gate[layer], ffn_w_up[layer], ffn_w_down[layer])
        if with_ctx_out:
            hc = hc + cg1 * o_ctx
            hc = hc + cg2 * swiglu(rms_norm(hc, norm_g[layer, 1]) * (1.0 + csc2) + csh2,
                                   ffn_w_gate[layer], ffn_w_up[layer], ffn_w_down[layer])
    return rms_norm(h, final_g)
```

```cpp
#include <hip/hip_runtime.h>
#include <hip/hip_cooperative_groups.h>
#include <cstdio>
namespace cg = cooperative_groups;

#define LAS __attribute__((address_space(3)))
typedef unsigned short bf16_t;
typedef short bf16x8 __attribute__((ext_vector_type(8)));
typedef float f32x4 __attribute__((ext_vector_type(4)));
typedef float f32x16 __attribute__((ext_vector_type(16)));
typedef unsigned u32x4 __attribute__((ext_vector_type(4)));
typedef unsigned u32x2 __attribute__((ext_vector_type(2)));

constexpr int NT = 512;
constexpr int DM_ = 1024, SEQ_ = 4096, NB_ = 4, CTXL = 256, FF = 2816;
constexpr int NLAT = NB_ * SEQ_;
constexpr int NCTX = NB_ * CTXL;
constexpr int NTOK = NLAT + NCTX;
constexpr int GROWS = 1088;
constexpr int SROWS = 1280;

constexpr size_t MiB = 1u << 20;
constexpr size_t O_WINA = 0;
constexpr size_t O_WINB = O_WINA + 1280ull * 1024 * 2;
constexpr size_t O_WOUT = O_WINB + 768ull * 1024 * 2;
constexpr size_t O_WGU0 = O_WOUT + 1024ull * 1024 * 2;
constexpr size_t O_WD0 = O_WGU0 + 5632ull * 1024 * 2;
constexpr size_t O_WGU1 = O_WD0 + 1024ull * 2816 * 2;
constexpr size_t O_WD1 = O_WGU1 + 5632ull * 1024 * 2;
constexpr size_t O_GLU = O_WD1 + 1024ull * 2816 * 2;
constexpr size_t O_WST = O_GLU + 2048ull * 1024 * 2;
constexpr size_t O_TT = O_WST + 64ull * 256 * 256 * 2;
constexpr size_t O_MODS = O_TT + 64ull * 256 * 512 * 2;
constexpr size_t O_ROPE = O_MODS + 2ull * 5 * 6144 * 4;
constexpr size_t O_DC = O_ROPE + 2ull * 1024 * 4;
constexpr size_t O_HCTX = O_DC + 256ull * 512 * 2;
constexpr size_t O_VTC = O_HCTX + 1024ull * 1024 * 4;
constexpr size_t O_BAR = O_VTC + 4ull * 128 * 256 * 2;
constexpr size_t O_PCNT = O_BAR + 16384;
constexpr size_t O_D256 = O_PCNT + 64ull * 256;
constexpr size_t O_XSS = O_D256 + 512ull * 512 * 2;
constexpr size_t O_RA = 73 * MiB;
static_assert(O_XSS + 16384ull * 4 * 4 <= O_RA, "R_W overflow");
constexpr size_t O_XN = O_RA;
constexpr size_t O_MIX = O_RA + 34 * MiB;
constexpr size_t O_I2 = O_RA + 68 * MiB;
constexpr size_t O_XNP = O_I2;
constexpr size_t O_ZT = O_RA + 100 * MiB;
constexpr size_t O_ZTC = O_RA + 132 * MiB;
constexpr size_t O_Q = O_RA + 134 * MiB;
constexpr size_t O_K = O_RA + 151 * MiB;
constexpr size_t O_VT = O_K + 17408ull * 128 * 2;
constexpr size_t O_ACT = O_RA + 34 * MiB;
constexpr size_t O_A2 = O_RA;
constexpr size_t O_S = O_RA + 69 * MiB;
constexpr size_t O_GY = O_RA + 149 * MiB;
constexpr size_t O_PART = O_RA + 128 * MiB;
constexpr size_t WS_NEED = O_RA + 181 * MiB;

struct Params {
    const float* x; const float* c; const float* ctx; const float* c_ctx; const float* mod_w; const float* mod_b; const float* norm_g;
    const float* ffn_g; const float* ffn_u; const float* ffn_d; const float* w_in; const float* w_out; const float* sink;
    const float* a_re; const float* a_im; const float* log_dt; const float* b_re; const float* b_im; const float* c_re; const float* c_im;
    const float* ssm_d; const float* glu_w; const float* final_g;
    float* out; unsigned char* ws;
};

__device__ __forceinline__ int otid() { int t = threadIdx.x; asm volatile("" : "+v"(t)); return t; }
__device__ __forceinline__ int obid() { int t = blockIdx.x; asm volatile("" : "+s"(t)); return t; }
__device__ __forceinline__ unsigned cvt_pk_bf16(float lo, float hi) { unsigned r; asm volatile("v_cvt_pk_bf16_f32 %0, %1, %2" : "=v"(r) : "v"(lo), "v"(hi)); return r; }
__device__ __forceinline__ bf16_t f2bf(float f) { unsigned u = __float_as_uint(f); u += 0x7FFFu + ((u >> 16) & 1u); return (bf16_t)(u >> 16); }
__device__ __forceinline__ float sigmoidf_(float v) { return __builtin_amdgcn_rcpf(1.0f + __builtin_amdgcn_exp2f(-1.4426950408889634f * v)); }
__device__ __forceinline__ float siluf_(float v) { return v * sigmoidf_(v); }
__device__ __forceinline__ float gelu_tanh(float v) { const float u = 0.7978845608028654f * (v + 0.044715f * v * v * v); return v * sigmoidf_(2.0f * u); }
__device__ __forceinline__ u32x4 pack8(const f32x4 a, const f32x4 b) { u32x4 w; w.x = cvt_pk_bf16(a[0], a[1]); w.y = cvt_pk_bf16(a[2], a[3]); w.z = cvt_pk_bf16(b[0], b[1]); w.w = cvt_pk_bf16(b[2], b[3]); return w; }

namespace pg8 {
constexpr int BM = 256, BK = 64, HALF = 128, HTB = HALF * BK * 2, STAGE_BYTES = 8 * HTB, NXCD = 8, WGM = 8;
__device__ __forceinline__ int lds_byte(int r, int c) { const int st = (r >> 4) * 2 + (c >> 5), rr = r & 15, cc = c & 31, ob = rr * 64 + cc * 2; return st * 1024 + (ob ^ (((ob >> 9) & 1) << 5)); }
__device__ __forceinline__ void stage_rc(int b, int& R, int& C) { const int st = b / 1024, sb = b % 1024, swz = sb ^ (((sb >> 9) & 1) << 5); R = (st >> 1) * 16 + swz / 64; C = (st & 1) * 32 + (swz % 64) / 2; }
__device__ __forceinline__ int perm32(int rho) { const int n = rho >> 4, i = rho & 15; return 8 * (i >> 2) + 4 * n + (i & 3); }

struct Unit { int arow, brow, pm, pn, kofs; size_t aoff, boff; };
struct Gemm { const bf16_t* A; const bf16_t* Bt; int K, lda, ldb; };

struct Sched {
    int nM, nN, nwg, G, c, mode, lda, ldb, base;
    __device__ void init(int nM_, int nN_, int G_, int c_, int mode_, int lda_, int ldb_) { nM = nM_; nN = nN_; nwg = nM_ * nN_; G = G_; c = c_; mode = mode_; lda = lda_; ldb = ldb_; base = 0; }
    __device__ bool next(int i, Unit& u) const {
        const long L = (long)base + (long)i * G + c; if (L >= nwg) return false;
        if (mode == 4) {
            { const int x = (int)L & 7, o = ((int)L & 255) >> 3; u.pm = ((int)L >> 8) * 32 + x * 4 + (o >> 3); u.pn = o & 7; }
            u.arow = u.pm * BM; u.brow = u.pn * BM; u.kofs = 0;
            u.aoff = (size_t)u.arow * lda; u.boff = (size_t)u.brow * ldb; return true;
        }
        if (mode == 0 || mode == 3) {
            int wgid = (int)L; { const int q = nwg / NXCD, r = nwg % NXCD, xcd = wgid % NXCD, off = wgid / NXCD; wgid = (xcd < r ? xcd * (q + 1) : r * (q + 1) + (xcd - r) * q) + off; }
            const int nig = WGM * nN, gid = wgid / nig, fm = gid * WGM, gsz = (nM - fm) < WGM ? (nM - fm) : WGM;
            u.pm = fm + ((wgid % nig) % gsz); u.pn = (wgid % nig) / gsz; u.arow = u.pm * BM; u.brow = u.pn * BM; u.kofs = 0;
        } else if (mode == 1) {
            const int g = (int)L / nM, mi = (int)L % nM; u.pm = mi; u.pn = g; u.arow = g * GROWS + mi * BM; u.brow = g * BM; u.kofs = 0;
        } else {
            const int tile = (int)L % nM, ks = (int)L / nM; u.pm = tile >> 2; u.pn = tile & 3; u.arow = u.pm * BM; u.brow = u.pn * BM; u.kofs = ks * 256;
        }
        u.aoff = (size_t)u.arow * lda + u.kofs;
        u.boff = (mode == 3) ? (size_t)((u.pn >> 4) * 4096 + (u.pn & 15)) * 1024 : (size_t)u.brow * ldb + u.kofs;
        return true;
    }
};

template <class T, class = void> struct epi_after_drain { static constexpr bool value = false; };
template <class T> struct epi_after_drain<T, decltype((void)T::AFTER_DRAIN)> { static constexpr bool value = T::AFTER_DRAIN; };
#ifndef GP_ALIGN
#define GP_ALIGN true
#endif
#ifndef GP_SP2
#define GP_SP2 true
#endif
template <class Epi, bool ALIGN_EPI = GP_ALIGN, bool SP2 = GP_SP2>
__device__ __forceinline__ void gemm_phase(LAS unsigned char* lds, const Gemm g, const Sched& S, const Epi& E) {
    const int tid = otid(), wid = __builtin_amdgcn_readfirstlane(tid >> 6), lane = tid & 63, wr = wid >> 2, wc = wid & 3, fr = lane & 15, fq = lane >> 4;
    const int K = g.K, nt = K / BK;
    unsigned voffA[2], voffB[2];
#pragma unroll
    for (int i = 0; i < 2; ++i) { int R, C; stage_rc(tid * 16 + i * 8192, R, C); const int Rb = (R & ~31) + perm32(R & 31);
        voffA[i] = (unsigned)(R * g.lda + C) * 2u; voffB[i] = (unsigned)(Rb * g.ldb + C) * 2u; }
    const size_t kstep = (size_t)(BK * 2);
    const size_t hstepA = (size_t)HALF * g.lda * 2, hstepB = (size_t)HALF * g.ldb * 2;
    const unsigned ldsw = (unsigned)wid * 1024u;
    const int aoff = lds_byte(wr * 64 + fr, fq * 8), boff = lds_byte(wc * 32 + fr, fq * 8);
#define PG8_SA(b, h) (((b) * 2 + (h)) * HTB)
#define PG8_SB(b, h) ((4 + (b) * 2 + (h)) * HTB)
#define PG8_STAGE(bufoff, gbase, voff) do { _Pragma("unroll") for (int _i = 0; _i < 2; ++_i) \
        __builtin_amdgcn_global_load_lds((const unsigned*)((const char*)(gbase) + (voff)[_i]), (LAS unsigned*)(lds + (bufoff) + ldsw + _i * 8192), 16, 0, 0); } while (0)
#define PG8_LDA(dst, b, h) do { _Pragma("unroll") for (int m = 0; m < 4; ++m) _Pragma("unroll") for (int k = 0; k < 2; ++k) dst[m][k] = *(const LAS bf16x8*)(lds + PG8_SA(b, h) + aoff + m * 2048 + k * 1024); } while (0)
#define PG8_LDB(dst, b, h) do { _Pragma("unroll") for (int n = 0; n < 2; ++n) _Pragma("unroll") for (int k = 0; k < 2; ++k) dst[n][k] = *(const LAS bf16x8*)(lds + PG8_SB(b, h) + boff + n * 2048 + k * 1024); } while (0)
#define PG8_MMA(ai, bj, At, Bt) do { __builtin_amdgcn_s_setprio(1); _Pragma("unroll") for (int m = 0; m < 4; ++m) _Pragma("unroll") for (int n = 0; n < 2; ++n) _Pragma("unroll") for (int k = 0; k < 2; ++k) \
        acc[ai][bj][m][n] = __builtin_amdgcn_mfma_f32_16x16x32_bf16(Bt[n][k], At[m][k], acc[ai][bj][m][n], 0, 0, 0); __builtin_amdgcn_s_setprio(0); } while (0)
#define PG8_WAIT_V(n) asm volatile("s_waitcnt vmcnt(" #n ")" ::: "memory")
#define PG8_WAIT_L(n) asm volatile("s_waitcnt lgkmcnt(" #n ")" ::: "memory")
#define PG8_BAR __builtin_amdgcn_s_barrier()
#define PG8_SCHED __builtin_amdgcn_sched_barrier(0)
    Unit cur, nxt; int ui = 0;
    if (!S.next(0, cur)) return;
    f32x4 acc[2][2][4][2];
#pragma unroll
    for (int a = 0; a < 2; ++a)
#pragma unroll
        for (int b = 0; b < 2; ++b)
#pragma unroll
            for (int m = 0; m < 4; ++m)
#pragma unroll
                for (int n = 0; n < 2; ++n) acc[a][b][m][n] = (f32x4){0.f, 0.f, 0.f, 0.f};
    bf16x8 At[4][2], B0[2][2], B1[2][2];
    const char* cA = (const char*)g.A + cur.aoff * 2; const char* cB = (const char*)g.Bt + cur.boff * 2;
    if constexpr (SP2) {
        PG8_STAGE(PG8_SB(0, 0), cB, voffB); PG8_STAGE(PG8_SB(0, 1), cB + hstepB, voffB); PG8_STAGE(PG8_SA(0, 0), cA, voffA); PG8_STAGE(PG8_SA(0, 1), cA + hstepA, voffA);
        if (wr == 1) PG8_BAR;
        PG8_WAIT_V(2); PG8_BAR;
        PG8_STAGE(PG8_SB(1, 0), cB + kstep, voffB); PG8_STAGE(PG8_SA(1, 0), cA + kstep, voffA); PG8_STAGE(PG8_SB(1, 1), cB + hstepB + kstep, voffB);
        PG8_WAIT_V(6); PG8_BAR;
    } else {
        PG8_STAGE(PG8_SB(0, 0), cB, voffB); PG8_STAGE(PG8_SA(0, 0), cA, voffA); PG8_STAGE(PG8_SB(0, 1), cB + hstepB, voffB); PG8_STAGE(PG8_SA(0, 1), cA + hstepA, voffA);
        if (wr == 1) PG8_BAR;
        PG8_WAIT_V(4); PG8_BAR;
        PG8_STAGE(PG8_SB(1, 0), cB + kstep, voffB); PG8_STAGE(PG8_SA(1, 0), cA + kstep, voffA); PG8_STAGE(PG8_SB(1, 1), cB + hstepB + kstep, voffB);
        PG8_WAIT_V(6); PG8_BAR;
    }
    for (;;) {
        const bool has_next = S.next(ui + 1, nxt);
        const char* nA = has_next ? (const char*)g.A + nxt.aoff * 2 : cA; const char* nB = has_next ? (const char*)g.Bt + nxt.boff * 2 : cB;
        for (int t = 0; t < nt; t += 2) {
            const bool last = (t == nt - 2);
            const char* a1 = cA + (size_t)(t + 1) * kstep;
            const char* a2 = last ? nA : cA + (size_t)(t + 2) * kstep; const char* b2 = last ? nB : cB + (size_t)(t + 2) * kstep;
            const char* a3 = a2 + kstep; const char* b3 = b2 + kstep;
            if constexpr (SP2) {
            PG8_LDB(B0, 0, 0); PG8_LDB(B1, 0, 1); PG8_SCHED; PG8_LDA(At, 0, 0); PG8_STAGE(PG8_SA(1, 1), a1 + hstepA, voffA);
            PG8_WAIT_V(8); PG8_WAIT_L(0); PG8_BAR; PG8_MMA(0, 0, At, B0); PG8_MMA(0, 1, At, B1); PG8_BAR; PG8_SCHED;
            PG8_LDA(At, 0, 1); PG8_STAGE(PG8_SB(0, 0), b2, voffB); PG8_STAGE(PG8_SB(0, 1), b2 + hstepB, voffB); PG8_STAGE(PG8_SA(0, 0), a2, voffA);
            PG8_WAIT_V(8); PG8_WAIT_L(0); PG8_BAR; PG8_MMA(1, 0, At, B0); PG8_MMA(1, 1, At, B1); PG8_BAR; PG8_SCHED;
            PG8_LDB(B0, 1, 0); PG8_LDB(B1, 1, 1); PG8_SCHED; PG8_LDA(At, 1, 0); PG8_STAGE(PG8_SA(0, 1), a2 + hstepA, voffA);
            PG8_WAIT_V(8); PG8_WAIT_L(0); PG8_BAR; PG8_MMA(0, 0, At, B0); PG8_MMA(0, 1, At, B1); PG8_BAR; PG8_SCHED;
            PG8_LDA(At, 1, 1); PG8_STAGE(PG8_SB(1, 0), b3, voffB); PG8_STAGE(PG8_SB(1, 1), b3 + hstepB, voffB); PG8_STAGE(PG8_SA(1, 0), a3, voffA);
            PG8_WAIT_V(8); PG8_WAIT_L(0); PG8_BAR; PG8_MMA(1, 0, At, B0); PG8_MMA(1, 1, At, B1); PG8_BAR; PG8_SCHED;
            } else {
            PG8_LDB(B0, 0, 0); PG8_SCHED; PG8_LDA(At, 0, 0); PG8_STAGE(PG8_SA(1, 1), a1 + hstepA, voffA);
            PG8_WAIT_L(8); PG8_BAR; PG8_WAIT_L(0); PG8_MMA(0, 0, At, B0); PG8_BAR; PG8_SCHED;
            PG8_LDB(B1, 0, 1); PG8_STAGE(PG8_SB(0, 0), b2, voffB);
            PG8_BAR; PG8_WAIT_L(0); PG8_MMA(0, 1, At, B1); PG8_BAR;
            PG8_LDA(At, 0, 1); PG8_STAGE(PG8_SA(0, 0), a2, voffA);
            PG8_BAR; PG8_WAIT_L(0); PG8_MMA(1, 0, At, B0); PG8_BAR; PG8_SCHED;
            PG8_STAGE(PG8_SB(0, 1), b2 + hstepB, voffB);
            PG8_WAIT_V(6); PG8_BAR; PG8_MMA(1, 1, At, B1); PG8_BAR;
            PG8_LDB(B0, 1, 0); PG8_SCHED; PG8_LDA(At, 1, 0); PG8_STAGE(PG8_SA(0, 1), a2 + hstepA, voffA);
            PG8_WAIT_L(8); PG8_BAR; PG8_WAIT_L(0); PG8_MMA(0, 0, At, B0); PG8_BAR; PG8_SCHED;
            PG8_LDB(B1, 1, 1); PG8_STAGE(PG8_SB(1, 0), b3, voffB);
            PG8_BAR; PG8_WAIT_L(0); PG8_MMA(0, 1, At, B1); PG8_BAR;
            PG8_LDA(At, 1, 1); PG8_STAGE(PG8_SA(1, 0), a3, voffA);
            PG8_BAR; PG8_WAIT_L(0); PG8_MMA(1, 0, At, B0); PG8_BAR; PG8_SCHED;
            PG8_STAGE(PG8_SB(1, 1), b3 + hstepB, voffB);
            PG8_WAIT_V(6); PG8_BAR; PG8_MMA(1, 1, At, B1); PG8_BAR;
                    }
        }
        if constexpr (ALIGN_EPI) { if (wr == 0) PG8_BAR; }
        if constexpr (!epi_after_drain<Epi>::value) E(acc, cur, wr, wc, fr, fq);
        if (!has_next) break;
#pragma unroll
        for (int a = 0; a < 2; ++a)
#pragma unroll
            for (int b = 0; b < 2; ++b)
#pragma unroll
                for (int m = 0; m < 4; ++m)
#pragma unroll
                    for (int n = 0; n < 2; ++n) acc[a][b][m][n] = (f32x4){0.f, 0.f, 0.f, 0.f};
        cur = nxt; cA = nA; cB = nB; ++ui;
        if constexpr (ALIGN_EPI) { if (wr == 1) PG8_BAR; }
    }
    PG8_WAIT_V(0);
    if constexpr (!ALIGN_EPI) { if (wr == 0) PG8_BAR; }
    PG8_BAR;
    if constexpr (epi_after_drain<Epi>::value) E.fused(acc, cur, wr, wc, fr, fq, lds, wid, lane);
#undef PG8_SA
#undef PG8_SB
#undef PG8_STAGE
#undef PG8_LDA
#undef PG8_LDB
#undef PG8_MMA
#undef PG8_WAIT_V
#undef PG8_WAIT_L
#undef PG8_BAR
#undef PG8_SCHED
}
}
using pg8::Unit;
typedef f32x4 Acc[2][2][4][2];

struct EpiInA {
    bf16_t *ZT, *ZTc; int tk0, perm;
    __device__ __forceinline__ void operator()(const Acc& acc, const Unit& u, int wr, int wc, int fr, int fq) const {
#pragma unroll
        for (int ai = 0; ai < 2; ++ai)
#pragma unroll
            for (int m = 0; m < 4; ++m) {
                const int r = u.arow + ai * 128 + wr * 64 + m * 16 + fr;
                const int c = r & 511, cs = r >> 9;
#pragma unroll
                for (int bj = 0; bj < 2; ++bj) {
                    const int tk = tk0 + u.brow + bj * 128 + wc * 32 + fq * 8;
                    bf16_t* dst;
                    if (perm) { const int b = tk >> 12, rr = (tk >> 8) & 15, tp = tk & 255; dst = ZT + ((size_t)((b * 512 + c) * 16 + rr) * 512 + cs * 256 + tp); }
                    else { const int b = (tk - NLAT) >> 8, t = tk & 255; dst = ZTc + ((size_t)(b * 512 + c) * 512 + cs * 256 + t); }
                    *(u32x4*)dst = pack8(acc[ai][bj][m][0], acc[ai][bj][m][1]);
                }
            }
    }
};
struct EpiInB {
    bf16_t *Q, *Kb; const float *ropeC, *ropeS; bf16_t *VT, *VTc;
    __device__ __forceinline__ void operator()(const Acc& acc, const Unit& u, int wr, int wc, int fr, int fq) const {
#pragma unroll
        for (int ai = 0; ai < 2; ++ai)
#pragma unroll
            for (int m = 0; m < 4; ++m) {
                const int tok = u.arow + ai * 128 + wr * 64 + m * 16 + fr;
                const bool lat = tok < NLAT; const int pos = tok & 4095, prow = pos >> 6, pcol = pos & 63;
#pragma unroll
                for (int bj = 0; bj < 2; ++bj) {
                    const int col = u.brow + bj * 128 + wc * 32 + fq * 8;
                    f32x4 v0 = acc[ai][bj][m][0], v1 = acc[ai][bj][m][1];
                    if (col >= 640) {
                        const int dv = col - 640, kvh = dv >> 6, d = dv & 63, dt = d >> 5, rl0 = d & 31;
                        int b, t; if (lat) { b = tok >> 12; t = tok & 4095; } else { b = (tok - NLAT) >> 8; t = tok & 255; }
                        const int tile = t >> 5, s = (t >> 4) & 1, k16 = t & 15, hh = (k16 >> 2) & 1, j = ((k16 >> 3) << 2) | (k16 & 3);
                        bf16_t* vb = (lat ? VT + (size_t)((b * 2 + kvh) * 128 + tile) * 2048 : VTc + (size_t)((b * 2 + kvh) * 8 + tile) * 2048) + (dt * 2 + s) * 512 + (hh * 32 + rl0) * 8 + j;
                        const u32x4 w = pack8(v0, v1);
                        vb[0] = (bf16_t)(w.x & 0xFFFFu); vb[8] = (bf16_t)(w.x >> 16); vb[16] = (bf16_t)(w.y & 0xFFFFu); vb[24] = (bf16_t)(w.y >> 16);
                        vb[32] = (bf16_t)(w.z & 0xFFFFu); vb[40] = (bf16_t)(w.z >> 16); vb[48] = (bf16_t)(w.w & 0xFFFFu); vb[56] = (bf16_t)(w.w >> 16);
                        continue;
                    }
                    if (lat) {
                        const int i0 = (col & 63) >> 1, pp = (i0 < 16) ? prow : pcol, f0 = i0 & 15;
                        const f32x4 cs = *(const f32x4*)(ropeC + pp * 16 + f0), sn = *(const f32x4*)(ropeS + pp * 16 + f0);
                        f32x4 w0, w1;
                        w0[0] = v0[0] * cs[0] - v0[1] * sn[0]; w0[1] = v0[0] * sn[0] + v0[1] * cs[0];
                        w0[2] = v0[2] * cs[1] - v0[3] * sn[1]; w0[3] = v0[2] * sn[1] + v0[3] * cs[1];
                        w1[0] = v1[0] * cs[2] - v1[1] * sn[2]; w1[1] = v1[0] * sn[2] + v1[1] * cs[2];
                        w1[2] = v1[2] * cs[3] - v1[3] * sn[3]; w1[3] = v1[2] * sn[3] + v1[3] * cs[3];
                        v0 = w0; v1 = w1;
                    }
                    bf16_t* dst = (col < 512) ? Q + (size_t)tok * 512 + col : Kb + (size_t)tok * 128 + (col - 512);
                    *(u32x4*)dst = pack8(v0, v1);
                }
            }
    }
};
struct EpiDft {
    bf16_t* MIX; int isctx;
    __device__ __forceinline__ void operator()(const Acc& acc, const Unit& u, int wr, int wc, int fr, int fq) const {
#pragma unroll
        for (int ai = 0; ai < 2; ++ai)
#pragma unroll
            for (int m = 0; m < 4; ++m) {
                const int k = u.arow + ai * 128 + wr * 64 + m * 16 + fr;
#pragma unroll
                for (int bj = 0; bj < 2; ++bj) {
                    const int col = u.brow + bj * 128 + wc * 32 + fq * 8; const int b = col >> 9, c = col & 511;
                    const size_t trow = isctx ? (size_t)(NLAT + b * 256 + k) : (size_t)(b * 4096 + k);
                    *(u32x4*)(MIX + trow * 1024 + c) = pack8(acc[ai][bj][m][0], acc[ai][bj][m][1]);
                }
            }
    }
};
struct EpiI2 {
    bf16_t* I2;
    __device__ __forceinline__ void operator()(const Acc& acc, const Unit& u, int wr, int wc, int fr, int fq) const {
#pragma unroll
        for (int ai = 0; ai < 2; ++ai)
#pragma unroll
            for (int m = 0; m < 4; ++m) {
                const int row = u.arow + ai * 128 + wr * 64 + m * 16 + fr;
#pragma unroll
                for (int bj = 0; bj < 2; ++bj) {
                    const int col = u.brow + bj * 128 + wc * 32 + fq * 8;
                    *(u32x4*)(I2 + (size_t)row * 32768 + col) = pack8(acc[ai][bj][m][0], acc[ai][bj][m][1]);
                }
            }
    }
};
struct EpiRes {
    const float *in_lat, *in_ctx; float *out_lat, *out_ctx; const float* gate;
    __device__ __forceinline__ void operator()(const Acc& acc, const Unit& u, int wr, int wc, int fr, int fq) const {
        const int row0 = u.arow + wr * 64 + fr, col0 = u.brow + wc * 32 + fq * 8;
        const bool lat = row0 < NLAT;
        const int b = lat ? (row0 >> 12) : 4;
        const float* ip = lat ? in_lat + (size_t)row0 * 1024 + col0 : in_ctx + (size_t)(row0 - NLAT) * 1024 + col0;
        float* op = lat ? out_lat + (size_t)row0 * 1024 + col0 : out_ctx + (size_t)(row0 - NLAT) * 1024 + col0;
        const float* gp = gate + b * 6144 + col0;
        f32x4 gv[2][2];
#pragma unroll
        for (int bj = 0; bj < 2; ++bj)
#pragma unroll
            for (int n = 0; n < 2; ++n) gv[bj][n] = *(const f32x4*)(gp + bj * 128 + 4 * n);
#pragma unroll
        for (int ai = 0; ai < 2; ++ai)
#pragma unroll
            for (int mh = 0; mh < 2; ++mh) {
                f32x4 hv[2][2][2];
#pragma unroll
                for (int mm = 0; mm < 2; ++mm)
#pragma unroll
                    for (int bj = 0; bj < 2; ++bj)
#pragma unroll
                        for (int n = 0; n < 2; ++n) hv[mm][bj][n] = *(const f32x4*)(ip + (size_t)(ai * 128 + (mh * 2 + mm) * 16) * 1024 + bj * 128 + 4 * n);
#pragma unroll
                for (int mm = 0; mm < 2; ++mm)
#pragma unroll
                    for (int bj = 0; bj < 2; ++bj)
#pragma unroll
                        for (int n = 0; n < 2; ++n) *(f32x4*)(op + (size_t)(ai * 128 + (mh * 2 + mm) * 16) * 1024 + bj * 128 + 4 * n) = hv[mm][bj][n] + gv[bj][n] * acc[ai][bj][mh * 2 + mm][n];
            }
    }
};
struct EpiResFinal {
    static constexpr bool AFTER_DRAIN = true;
    const float* H; float* out; const float* gate; const float* fg; float* xss; unsigned* pcnt; unsigned* tmo;
    __device__ __forceinline__ void fused(Acc& acc, const Unit& u, int wr, int wc, int fr, int fq, LAS unsigned char* lds, int wid, int lane) const {
        LAS float* P = (LAS float*)lds;
        LAS float* S = (LAS float*)(lds + 8192);
        const int row0 = u.arow + wr * 64 + fr, col0 = u.brow + wc * 32 + fq * 8;
        const float* ip = H + (size_t)row0 * 1024 + col0; float* op = out + (size_t)row0 * 1024 + col0;
        const float* gp = gate + (row0 >> 12) * 6144 + col0;
        f32x4 gv[2][2];
#pragma unroll
        for (int bj = 0; bj < 2; ++bj)
#pragma unroll
            for (int n = 0; n < 2; ++n) gv[bj][n] = *(const f32x4*)(gp + bj * 128 + 4 * n);
#pragma unroll
        for (int ai = 0; ai < 2; ++ai)
#pragma unroll
            for (int m = 0; m < 4; ++m) {
                float s = 0.f;
#pragma unroll
                for (int bj = 0; bj < 2; ++bj)
#pragma unroll
                    for (int n = 0; n < 2; ++n) {
                        const f32x4 hv = *(const f32x4*)(ip + (size_t)(ai * 128 + m * 16) * 1024 + bj * 128 + 4 * n);
                        const f32x4 h = hv + gv[bj][n] * acc[ai][bj][m][n]; acc[ai][bj][m][n] = h;
                        s += (h[0] * h[0] + h[1] * h[1]) + (h[2] * h[2] + h[3] * h[3]);
                    }
                s += __shfl_xor(s, 16); s += __shfl_xor(s, 32);
                if (fq == 0) P[(ai * 128 + wr * 64 + m * 16 + fr) * 4 + wc] = s;
            }
        asm volatile("s_waitcnt lgkmcnt(0)" ::: "memory"); __builtin_amdgcn_s_barrier(); asm volatile("" ::: "memory");
        const int row = wid * 32 + (lane & 31);
        if (lane < 32) {
            const float t = (P[row * 4 + 0] + P[row * 4 + 1]) + (P[row * 4 + 2] + P[row * 4 + 3]);
            __hip_atomic_store((unsigned*)xss + ((size_t)(u.arow + row) * 4 + u.pn), __float_as_uint(t), __ATOMIC_RELAXED, __HIP_MEMORY_SCOPE_AGENT);
        }
        asm volatile("s_waitcnt vmcnt(0)" ::: "memory");
        if (lane == 0) __hip_atomic_fetch_add(pcnt + 64 * u.pm, 1u, __ATOMIC_RELAXED, __HIP_MEMORY_SCOPE_AGENT);
        if (wid == 0) {
            unsigned sp = 0;
            while ((unsigned)__builtin_amdgcn_readfirstlane(__hip_atomic_load(pcnt + 64 * u.pm, __ATOMIC_RELAXED, __HIP_MEMORY_SCOPE_AGENT)) < 32u) {
                __builtin_amdgcn_s_sleep(2);
                if ((++sp & 1023u) == 0u) { if (__hip_atomic_load(tmo, __ATOMIC_RELAXED, __HIP_MEMORY_SCOPE_AGENT) != 0u) break; if (sp > (1u << 22)) { if (lane == 0) atomicAdd(tmo, 1u); break; } }
            }
            __builtin_amdgcn_fence(__ATOMIC_ACQUIRE, "agent");
        }
        asm volatile("s_waitcnt vmcnt(0) lgkmcnt(0)" ::: "memory"); __builtin_amdgcn_s_barrier(); asm volatile("" ::: "memory");
        if (lane < 32) {
            const unsigned* slot = (const unsigned*)xss + (size_t)(u.arow + row) * 4; float t = 0.f;
#pragma unroll
            for (int q = 0; q < 4; ++q) t += __uint_as_float(__hip_atomic_load(slot + q, __ATOMIC_RELAXED, __HIP_MEMORY_SCOPE_AGENT));
            S[row] = rsqrtf(t * (1.0f / 1024.0f) + 1e-6f);
        }
        asm volatile("s_waitcnt lgkmcnt(0)" ::: "memory"); __builtin_amdgcn_s_barrier(); asm volatile("" ::: "memory");
        f32x4 fv[2][2];
#pragma unroll
        for (int bj = 0; bj < 2; ++bj)
#pragma unroll
            for (int n = 0; n < 2; ++n) fv[bj][n] = *(const f32x4*)(fg + col0 + bj * 128 + 4 * n);
#pragma unroll
        for (int ai = 0; ai < 2; ++ai)
#pragma unroll
            for (int m = 0; m < 4; ++m) {
                const float rinv = S[ai * 128 + wr * 64 + m * 16 + fr];
#pragma unroll
                for (int bj = 0; bj < 2; ++bj)
#pragma unroll
                    for (int n = 0; n < 2; ++n) *(f32x4*)(op + (size_t)(ai * 128 + m * 16) * 1024 + bj * 128 + 4 * n) = acc[ai][bj][m][n] * rinv * fv[bj][n];
            }
    }
};
struct EpiResNorm {
    static constexpr bool AFTER_DRAIN = true;
    const float* X; float* H; const float* gate; const float* ng; const float* mods_l; bf16_t* XNo; float* xss; unsigned* pcnt; unsigned* tmo;
    __device__ __forceinline__ void fused(Acc& acc, const Unit& u, int wr, int wc, int fr, int fq, LAS unsigned char* lds, int wid, int lane) const {
        LAS float* P = (LAS float*)lds; LAS float* S = (LAS float*)(lds + 8192);
        const int row0 = u.arow + wr * 64 + fr, col0 = u.brow + wc * 32 + fq * 8, b = row0 >> 12;
        const float* ip = X + (size_t)row0 * 1024 + col0; float* op = H + (size_t)row0 * 1024 + col0;
        {
            const float* gp = gate + b * 6144 + col0; f32x4 gv[2][2];
#pragma unroll
            for (int bj = 0; bj < 2; ++bj)
#pragma unroll
                for (int n = 0; n < 2; ++n) gv[bj][n] = *(const f32x4*)(gp + bj * 128 + 4 * n);
#pragma unroll
            for (int ai = 0; ai < 2; ++ai)
#pragma unroll
                for (int m = 0; m < 4; ++m) {
                    float s = 0.f;
#pragma unroll
                    for (int bj = 0; bj < 2; ++bj)
#pragma unroll
                        for (int n = 0; n < 2; ++n) {
                            const f32x4 hv = *(const f32x4*)(ip + (size_t)(ai * 128 + m * 16) * 1024 + bj * 128 + 4 * n);
                            const f32x4 h = hv + gv[bj][n] * acc[ai][bj][m][n]; acc[ai][bj][m][n] = h;
                            *(f32x4*)(op + (size_t)(ai * 128 + m * 16) * 1024 + bj * 128 + 4 * n) = h;
                            s += (h[0] * h[0] + h[1] * h[1]) + (h[2] * h[2] + h[3] * h[3]);
                        }
                    s += __shfl_xor(s, 16); s += __shfl_xor(s, 32);
                    if (fq == 0) P[(ai * 128 + wr * 64 + m * 16 + fr) * 4 + wc] = s;
                }
        }
        asm volatile("s_waitcnt lgkmcnt(0)" ::: "memory"); __builtin_amdgcn_s_barrier(); asm volatile("" ::: "memory");
        const int row = wid * 32 + (lane & 31);
        if (lane < 32) {
            const float t = (P[row * 4 + 0] + P[row * 4 + 1]) + (P[row * 4 + 2] + P[row * 4 + 3]);
            __hip_atomic_store((unsigned*)xss + ((size_t)(u.arow + row) * 4 + u.pn), __float_as_uint(t), __ATOMIC_RELAXED, __HIP_MEMORY_SCOPE_AGENT);
        }
        asm volatile("s_waitcnt vmcnt(0)" ::: "memory");
        if (lane == 0) __hip_atomic_fetch_add(pcnt + 64 * u.pm, 1u, __ATOMIC_RELAXED, __HIP_MEMORY_SCOPE_AGENT);
        if (wid == 0) {
            unsigned sp = 0;
            while ((unsigned)__builtin_amdgcn_readfirstlane(__hip_atomic_load(pcnt + 64 * u.pm, __ATOMIC_RELAXED, __HIP_MEMORY_SCOPE_AGENT)) < 32u) {
                __builtin_amdgcn_s_sleep(2);
                if ((++sp & 1023u) == 0u) { if (__hip_atomic_load(tmo, __ATOMIC_RELAXED, __HIP_MEMORY_SCOPE_AGENT) != 0u) break; if (sp > (1u << 22)) { if (lane == 0) atomicAdd(tmo, 1u); break; } }
            }
            __builtin_amdgcn_fence(__ATOMIC_ACQUIRE, "agent");
        }
        asm volatile("s_waitcnt vmcnt(0) lgkmcnt(0)" ::: "memory"); __builtin_amdgcn_s_barrier(); asm volatile("" ::: "memory");
        if (lane < 32) {
            const unsigned* slot = (const unsigned*)xss + (size_t)(u.arow + row) * 4; float t = 0.f;
#pragma unroll
            for (int q = 0; q < 4; ++q) t += __uint_as_float(__hip_atomic_load(slot + q, __ATOMIC_RELAXED, __HIP_MEMORY_SCOPE_AGENT));
            S[row] = rsqrtf(t * (1.0f / 1024.0f) + 1e-6f);
        }
        asm volatile("s_waitcnt lgkmcnt(0)" ::: "memory"); __builtin_amdgcn_s_barrier(); asm volatile("" ::: "memory");
        bf16_t* xp = XNo + (size_t)row0 * 1024 + col0;
#pragma unroll
        for (int bj = 0; bj < 2; ++bj) {
            f32x4 mv[2], sv[2];
#pragma unroll
            for (int n = 0; n < 2; ++n) { const int c = col0 + bj * 128 + 4 * n; const f32x4 g4 = *(const f32x4*)(ng + c), s4 = *(const f32x4*)(mods_l + (size_t)b * 6144 + 4 * 1024 + c); sv[n] = *(const f32x4*)(mods_l + (size_t)b * 6144 + 3 * 1024 + c);
#pragma unroll
                for (int j = 0; j < 4; ++j) mv[n][j] = g4[j] * (1.0f + s4[j]); }
#pragma unroll
            for (int ai = 0; ai < 2; ++ai)
#pragma unroll
                for (int m = 0; m < 4; ++m) {
                    const float rinv = S[ai * 128 + wr * 64 + m * 16 + fr];
                    const f32x4 y0 = acc[ai][bj][m][0] * rinv * mv[0] + sv[0], y1 = acc[ai][bj][m][1] * rinv * mv[1] + sv[1];
                    *(u32x4*)(xp + (size_t)(ai * 128 + m * 16) * 1024 + bj * 128) = pack8(y0, y1);
                }
        }
    }
};
struct EpiPart {
    float* slab;
    __device__ __forceinline__ void operator()(const Acc& acc, const Unit& u, int wr, int wc, int fr, int fq) const {
        float* base = slab + (size_t)(u.kofs >> 8) * 1024 * 1024;
#pragma unroll
        for (int ai = 0; ai < 2; ++ai)
#pragma unroll
            for (int m = 0; m < 4; ++m) {
                const int row = u.arow + ai * 128 + wr * 64 + m * 16 + fr;
                float* op = base + (size_t)row * 1024;
#pragma unroll
                for (int bj = 0; bj < 2; ++bj) {
                    const int col = u.brow + bj * 128 + wc * 32 + fq * 8;
                    *(f32x4*)(op + col) = acc[ai][bj][m][0]; *(f32x4*)(op + col + 4) = acc[ai][bj][m][1];
                }
            }
    }
};
struct EpiSwiglu {
    bf16_t* ACT;
    __device__ __forceinline__ void operator()(const Acc& acc, const Unit& u, int wr, int wc, int fr, int fq) const {
#pragma unroll
        for (int ai = 0; ai < 2; ++ai)
#pragma unroll
            for (int m = 0; m < 4; ++m) {
                const int row = u.arow + ai * 128 + wr * 64 + m * 16 + fr;
                const int col = u.pn * 128 + wc * 32 + fq * 8;
                f32x4 o0, o1;
#pragma unroll
                for (int j = 0; j < 4; ++j) { o0[j] = siluf_(acc[ai][0][m][0][j]) * acc[ai][1][m][0][j]; o1[j] = siluf_(acc[ai][0][m][1][j]) * acc[ai][1][m][1][j]; }
                *(u32x4*)(ACT + (size_t)row * FF + col) = pack8(o0, o1);
            }
    }
};
struct EpiGlu {
    float* H; const float* gate;
    __device__ __forceinline__ void operator()(const Acc& acc, const Unit& u, int wr, int wc, int fr, int fq) const {
        const int b = u.arow >> 12; const int col = u.pn * 128 + wc * 32 + fq * 8;
        const float* gp = gate + b * 6144 + col;
        float* hp0 = H + (size_t)(u.arow + wr * 64 + fr) * 1024 + col;
        f32x4 gv[2];
#pragma unroll
        for (int n = 0; n < 2; ++n) gv[n] = *(const f32x4*)(gp + 4 * n);
#pragma unroll
        for (int ai = 0; ai < 2; ++ai) {
            f32x4 hv[4][2];
#pragma unroll
            for (int m = 0; m < 4; ++m)
#pragma unroll
                for (int n = 0; n < 2; ++n) hv[m][n] = *(const f32x4*)(hp0 + (size_t)(ai * 128 + m * 16) * 1024 + 4 * n);
#pragma unroll
            for (int m = 0; m < 4; ++m)
#pragma unroll
                for (int n = 0; n < 2; ++n) {
                    f32x4 o;
#pragma unroll
                    for (int j = 0; j < 4; ++j) o[j] = hv[m][n][j] + gv[n][j] * (acc[ai][0][m][n][j] * sigmoidf_(acc[ai][1][m][n][j]));
                    *(f32x4*)(hp0 + (size_t)(ai * 128 + m * 16) * 1024 + 4 * n) = o;
                }
        }
    }
};
struct EpiGluNorm {
    static constexpr bool AFTER_DRAIN = true;
    float* H; const float* gate; const float* ng; const float* mods_l; bf16_t* XNo; float* xss; unsigned* pcnt; unsigned* tmo;
    __device__ __forceinline__ void fused(Acc& acc, const Unit& u, int wr, int wc, int fr, int fq, LAS unsigned char* lds, int wid, int lane) const {
        LAS float* P = (LAS float*)lds; LAS float* S = (LAS float*)(lds + 8192);
        const int row0 = u.arow + wr * 64 + fr, col = u.pn * 128 + wc * 32 + fq * 8, b = row0 >> 12;
        float* hp = H + (size_t)row0 * 1024 + col;
        {
            const float* gp = gate + b * 6144 + col; f32x4 gv[2];
#pragma unroll
            for (int n = 0; n < 2; ++n) gv[n] = *(const f32x4*)(gp + 4 * n);
#pragma unroll
            for (int ai = 0; ai < 2; ++ai)
#pragma unroll
                for (int m = 0; m < 4; ++m) {
                    float s = 0.f;
#pragma unroll
                    for (int n = 0; n < 2; ++n) {
                        const f32x4 hv = *(const f32x4*)(hp + (size_t)(ai * 128 + m * 16) * 1024 + 4 * n); f32x4 o;
#pragma unroll
                        for (int j = 0; j < 4; ++j) o[j] = hv[j] + gv[n][j] * (acc[ai][0][m][n][j] * sigmoidf_(acc[ai][1][m][n][j]));
                        *(f32x4*)(hp + (size_t)(ai * 128 + m * 16) * 1024 + 4 * n) = o; acc[ai][0][m][n] = o;
                        s += (o[0] * o[0] + o[1] * o[1]) + (o[2] * o[2] + o[3] * o[3]);
                    }
                    s += __shfl_xor(s, 16); s += __shfl_xor(s, 32);
                    if (fq == 0) P[(ai * 128 + wr * 64 + m * 16 + fr) * 4 + wc] = s;
                }
        }
        asm volatile("s_waitcnt lgkmcnt(0)" ::: "memory"); __builtin_amdgcn_s_barrier(); asm volatile("" ::: "memory");
        const int row = wid * 32 + (lane & 31);
        if (lane < 32) {
            const float t = (P[row * 4 + 0] + P[row * 4 + 1]) + (P[row * 4 + 2] + P[row * 4 + 3]);
            __hip_atomic_store((unsigned*)xss + ((size_t)(u.arow + row) * 8 + u.pn), __float_as_uint(t), __ATOMIC_RELAXED, __HIP_MEMORY_SCOPE_AGENT);
        }
        asm volatile("s_waitcnt vmcnt(0)" ::: "memory");
        if (lane == 0) __hip_atomic_fetch_add(pcnt + 64 * u.pm, 1u, __ATOMIC_RELAXED, __HIP_MEMORY_SCOPE_AGENT);
        if (wid == 0) {
            unsigned sp = 0;
            while ((unsigned)__builtin_amdgcn_readfirstlane(__hip_atomic_load(pcnt + 64 * u.pm, __ATOMIC_RELAXED, __HIP_MEMORY_SCOPE_AGENT)) < 64u) {
                __builtin_amdgcn_s_sleep(2);
                if ((++sp & 1023u) == 0u) { if (__hip_atomic_load(tmo, __ATOMIC_RELAXED, __HIP_MEMORY_SCOPE_AGENT) != 0u) break; if (sp > (1u << 22)) { if (lane == 0) atomicAdd(tmo, 1u); break; } }
            }
            __builtin_amdgcn_fence(__ATOMIC_ACQUIRE, "agent");
        }
        asm volatile("s_waitcnt vmcnt(0) lgkmcnt(0)" ::: "memory"); __builtin_amdgcn_s_barrier(); asm volatile("" ::: "memory");
        if (lane < 32) {
            const unsigned* slot = (const unsigned*)xss + (size_t)(u.arow + row) * 8; float t = 0.f;
#pragma unroll
            for (int q = 0; q < 8; ++q) t += __uint_as_float(__hip_atomic_load(slot + q, __ATOMIC_RELAXED, __HIP_MEMORY_SCOPE_AGENT));
            S[row] = rsqrtf(t * (1.0f / 1024.0f) + 1e-6f);
        }
        asm volatile("s_waitcnt lgkmcnt(0)" ::: "memory"); __builtin_amdgcn_s_barrier(); asm volatile("" ::: "memory");
        f32x4 mv[2], sv[2];
#pragma unroll
        for (int n = 0; n < 2; ++n) { const int c = col + 4 * n; const f32x4 g4 = *(const f32x4*)(ng + c), s4 = *(const f32x4*)(mods_l + (size_t)b * 6144 + 4 * 1024 + c); sv[n] = *(const f32x4*)(mods_l + (size_t)b * 6144 + 3 * 1024 + c);
#pragma unroll
            for (int j = 0; j < 4; ++j) mv[n][j] = g4[j] * (1.0f + s4[j]); }
        bf16_t* xp = XNo + (size_t)row0 * 1024 + col;
#pragma unroll
        for (int ai = 0; ai < 2; ++ai)
#pragma unroll
            for (int m = 0; m < 4; ++m) {
                const float rinv = S[ai * 128 + wr * 64 + m * 16 + fr];
                const f32x4 y0 = acc[ai][0][m][0] * rinv * mv[0] + sv[0], y1 = acc[ai][0][m][1] * rinv * mv[1] + sv[1];
                *(u32x4*)(xp + (size_t)(ai * 128 + m * 16) * 1024) = pack8(y0, y1);
            }
    }
};
struct EpiState {
    bf16_t* S;
    __device__ __forceinline__ void operator()(const Acc& acc, const Unit& u, int wr, int wc, int fr, int fq) const {
        bf16_t* base = S + (size_t)u.pn * SROWS * 256;
#pragma unroll
        for (int ai = 0; ai < 2; ++ai)
#pragma unroll
            for (int m = 0; m < 4; ++m) {
                const int lrow = u.pm * 256 + ai * 128 + wr * 64 + m * 16 + fr;
                bf16_t* op = base + (size_t)lrow * 256;
#pragma unroll
                for (int bj = 0; bj < 2; ++bj) *(u32x4*)(op + bj * 128 + wc * 32 + fq * 8) = pack8(acc[ai][bj][m][0], acc[ai][bj][m][1]);
            }
    }
};
struct EpiSout {
    bf16_t* GY;
    __device__ __forceinline__ void operator()(const Acc& acc, const Unit& u, int wr, int wc, int fr, int fq) const {
#pragma unroll
        for (int ai = 0; ai < 2; ++ai)
#pragma unroll
            for (int m = 0; m < 4; ++m) {
                const int lrow = u.pm * 256 + ai * 128 + wr * 64 + m * 16 + fr;
                const int b = lrow >> 8, ch = lrow & 255;
#pragma unroll
                for (int bj = 0; bj < 2; ++bj) {
                    const int n = bj * 128 + wc * 32 + fq * 8; const int t = n >> 4, h0 = n & 15;
                    f32x4 o0, o1;
#pragma unroll
                    for (int j = 0; j < 4; ++j) { o0[j] = gelu_tanh(acc[ai][bj][m][0][j]); o1[j] = gelu_tanh(acc[ai][bj][m][1][j]); }
                    *(u32x4*)(GY + (size_t)(b * 4096 + ch * 16 + t) * 1024 + u.pn * 16 + h0) = pack8(o0, o1);
                }
            }
    }
};

__device__ __forceinline__ void p0_transpose(const float* src, int ld, int K, int c0, bf16_t* dst, float scale, LAS float* tile) {
    const int tid = otid();
    const int lkk = tid >> 7, lcc = tid & 127;
    float r[16];
#pragma unroll
    for (int i = 0; i < 16; ++i) r[i] = __builtin_nontemporal_load(src + (size_t)(lkk + 4 * i) * ld + c0 + lcc);
    for (int k0 = 0; k0 < K; k0 += 64) {
        __syncthreads();
#pragma unroll
        for (int i = 0; i < 16; ++i) tile[(lkk + 4 * i) * 129 + lcc] = r[i];
        if (k0 + 64 < K) {
#pragma unroll
            for (int i = 0; i < 16; ++i) r[i] = __builtin_nontemporal_load(src + (size_t)(k0 + 64 + lkk + 4 * i) * ld + c0 + lcc);
        }
        __syncthreads();
        { const int cc = tid >> 2, kk0 = (tid & 3) * 16; float v[16];
#pragma unroll
          for (int j = 0; j < 16; ++j) v[j] = tile[(kk0 + j) * 129 + cc] * scale;
          u32x4 w0, w1; w0.x = cvt_pk_bf16(v[0], v[1]); w0.y = cvt_pk_bf16(v[2], v[3]); w0.z = cvt_pk_bf16(v[4], v[5]); w0.w = cvt_pk_bf16(v[6], v[7]);
          w1.x = cvt_pk_bf16(v[8], v[9]); w1.y = cvt_pk_bf16(v[10], v[11]); w1.z = cvt_pk_bf16(v[12], v[13]); w1.w = cvt_pk_bf16(v[14], v[15]);
          bf16_t* dp = dst + (size_t)cc * K + k0 + kk0; *(u32x4*)dp = w0; *(u32x4*)(dp + 8) = w1; }
    }
    __syncthreads();
}

__device__ __forceinline__ void p0_s5_item(const Params& p, int g, LAS float* L) {
    const int tid = otid();
    LAS float* pw_re = L;
    LAS float* pw_im = L + 2176;
    LAS float* bb_re = L + 4352;
    LAS float* bb_im = L + 6400;
    LAS float* cc_re = L + 8448;
    LAS float* cc_im = L + 10528;
    LAS float* Kt = L + 12608;
    __syncthreads();
    if (tid < 128) {
        const int dir = tid >> 6, pp = tid & 63;
        const float dt = expf(p.log_dt[dir * 64 + g]);
        const float are = p.a_re[(dir * 64 + g) * 64 + pp], aim = p.a_im[(dir * 64 + g) * 64 + pp];
        for (int tau = 0; tau <= 16; ++tau) {
            const float mag = expf(are * dt * (float)tau); float s, c; sincosf(aim * dt * (float)tau, &s, &c);
            pw_re[(dir * 64 + pp) * 17 + tau] = mag * c; pw_im[(dir * 64 + pp) * 17 + tau] = mag * s;
        }
        const float abr = pw_re[(dir * 64 + pp) * 17 + 1], abi = pw_im[(dir * 64 + pp) * 17 + 1];
        const float nr = abr - 1.0f, ni = abi, den = are * are + aim * aim;
        const float fre = (nr * are + ni * aim) / den, fim = (ni * are - nr * aim) / den;
        for (int h = 0; h < 16; ++h) {
            const float br = p.b_re[((size_t)(dir * 64 + g) * 64 + pp) * 16 + h], bi = p.b_im[((size_t)(dir * 64 + g) * 64 + pp) * 16 + h];
            bb_re[(dir * 64 + pp) * 16 + h] = fre * br - fim * bi; bb_im[(dir * 64 + pp) * 16 + h] = fre * bi + fim * br;
        }
    }
    for (int idx = tid; idx < 2048; idx += NT) {
        const int dir = idx >> 10, h = (idx >> 6) & 15, pp = idx & 63;
        cc_re[(dir * 16 + h) * 65 + pp] = p.c_re[((size_t)(dir * 64 + g) * 16 + h) * 64 + pp]; cc_im[(dir * 16 + h) * 65 + pp] = p.c_im[((size_t)(dir * 64 + g) * 16 + h) * 64 + pp];
    }
    __syncthreads();
    {
        const int dir = tid >> 8, tau = (tid >> 4) & 15, h = tid & 15;
        float a[16];
#pragma unroll
        for (int j = 0; j < 16; ++j) a[j] = 0.f;
        for (int pp = 0; pp < 64; ++pp) {
            const float cr = cc_re[(dir * 16 + h) * 65 + pp], ci = cc_im[(dir * 16 + h) * 65 + pp];
            const float pr = pw_re[(dir * 64 + pp) * 17 + tau], pi = pw_im[(dir * 64 + pp) * 17 + tau];
            const float xr = cr * pr - ci * pi, xi = cr * pi + ci * pr;
#pragma unroll
            for (int j = 0; j < 16; ++j) a[j] += xr * bb_re[(dir * 64 + pp) * 16 + j] - xi * bb_im[(dir * 64 + pp) * 16 + j];
        }
#pragma unroll
        for (int j = 0; j < 16; ++j) Kt[tid * 16 + j] = a[j];
    }
    __syncthreads();
    bf16_t* Wst = (bf16_t*)(p.ws + O_WST) + (size_t)g * 256 * 256;
    for (int ch = tid; ch < 8192; ch += NT) {
        const int n = ch >> 5, k0 = (ch & 31) * 8; const int dir = n >> 7, ri = (n >> 6) & 1, pp = n & 63, s = k0 >> 4, h0 = k0 & 15; const int e = dir ? s : 15 - s;
        const float pr = pw_re[(dir * 64 + pp) * 17 + e], pi = pw_im[(dir * 64 + pp) * 17 + e];
        float v[8];
#pragma unroll
        for (int j = 0; j < 8; ++j) { const float br = bb_re[(dir * 64 + pp) * 16 + h0 + j], bi = bb_im[(dir * 64 + pp) * 16 + h0 + j]; v[j] = ri ? (pr * bi + pi * br) : (pr * br - pi * bi); }
        u32x4 w; w.x = cvt_pk_bf16(v[0], v[1]); w.y = cvt_pk_bf16(v[2], v[3]); w.z = cvt_pk_bf16(v[4], v[5]); w.w = cvt_pk_bf16(v[6], v[7]);
        *(u32x4*)(Wst + (size_t)n * 256 + k0) = w;
    }
    bf16_t* Tt = (bf16_t*)(p.ws + O_TT) + (size_t)g * 256 * 512;
    for (int ch = tid; ch < 16384; ch += NT) {
        const int n = ch >> 6, k0 = (ch & 63) * 8; const int t = n >> 4, h = n & 15; float v[8];
        if (k0 < 256) {
            const int s = k0 >> 4, h0 = k0 & 15;
#pragma unroll
            for (int j = 0; j < 8; ++j) {
                float x = 0.f;
                if (s <= t) x += Kt[((0 * 16 + (t - s)) * 16 + h) * 16 + h0 + j];
                if (s >= t) x += Kt[((1 * 16 + (s - t)) * 16 + h) * 16 + h0 + j];
                if (s == t && h == h0 + j) x += p.ssm_d[g * 16 + h];
                v[j] = x;
            }
        } else {
            const int kk = k0 - 256, dir = kk >> 7, ri = (kk >> 6) & 1, p0 = kk & 63; const int e = dir ? 16 - t : t + 1;
#pragma unroll
            for (int j = 0; j < 8; ++j) {
                const int pp = p0 + j;
                const float cr = cc_re[(dir * 16 + h) * 65 + pp], ci = cc_im[(dir * 16 + h) * 65 + pp], pr = pw_re[(dir * 64 + pp) * 17 + e], pi = pw_im[(dir * 64 + pp) * 17 + e];
                v[j] = ri ? -(cr * pi + ci * pr) : (cr * pr - ci * pi);
            }
        }
        u32x4 w; w.x = cvt_pk_bf16(v[0], v[1]); w.y = cvt_pk_bf16(v[2], v[3]); w.z = cvt_pk_bf16(v[4], v[5]); w.w = cvt_pk_bf16(v[6], v[7]);
        *(u32x4*)(Tt + (size_t)n * 512 + k0) = w;
    }
    __syncthreads();
}

__device__ __forceinline__ void p0_adaln_item(const Params& p, int it, LAS float* L) {
    const int tid = otid(); const int l = it / 96, n0 = (it % 96) * 64;
    LAS float* sc = L;
    LAS float* red = L + 5120;
    __syncthreads();
    for (int idx = tid; idx < 5120; idx += NT) { const int r = idx >> 10, k = idx & 1023; const float v = (r < 4) ? p.c[r * 1024 + k] : p.c_ctx[k]; sc[idx] = siluf_(v); }
    __syncthreads();
    const int n = tid & 63, kq = tid >> 6; float a[5] = {0.f, 0.f, 0.f, 0.f, 0.f};
    const float* wp = p.mod_w + (size_t)l * 1024 * 6144 + n0 + n;
    for (int k = kq; k < 1024; k += 128) {
        float w[16];
#pragma unroll
        for (int u = 0; u < 16; ++u) w[u] = __builtin_nontemporal_load(wp + (size_t)(k + 8 * u) * 6144);
#pragma unroll
        for (int u = 0; u < 16; ++u)
#pragma unroll
            for (int r = 0; r < 5; ++r) a[r] += sc[r * 1024 + k + 8 * u] * w[u];
    }
#pragma unroll
    for (int r = 0; r < 5; ++r) red[(kq * 5 + r) * 64 + n] = a[r];
    __syncthreads();
    if (tid < 320) { const int r = tid >> 6, nn = tid & 63; float s = p.mod_b[l * 6144 + n0 + nn];
#pragma unroll
        for (int q = 0; q < 8; ++q) s += red[(q * 5 + r) * 64 + nn];
        ((float*)(p.ws + O_MODS))[(size_t)(l * 5 + r) * 6144 + n0 + nn] = s; }
    __syncthreads();
}

__device__ __forceinline__ void p0_fold_item(const Params& p, int it, LAS float* L) {
    const int tid = otid(); const int grp = it >> 4, kt = it & 15;
    LAS float* w = L;
    LAS float* cT = L + 4160;
    LAS float* sT = L + 4224;
    __syncthreads();
#pragma unroll
    for (int i = 0; i < 8; ++i) { const int idx = tid + i * NT, kk = idx >> 6, j = idx & 63; w[kk * 65 + j] = p.w_in[(size_t)(kt * 64 + kk) * 1280 + grp * 64 + j]; }
    if (tid < 64) { cT[tid] = cospif((float)tid / 32.0f); sT[tid] = sinpif((float)tid / 32.0f); }
    __syncthreads();
    const int kk = tid & 63, q = tid >> 6; bf16_t* WinA = (bf16_t*)(p.ws + O_WINA);
    for (int i = 0; i < 8; ++i) {
        const int n = q + 8 * i; float ac = 0.f, as = 0.f; int ph = 0;
        for (int j = 0; j < 64; ++j) { const float wv = w[kk * 65 + j]; ac += wv * cT[ph]; as += wv * sT[ph]; ph = (ph + n) & 63; }
        WinA[(size_t)(grp * 64 + n) * 1024 + kt * 64 + kk] = f2bf(ac);
        WinA[(size_t)(512 + grp * 64 + n) * 1024 + kt * 64 + kk] = f2bf(as);
    }
    __syncthreads();
}

__device__ __forceinline__ void p0_dft_item(const Params& p, int it, LAS float* L) {
    const int tid = otid();
    __syncthreads();
    for (int i = tid; i < 256; i += NT) L[i] = cospif((float)i / 128.0f);
    __syncthreads();
    if (it == 0) {
        bf16_t* D = (bf16_t*)(p.ws + O_D256);
        for (int idx = tid; idx < 512 * 512; idx += NT) {
            const int row = idx >> 9, col = idx & 511; const int ro = row >> 8, k = row & 255, cs = col >> 8, t = col & 255; const int ph = (k * t) & 255;
            const float C = L[ph], S = L[(ph - 64) & 255];
            const float v = ro == 0 ? (cs == 0 ? C : -S) : (cs == 0 ? -S : -C);
            D[idx] = f2bf(v);
        }
    } else {
        bf16_t* Dc = (bf16_t*)(p.ws + O_DC);
        for (int idx = tid; idx < 256 * 512; idx += NT) {
            const int k = idx >> 9, j = idx & 511, t = j & 255, cs = j >> 8; const int ph = (k * t) & 255;
            Dc[idx] = f2bf((cs ? -L[(ph - 64) & 255] : L[ph]) * (1.0f / 128.0f));
        }
    }
    __syncthreads();
}

constexpr int P0_S5 = 64, P0_ADA = 192, P0_FOLD = 128, P0_TR = 134, P0_DFT = 2, P0_MISC = 1;
constexpr int P0_ITEMS = P0_S5 + P0_ADA + P0_FOLD + P0_TR + P0_DFT + P0_MISC;

__device__ __forceinline__ void p0_transpose_dispatch(const Params& p, int it, LAS float* L) {
    unsigned char* ws = p.ws;
    const float* src; int ld, K, c0; bf16_t* dst; float scale = 1.0f;
    if (it < 16) { const int l = it >> 3; it &= 7; src = p.ffn_d + (size_t)l * FF * 1024; ld = 1024; K = FF; c0 = 128 * it; dst = (bf16_t*)(ws + (l ? O_WD1 : O_WD0)) + (size_t)(128 * it) * FF; }
    else {
        it -= 16;
        if (it < 4) { src = p.w_in; ld = 1280; K = 1024; c0 = 512 + 128 * it; dst = (bf16_t*)(ws + O_WINB) + (size_t)(128 * it) * 1024; scale = 0.125f * 1.4426950408889634f; }
        else if (it < 5) { src = p.w_in; ld = 1280; K = 1024; c0 = 1024; dst = (bf16_t*)(ws + O_WINB) + (size_t)512 * 1024; }
        else if (it < 6) { src = p.w_in; ld = 1280; K = 1024; c0 = 1152; dst = (bf16_t*)(ws + O_WINB) + (size_t)640 * 1024; }
        else if (it < 14) { it -= 6; src = p.w_out; ld = 1024; K = 1024; c0 = 128 * it; dst = (bf16_t*)(ws + O_WOUT) + (size_t)(128 * it) * 1024; }
        else if (it < 14 + 88) {
            it -= 14; const int l = it / 44; it -= l * 44;
            bf16_t* wgu = (bf16_t*)(ws + (l ? O_WGU1 : O_WGU0));
            const int up = it / 22, tile = it % 22;
            src = (up ? p.ffn_u : p.ffn_g) + (size_t)l * 1024 * FF; ld = FF; K = 1024; c0 = 128 * tile; dst = wgu + (size_t)(tile * 256 + up * 128) * 1024;
        } else {
            it -= 102; c0 = 128 * it; const int half = c0 >> 10, j = c0 & 1023;
            src = p.glu_w; ld = 2048; K = 1024; dst = (bf16_t*)(ws + O_GLU) + (size_t)((j >> 7) * 256 + half * 128) * 1024;
        }
    }
    p0_transpose(src, ld, K, c0, dst, scale, L);
}

__device__ __forceinline__ void p0_misc(const Params& p) {
    const int tid = otid();
    float* rc = (float*)(p.ws + O_ROPE); float* rs = rc + 1024;
    for (int i = tid; i < 1024; i += NT) { const int pp = i >> 4, f = i & 15; const float inv = powf(10000.0f, -(float)f / 16.0f); const float ang = (float)pp * inv; float s, c; sincosf(ang, &s, &c); rc[i] = c; rs[i] = s; }
}

__device__ __forceinline__ void p0_dispatch(const Params& p, int it, LAS float* L) {
    int i = it;
    if (i < 64) { p0_s5_item(p, i, L); return; } i -= 64;
    if (i < 16) { p0_transpose_dispatch(p, i, L); return; } i -= 16;
    if (i < 128) { p0_fold_item(p, i, L); return; } i -= 128;
    if (i < 118) { p0_transpose_dispatch(p, 16 + i, L); return; } i -= 118;
    if (i < 192) { p0_adaln_item(p, i, L); return; } i -= 192;
    if (i < 2) { p0_dft_item(p, i, L); return; } i -= 2;
    p0_misc(p);
}
__device__ __forceinline__ void phase_p0(const Params& p, LAS float* L, unsigned* qhead, volatile LAS unsigned* qslot) {
    for (;;) {
        __syncthreads();
        if (threadIdx.x == 0) qslot[0] = __hip_atomic_fetch_add(qhead, 1u, __ATOMIC_RELAXED, __HIP_MEMORY_SCOPE_AGENT);
        __syncthreads();
        const int it = (int)qslot[0];
        if (it >= P0_ITEMS) break;
        p0_dispatch(p, it, L);
    }
}

template <int MODE>
__device__ __forceinline__ void phase_norm(const float* src_lat, const float* src_ctx, int nrows, const float* ng, const float* mods_l, int sh_idx, int sc_idx, bf16_t* dstb, float* dstf,
                                           const float* part = nullptr, int npart = 0, const float* pgate = nullptr, float* hstore = nullptr, int row_first = 0) {
    const int tid_ = otid(); const int lane = tid_ & 63, wv = obid() * 8 + (tid_ >> 6), nw = gridDim.x * 8;
    for (int row = row_first + wv; row < nrows; row += nw) {
        const float* sp; int mr;
        if (row < NLAT) { sp = src_lat + (size_t)row * 1024; mr = row >> 12; } else { sp = src_ctx + (size_t)(row - NLAT) * 1024; mr = 4; }
        f32x4 v[4]; float ss = 0.f;
#pragma unroll
        for (int i = 0; i < 4; ++i) v[i] = *(const f32x4*)(sp + i * 256 + lane * 4);
        if (npart > 0 && row >= NLAT) {
#pragma unroll
            for (int i = 0; i < 4; ++i) {
                const int col = i * 256 + lane * 4; f32x4 s = {0.f, 0.f, 0.f, 0.f};
#pragma unroll 2
                for (int k = 0; k < npart; ++k) s += *(const f32x4*)(part + ((size_t)k * 1024 + (row - NLAT)) * 1024 + col);
                v[i] += *(const f32x4*)(pgate + col) * s;
                if (hstore) *(f32x4*)(hstore + (size_t)(row - NLAT) * 1024 + col) = v[i];
            }
        }
#pragma unroll
        for (int i = 0; i < 4; ++i) ss += v[i][0] * v[i][0] + v[i][1] * v[i][1] + v[i][2] * v[i][2] + v[i][3] * v[i][3];
#pragma unroll
        for (int o = 32; o >= 1; o >>= 1) ss += __shfl_xor(ss, o);
        const float rinv = rsqrtf(ss * (1.0f / 1024.0f) + 1e-6f);
#pragma unroll
        for (int i = 0; i < 4; ++i) {
            const int col = i * 256 + lane * 4; const f32x4 gv = *(const f32x4*)(ng + col); f32x4 y;
            if (MODE == 2) {
#pragma unroll
                for (int j = 0; j < 4; ++j) y[j] = v[i][j] * rinv * gv[j];
                *(f32x4*)(dstf + (size_t)row * 1024 + col) = y;
            } else {
                const f32x4 sh = *(const f32x4*)(mods_l + (size_t)mr * 6144 + sh_idx * 1024 + col), sc = *(const f32x4*)(mods_l + (size_t)mr * 6144 + sc_idx * 1024 + col);
#pragma unroll
                for (int j = 0; j < 4; ++j) y[j] = v[i][j] * rinv * gv[j] * (1.0f + sc[j]) + sh[j];
                u32x2 w; w.x = cvt_pk_bf16(y[0], y[1]); w.y = cvt_pk_bf16(y[2], y[3]);
                if (MODE == 0) *(u32x2*)(dstb + (size_t)row * 1024 + col) = w;
                else {
                    int lrow, s;
                    if (row < NLAT) { const int b = row >> 12, t = row & 4095; lrow = b * 256 + (t >> 4); s = t & 15; } else { const int r2 = row - NLAT, b = r2 >> 8, t = r2 & 255; lrow = 1024 + b * 16 + (t >> 4); s = t & 15; }
                    const int g = col >> 4, h2 = col & 15;
                    *(u32x2*)(dstb + ((size_t)g * GROWS + lrow) * 512 + s * 16 + h2) = w;
                }
            }
        }
    }
}

struct AttnFr { bf16x8 k[4]; bf16x8 v[4]; };
__device__ __forceinline__ void attn_load(AttnFr& f, const bf16_t* kp, const bf16_t* vp) {
#pragma unroll
    for (int kk = 0; kk < 4; ++kk) f.k[kk] = *(const bf16x8*)(kp + 16 * kk);
#pragma unroll
    for (int q = 0; q < 4; ++q) f.v[q] = *(const bf16x8*)(vp + q * 512);
}

__device__ __forceinline__ void attn_item(const Params& p, int item) {
    const int lane = otid() & 63, r = lane & 31, h = lane >> 5;
    const bf16_t* Q = (const bf16_t*)(p.ws + O_Q); const bf16_t* Kb = (const bf16_t*)(p.ws + O_K);
    const bf16_t* VT = (const bf16_t*)(p.ws + O_VT); const bf16_t* VTc = (const bf16_t*)(p.ws + O_VTC);
    bf16_t* MIX = (bf16_t*)(p.ws + O_MIX);
    int b, qt, hq, tok0, q0, ntile; bool isctx;
    if (item < 4096) { isctx = false; b = item >> 10; qt = (item >> 3) & 127; hq = item & 7; q0 = qt * 32; tok0 = b * 4096 + q0; ntile = 17; }
    else { const int it = item - 4096; isctx = true; b = it >> 6; qt = (it >> 3) & 7; hq = it & 7; q0 = qt * 32; tok0 = NLAT + b * 256 + q0; ntile = 8; }
    const int kvh = hq >> 2;
    bf16x8 qf[4];
    { const bf16_t* qp = Q + (size_t)(tok0 + r) * 512 + hq * 64 + h * 8;
#pragma unroll
      for (int kk = 0; kk < 4; ++kk) qf[kk] = *(const bf16x8*)(qp + 16 * kk); }
    float mrun = p.sink[hq] * 1.4426950408889634f, lrun = 1.0f;
    f32x16 o0, o1;
#pragma unroll
    for (int i = 0; i < 16; ++i) { o0[i] = 0.f; o1[i] = 0.f; }
    const int qpos = q0 + r;
    auto tile_ptrs = [&](int ti, const bf16_t*& kp, const bf16_t*& vp) {
        if (ti < 8) { kp = Kb + (size_t)(NLAT + b * 256 + 32 * ti + r) * 128 + kvh * 64 + h * 8; vp = VTc + (size_t)((b * 2 + kvh) * 8 + ti) * 2048 + lane * 8; }
        else { const int kbase = q0 - 128 + 32 * (ti - 8); const int kc = kbase < 0 ? 0 : (kbase > 4064 ? 4064 : kbase);
               kp = Kb + (size_t)(b * 4096 + kc + r) * 128 + kvh * 64 + h * 8; vp = VT + (size_t)((b * 2 + kvh) * 128 + (kc >> 5)) * 2048 + lane * 8; }
    };
    AttnFr cur, nxt;
    { const bf16_t *kp, *vp; tile_ptrs(0, kp, vp); attn_load(cur, kp, vp); }
    for (int ti = 0; ti < ntile; ++ti) {
        if (ti + 1 < ntile) { const bf16_t *kp, *vp; tile_ptrs(ti + 1, kp, vp); attn_load(nxt, kp, vp); }
        f32x16 s;
#pragma unroll
        for (int i = 0; i < 16; ++i) s[i] = 0.f;
#pragma unroll
        for (int kk = 0; kk < 4; ++kk) s = __builtin_amdgcn_mfma_f32_32x32x16_bf16(cur.k[kk], qf[kk], s, 0, 0, 0);
        if (ti >= 8) {
            const int kbase = q0 - 128 + 32 * (ti - 8);
            if (ti == 8 || ti == 16 || kbase < 0 || kbase > 4064) {
#pragma unroll
                for (int i = 0; i < 16; ++i) { const int kpos = kbase + (i & 3) + 8 * (i >> 2) + 4 * h; const int d = kpos - qpos; const bool ok = (kpos >= 0) && (kpos < 4096) && (d <= 128) && (d >= -128); s[i] = ok ? s[i] : -1e30f; }
            }
        }
        float mx = s[0];
#pragma unroll
        for (int i = 1; i < 16; ++i) mx = fmaxf(mx, s[i]);
        mx = fmaxf(mx, __shfl_xor(mx, 32));
        const float mnew = fmaxf(mrun, mx), alpha = __builtin_amdgcn_exp2f(mrun - mnew);
        float ps = 0.f; float pv[16];
#pragma unroll
        for (int i = 0; i < 16; ++i) { pv[i] = __builtin_amdgcn_exp2f(s[i] - mnew); ps += pv[i]; }
        ps += __shfl_xor(ps, 32);
        lrun = lrun * alpha + ps;
        if (__builtin_amdgcn_ballot_w64(mnew != mrun) != 0ull) {
#pragma unroll
            for (int i = 0; i < 16; ++i) { o0[i] *= alpha; o1[i] *= alpha; }
        }
        mrun = mnew;
        bf16x8 pf[2];
#pragma unroll
        for (int sidx = 0; sidx < 2; ++sidx) { u32x4 w; w.x = cvt_pk_bf16(pv[8 * sidx + 0], pv[8 * sidx + 1]); w.y = cvt_pk_bf16(pv[8 * sidx + 2], pv[8 * sidx + 3]); w.z = cvt_pk_bf16(pv[8 * sidx + 4], pv[8 * sidx + 5]); w.w = cvt_pk_bf16(pv[8 * sidx + 6], pv[8 * sidx + 7]); pf[sidx] = __builtin_bit_cast(bf16x8, w); }
#pragma unroll
        for (int sidx = 0; sidx < 2; ++sidx) {
            o0 = __builtin_amdgcn_mfma_f32_32x32x16_bf16(cur.v[sidx], pf[sidx], o0, 0, 0, 0);
            o1 = __builtin_amdgcn_mfma_f32_32x32x16_bf16(cur.v[2 + sidx], pf[sidx], o1, 0, 0, 0);
        }
        cur = nxt;
    }
    const float inv = 1.0f / lrun;
    bf16_t* op = MIX + (size_t)(tok0 + r) * 1024 + 512 + hq * 64;
#pragma unroll
    for (int rg = 0; rg < 4; ++rg) {
        const int d0 = 8 * rg + 4 * h;
        u32x2 w0, w1;
        w0.x = cvt_pk_bf16(o0[4 * rg] * inv, o0[4 * rg + 1] * inv); w0.y = cvt_pk_bf16(o0[4 * rg + 2] * inv, o0[4 * rg + 3] * inv);
        w1.x = cvt_pk_bf16(o1[4 * rg] * inv, o1[4 * rg + 1] * inv); w1.y = cvt_pk_bf16(o1[4 * rg + 2] * inv, o1[4 * rg + 3] * inv);
        *(u32x2*)(op + d0) = w0; *(u32x2*)(op + 32 + d0) = w1;
    }
}


__device__ __forceinline__ void phase_dft_combine(const Params& p, LAS float* L) {
    const int tid = otid(); const int G = gridDim.x, bx = obid();
    const bf16_t* I2 = (const bf16_t*)(p.ws + O_I2); bf16_t* MIX = (bf16_t*)(p.ws + O_MIX);
    constexpr float C16[16] = {1.0f, 0.92387953251f, 0.70710678119f, 0.38268343237f, 0.0f, -0.38268343237f, -0.70710678119f, -0.92387953251f, -1.0f, -0.92387953251f, -0.70710678119f, -0.38268343237f, 0.0f, 0.38268343237f, 0.70710678119f, 0.92387953251f};
    constexpr float S16[16] = {0.0f, 0.38268343237f, 0.70710678119f, 0.92387953251f, 1.0f, 0.92387953251f, 0.70710678119f, 0.38268343237f, 0.0f, -0.38268343237f, -0.70710678119f, -0.92387953251f, -1.0f, -0.92387953251f, -0.70710678119f, -0.38268343237f};
    for (int pair = bx; pair < 1024; pair += G) {
        const int b = pair >> 8, kp = pair & 255;
        __syncthreads();
        if (tid < 16) { float s, c; sincospif((float)(kp * tid) / 2048.0f, &s, &c); L[tid] = c; L[16 + tid] = s; }
        __syncthreads();
        const int c = tid;
        const u32x4* pr = (const u32x4*)(I2 + (size_t)kp * 32768 + (size_t)(b * 512 + c) * 16);
        const u32x4* pi = (const u32x4*)(I2 + (size_t)(256 + kp) * 32768 + (size_t)(b * 512 + c) * 16);
        const u32x4 r0 = pr[0], r1 = pr[1], i0 = pi[0], i1 = pi[1];
        const unsigned rw[8] = {r0.x, r0.y, r0.z, r0.w, r1.x, r1.y, r1.z, r1.w}, iw[8] = {i0.x, i0.y, i0.z, i0.w, i1.x, i1.y, i1.z, i1.w};
        float xr[16], xi[16];
#pragma unroll
        for (int r = 0; r < 16; ++r) {
            const float ire = __uint_as_float((r & 1) ? (rw[r >> 1] & 0xFFFF0000u) : (rw[r >> 1] << 16));
            const float iim = __uint_as_float((r & 1) ? (iw[r >> 1] & 0xFFFF0000u) : (iw[r >> 1] << 16));
            const float ct = L[r], st = L[16 + r];
            xr[r] = ire * ct + iim * st; xi[r] = iim * ct - ire * st;
        }
#pragma unroll
        for (int j = 0; j < 16; ++j) {
            float y = 0.f;
#pragma unroll
            for (int r = 0; r < 16; ++r) y += xr[r] * C16[(j * r) & 15] + xi[r] * S16[(j * r) & 15];
            MIX[(size_t)(b * 4096 + kp + 256 * j) * 1024 + c] = f2bf(y * (1.0f / 512.0f));
        }
    }
}

__device__ __forceinline__ void phase_scan(const Params& p, unsigned* gcnt, unsigned* tmo) {
    const int tid_ = otid(); const int lane = tid_ & 63, wave = tid_ >> 6;
    const bf16_t* S = (const bf16_t*)(p.ws + O_S); bf16_t* A2 = (bf16_t*)(p.ws + O_A2);
    const int nitems = 512;
    for (int item = obid() + gridDim.x * wave; item < nitems; item += gridDim.x * 8) {
        const int b = item >> 7, g = (item >> 1) & 63, dir = item & 1, pp = lane;
        if (gcnt) {
            if (lane == 0) { unsigned sp = 0; while (__hip_atomic_load(gcnt + 64 * g, __ATOMIC_RELAXED, __HIP_MEMORY_SCOPE_AGENT) < 5u) { __builtin_amdgcn_s_sleep(2);
                if ((++sp & 1023u) == 0u) { if (__hip_atomic_load(tmo, __ATOMIC_RELAXED, __HIP_MEMORY_SCOPE_AGENT) != 0u) break; if (sp > (1u << 22)) { atomicAdd(tmo, 1u); break; } } } }
            __builtin_amdgcn_fence(__ATOMIC_ACQUIRE, "agent");
        }
        const float dt = expf(p.log_dt[dir * 64 + g]);
        const float are = p.a_re[(dir * 64 + g) * 64 + pp], aim = p.a_im[(dir * 64 + g) * 64 + pp];
        const float mag = expf(are * dt * 16.0f); float sn, cs; sincosf(aim * dt * 16.0f, &sn, &cs);
        const float ar = mag * cs, ai = mag * sn;
        float hr = 0.f, hi = 0.f;
        const bf16_t* Sg = S + (size_t)g * SROWS * 256 + dir * 128 + pp;
        bf16_t* Ag = A2 + (size_t)g * GROWS * 512 + 256 + dir * 128 + pp;
        for (int i = 0; i < 16; ++i) {
            const int ch = dir ? 15 - i : i; const size_t lrow = 1024 + b * 16 + ch;
            const float sr = __uint_as_float((unsigned)Sg[lrow * 256] << 16), si = __uint_as_float((unsigned)Sg[lrow * 256 + 64] << 16);
            const float nr = ar * hr - ai * hi + sr, ni = ar * hi + ai * hr + si; hr = nr; hi = ni;
        }
        for (int i0 = 0; i0 < 256; i0 += 8) {
            float sr[8], si[8];
#pragma unroll
            for (int j = 0; j < 8; ++j) { const int ch = dir ? 255 - (i0 + j) : (i0 + j); const size_t lrow = b * 256 + ch; sr[j] = __uint_as_float((unsigned)Sg[lrow * 256] << 16); si[j] = __uint_as_float((unsigned)Sg[lrow * 256 + 64] << 16); }
#pragma unroll
            for (int j = 0; j < 8; ++j) {
                const int ch = dir ? 255 - (i0 + j) : (i0 + j); const size_t lrow = b * 256 + ch;
                Ag[lrow * 512] = f2bf(hr); Ag[lrow * 512 + 64] = f2bf(hi);
                const float nr = ar * hr - ai * hi + sr[j], ni = ar * hi + ai * hr + si[j]; hr = nr; hi = ni;
            }
        }
    }
}


#define XB_TMO      128
#define XB_XCNT(j)  (256  + 64 * (j))
#define XB_XSUB(j)  (1280 + 64 * (j))
#define XB_XGEN(j)  (2304 + 64 * (j))
#define XB_TOP      3328
#define XB_TOPGEN   3392
#define XCD_BAR_WORDS 3456
#define XB_SPIN_CAP (1u << 22)
__device__ __forceinline__ unsigned xb_ld(unsigned* p)              { return __hip_atomic_load(p, __ATOMIC_RELAXED, __HIP_MEMORY_SCOPE_AGENT); }
__device__ __forceinline__ unsigned xb_add(unsigned* p, unsigned v) { return __hip_atomic_fetch_add(p, v, __ATOMIC_RELAXED, __HIP_MEMORY_SCOPE_AGENT); }
__device__ __forceinline__ unsigned xb_xcc_id() { return (unsigned)__builtin_amdgcn_s_getreg((3 << 11) | 20) & 0xFu; }
#define XB_SPIN(cond, bar) do { unsigned _sp = 0; while (cond) { __builtin_amdgcn_s_sleep(1); \
    if ((++_sp & 255u) == 0u) { if (xb_ld(&(bar)[XB_TMO])) break; if (_sp > XB_SPIN_CAP) { atomicAdd(&(bar)[XB_TMO], 1u); break; } } } } while (0)
__device__ __forceinline__ unsigned xcd_barrier_complete(unsigned* bar, unsigned x) {
    const unsigned G = gridDim.x;
    unsigned sum, cnt, mine, sp = 0u;
    for (;;) {
        sum = 0u; cnt = 0u; mine = 0u;
        for (unsigned j = 0; j < 16; ++j) { const unsigned c = xb_ld(&bar[XB_XCNT(j)]); sum += c; cnt += (c > 0u) ? 1u : 0u; mine = (j == x) ? c : mine; }
        if (sum == G) break;
        __builtin_amdgcn_s_sleep(1);
        if ((++sp & 255u) == 0u) { if (xb_ld(&bar[XB_TMO])) break; if (sp > XB_SPIN_CAP) { atomicAdd(&bar[XB_TMO], 1u); break; } }
    }
    const unsigned nloc = mine > 0u ? mine : 1u, nx = cnt > 0u ? cnt : 1u;
    return nloc | (nx << 16);
}
__device__ __forceinline__ void xcd_barrier(unsigned* bar, volatile LAS unsigned* st) {
    asm volatile("s_waitcnt vmcnt(0)" ::: "memory");
    __syncthreads();
    if (threadIdx.x == 0) {
        __builtin_amdgcn_s_waitcnt(0);
        const unsigned x = xb_xcc_id();
        unsigned nloc = st[0], nx = st[1];
        if (nloc == 0u) { const unsigned pk = xcd_barrier_complete(bar, x); nloc = pk & 0xFFFFu; nx = pk >> 16; st[0] = nloc; st[1] = nx; }
        const unsigned old = xb_add(&bar[XB_XSUB(x)], 1u);
        const unsigned gen = old / nloc;
        if (old + 1u == (gen + 1u) * nloc) {
            __builtin_amdgcn_fence(__ATOMIC_RELEASE, "agent");
            asm volatile("s_waitcnt vmcnt(0)" ::: "memory");
            const unsigned og = xb_add(&bar[XB_TOP], 1u);
            const unsigned tg = og / nx;
            if (og + 1u == (tg + 1u) * nx) xb_add(&bar[XB_TOPGEN], 1u);
            else XB_SPIN(xb_ld(&bar[XB_TOPGEN]) == tg, bar);
            __builtin_amdgcn_fence(__ATOMIC_ACQUIRE, "agent");
            xb_add(&bar[XB_XGEN(x)], 1u);
            asm volatile("s_waitcnt vmcnt(0)" ::: "memory");
        } else {
            XB_SPIN(xb_ld(&bar[XB_XGEN(x)]) == gen, bar);
            __builtin_amdgcn_fence(__ATOMIC_ACQUIRE, "agent");
            asm volatile("s_waitcnt vmcnt(0)" ::: "memory");
        }
    }
    __syncthreads();
}

__global__ void __launch_bounds__(NT) fwd_megakernel(Params p) {
    extern __shared__ __attribute__((aligned(16))) unsigned char shm[];
    cg::grid_group grid = cg::this_grid();
    LAS unsigned char* lds = (LAS unsigned char*)shm;
    LAS float* L = (LAS float*)shm;
    unsigned char* ws = p.ws;
    const int G = gridDim.x;
    float* mods = (float*)(ws + O_MODS);
    float* hctx = (float*)(ws + O_HCTX);
    bf16_t* XN = (bf16_t*)(ws + O_XN);
    bf16_t* ACT = (bf16_t*)(ws + O_ACT);
    const float* mods1 = mods + 5 * 6144;
    unsigned* bar = (unsigned*)(ws + O_BAR);
    volatile LAS unsigned* bst = (volatile LAS unsigned*)(lds + pg8::STAGE_BYTES);
    if (threadIdx.x < 4) bst[threadIdx.x] = 0u;
    __syncthreads();
    if (threadIdx.x == 0) (void)xb_add(&bar[XB_XCNT(xb_xcc_id())], 1u);
#define GRID_BAR() xcd_barrier(bar, bst)

    {
    phase_p0(p, L, bar + 0, bst + 2);
    }
    grid.sync();
    {
    phase_norm<0>(p.x, p.ctx, NTOK, p.norm_g + 0, mods, 0, 1, XN, nullptr);
    }
    GRID_BAR();
    {
    const int bx = obid();
    {
        const bf16_t* WinA = (const bf16_t*)(ws + O_WINA);
        bf16_t *ZT = (bf16_t*)(ws + O_ZT), *ZTc = (bf16_t*)(ws + O_ZTC), *VT = (bf16_t*)(ws + O_VT), *VTc = (bf16_t*)(ws + O_VTC);
        { pg8::Gemm g1{WinA, XN, 1024, 1024, 16384}; pg8::Sched s1; s1.init(4, 64, G, bx, 3, 1024, 16384);
          EpiInA e1{ZT, ZTc, 0, 1}; pg8::gemm_phase(lds, g1, s1, e1); }
        { pg8::Gemm gb{XN, (const bf16_t*)(ws + O_WINB), 1024, 1024, 1024}; pg8::Sched sb; sb.init(68, 3, G, bx, 0, 1024, 1024);
          EpiInB eb{(bf16_t*)(ws + O_Q), (bf16_t*)(ws + O_K), (const float*)(ws + O_ROPE), (const float*)(ws + O_ROPE) + 1024, VT, VTc}; pg8::gemm_phase(lds, gb, sb, eb); }
        { pg8::Gemm g3{WinA, XN + (size_t)NLAT * 1024, 1024, 1024, 1024}; pg8::Sched s3; s3.init(4, 4, G, (bx + G - (204 % G)) % G, 0, 1024, 1024);
          EpiInA e3{ZT, ZTc, NLAT, 0}; pg8::gemm_phase(lds, g3, s3, e3); }
    }
    }
    GRID_BAR();
    {
    const int bx = obid();
    {
        { pg8::Gemm gd{(const bf16_t*)(ws + O_D256), (const bf16_t*)(ws + O_ZT), 512, 512, 512}; pg8::Sched sd; sd.init(2, 128, G, bx, 0, 512, 512);
          EpiI2 ed{(bf16_t*)(ws + O_I2)}; pg8::gemm_phase(lds, gd, sd, ed); }
        const int wv = bx * 8 + (otid() >> 6), nw = G * 8;
        for (int item = wv; item < 4352; item += nw) attn_item(p, item);
        __syncthreads();
        { pg8::Gemm gc{(const bf16_t*)(ws + O_DC), (const bf16_t*)(ws + O_ZTC), 512, 512, 512}; pg8::Sched sc; sc.init(1, 8, G, (bx + 8) % G, 0, 512, 512);
          EpiDft ec{(bf16_t*)(ws + O_MIX), 1}; pg8::gemm_phase(lds, gc, sc, ec); }
    }
    }
    GRID_BAR();
    phase_dft_combine(p, L);
    GRID_BAR();
    {
    const int bx = obid();
    {
        const bf16_t* MIX = (const bf16_t*)(ws + O_MIX);
        pg8::Gemm g{MIX, (const bf16_t*)(ws + O_WOUT), 1024, 1024, 1024}; pg8::Sched s; s.init(64, 4, G, bx, 0, 1024, 1024);
        if (G == 256) {
            EpiResNorm e{p.x, p.out, mods + 2 * 1024, p.norm_g + 1024, mods, XN, (float*)(ws + O_XSS), (unsigned*)(ws + O_PCNT) + 32, bar + XB_TMO};
            pg8::gemm_phase<EpiResNorm, true>(lds, g, s, e);
            __syncthreads();
        } else {
            EpiRes e{p.x, p.ctx, p.out, hctx, mods + 2 * 1024};
            pg8::gemm_phase(lds, g, s, e);
        }
        pg8::Gemm gc{MIX + (size_t)NLAT * 1024, (const bf16_t*)(ws + O_WOUT), 256, 1024, 1024}; pg8::Sched sc; sc.init(16, 4, G, bx, 2, 1024, 1024);
        EpiPart ec{(float*)(ws + O_XNP)};
        pg8::gemm_phase<EpiPart, false>(lds, gc, sc, ec);
    }
    }
    GRID_BAR();
    {
    phase_norm<0>(p.out, p.ctx, NTOK, p.norm_g + 1024, mods, 3, 4, XN, nullptr, (const float*)(ws + O_XNP), 4, mods + 4 * 6144 + 2 * 1024, hctx, G == 256 ? NLAT : 0);
    }
    GRID_BAR();
    {
    const int bx = obid();
    {
        pg8::Gemm g{XN, (const bf16_t*)(ws + O_WGU0), 1024, 1024, 1024}; pg8::Sched s; s.init(68, 22, G, bx, 0, 1024, 1024);
        EpiSwiglu e{ACT};
        pg8::gemm_phase(lds, g, s, e);
    }
    }
    GRID_BAR();
    {
    const int bx = obid();
    {
        pg8::Gemm g{ACT, (const bf16_t*)(ws + O_WD0), FF, FF, FF}; pg8::Sched s; s.init(64, 4, G, bx, 0, FF, FF);
        EpiRes e{p.out, hctx, p.out, hctx, mods + 5 * 1024};
        pg8::gemm_phase(lds, g, s, e);
        pg8::Gemm gc{ACT + (size_t)NLAT * FF, (const bf16_t*)(ws + O_WD0), 256, FF, FF}; pg8::Sched sc; sc.init(16, 11, G, bx, 2, FF, FF);
        EpiPart ec{(float*)(ws + O_PART)};
        pg8::gemm_phase<EpiPart, false>(lds, gc, sc, ec);
    }
    }
    GRID_BAR();
    {
    phase_norm<1>(p.out, hctx, NTOK, p.norm_g + 2048, mods1, 0, 1, (bf16_t*)(ws + O_A2), nullptr, (const float*)(ws + O_PART), 11, mods + 4 * 6144 + 5 * 1024, nullptr);
    }
    GRID_BAR();
    {
    const int bx = obid();
    {
        pg8::Gemm g{(const bf16_t*)(ws + O_A2), (const bf16_t*)(ws + O_WST), 256, 512, 256}; pg8::Sched s; s.init(5, 64, G, bx, 1, 512, 256);
        EpiState e{(bf16_t*)(ws + O_S)};
        pg8::gemm_phase<EpiState, false>(lds, g, s, e);
        unsigned* gcnt = (unsigned*)(ws + O_PCNT) + 48;
        asm volatile("s_waitcnt vmcnt(0)" ::: "memory");
        __syncthreads();
        if (threadIdx.x == 0) {
            __builtin_amdgcn_fence(__ATOMIC_RELEASE, "agent");
            asm volatile("s_waitcnt vmcnt(0)" ::: "memory");
            for (int L = bx; L < 320; L += G) (void)__hip_atomic_fetch_add(gcnt + 64 * (L / 5), 1u, __ATOMIC_RELAXED, __HIP_MEMORY_SCOPE_AGENT);
        }
        phase_scan(p, gcnt, bar + XB_TMO);
    }
    }
    GRID_BAR();
    {
    const int bx = obid();
    {
        pg8::Gemm g{(const bf16_t*)(ws + O_A2), (const bf16_t*)(ws + O_TT), 512, 512, 512}; pg8::Sched s; s.init(4, 64, G, bx, 1, 512, 512);
        EpiSout e{(bf16_t*)(ws + O_GY)};
        pg8::gemm_phase(lds, g, s, e);
    }
    }
    GRID_BAR();
    {
    const int bx = obid();
    {
        pg8::Gemm g{(const bf16_t*)(ws + O_GY), (const bf16_t*)(ws + O_GLU), 1024, 1024, 1024};
        if (G == 256) {
            EpiGluNorm e{p.out, mods1 + 2 * 1024, p.norm_g + 3072, mods1, XN, (float*)(ws + O_S), (unsigned*)(ws + O_PCNT) + 16, bar + XB_TMO};
            pg8::Sched s; s.init(64, 8, G, bx, 4, 1024, 1024); s.nwg = 256;
            pg8::gemm_phase<EpiGluNorm, true>(lds, g, s, e);
            __syncthreads();
            pg8::Sched s2; s2.init(64, 8, G, bx, 4, 1024, 1024); s2.base = 256;
            pg8::gemm_phase<EpiGluNorm, true>(lds, g, s2, e);
        } else {
            pg8::Sched s; s.init(64, 8, G, bx, 0, 1024, 1024);
            EpiGlu e{p.out, mods1 + 2 * 1024};
            pg8::gemm_phase(lds, g, s, e);
        }
    }
    }
    GRID_BAR();
    if (G != 256) {
    phase_norm<0>(p.out, hctx, NLAT, p.norm_g + 3072, mods1, 3, 4, XN, nullptr);
    GRID_BAR();
    }
    {
    const int bx = obid();
    {
        pg8::Gemm g{XN, (const bf16_t*)(ws + O_WGU1), 1024, 1024, 1024}; pg8::Sched s; s.init(64, 22, G, bx, 0, 1024, 1024);
        EpiSwiglu e{ACT};
        pg8::gemm_phase(lds, g, s, e);
    }
    }
    GRID_BAR();
    {
    const int bx = obid();
    {
        pg8::Gemm g{ACT, (const bf16_t*)(ws + O_WD1), FF, FF, FF}; pg8::Sched s; s.init(64, 4, G, bx, 0, FF, FF);
        if (G == 256) {
            EpiResFinal e{p.out, p.out, mods1 + 5 * 1024, p.final_g, (float*)(ws + O_XSS), (unsigned*)(ws + O_PCNT), bar + XB_TMO};
            pg8::gemm_phase<EpiResFinal, true>(lds, g, s, e);
        } else {
            EpiRes e{p.out, hctx, p.out, hctx, mods1 + 5 * 1024};
            pg8::gemm_phase(lds, g, s, e);
        }
    }
    }
    if (G != 256) {
    GRID_BAR();
    phase_norm<2>(p.out, hctx, NLAT, p.final_g, nullptr, 0, 0, nullptr, p.out);
    }
}

extern "C" void kernel_launch(void* const* d_in, const int* in_sizes, int n_in, void* d_out, int out_size, void* d_ws, size_t ws_size, hipStream_t stream) {
    constexpr int kLds = pg8::STAGE_BYTES + 16;
    static int grid_blocks = 0;
    if (grid_blocks == 0) {
        if (n_in != 23 || ws_size < WS_NEED) { fprintf(stderr, "kernel_launch: unexpected n_in %d or workspace %zu < %zu\n", n_in, ws_size, (size_t)WS_NEED); grid_blocks = -1; return; }
        int dev = 0, cus = 0, per_cu = 0;
        hipGetDevice(&dev);
        hipDeviceGetAttribute(&cus, hipDeviceAttributeMultiprocessorCount, dev);
        hipFuncSetAttribute((const void*)fwd_megakernel, hipFuncAttributeMaxDynamicSharedMemorySize, kLds);
        hipOccupancyMaxActiveBlocksPerMultiprocessor(&per_cu, (const void*)fwd_megakernel, NT, kLds);
        if (per_cu < 1) { fprintf(stderr, "kernel_launch: occupancy query says %d blocks/CU\n", per_cu); per_cu = 1; }
        grid_blocks = cus;
        (void)hipGetLastError();
    }
    if (grid_blocks < 0) return;
    if (hipMemsetAsync((char*)d_ws + O_BAR, 0, 16384 + 64 * 256, stream) != hipSuccess) { fprintf(stderr, "kernel_launch: memset of barrier words failed\n"); return; }
    Params p{};
    p.x = (const float*)d_in[0]; p.c = (const float*)d_in[1]; p.ctx = (const float*)d_in[2]; p.c_ctx = (const float*)d_in[3];
    p.mod_w = (const float*)d_in[4]; p.mod_b = (const float*)d_in[5]; p.norm_g = (const float*)d_in[6];
    p.ffn_g = (const float*)d_in[7]; p.ffn_u = (const float*)d_in[8]; p.ffn_d = (const float*)d_in[9];
    p.w_in = (const float*)d_in[10]; p.w_out = (const float*)d_in[11]; p.sink = (const float*)d_in[12];
    p.a_re = (const float*)d_in[13]; p.a_im = (const float*)d_in[14]; p.log_dt = (const float*)d_in[15];
    p.b_re = (const float*)d_in[16]; p.b_im = (const float*)d_in[17]; p.c_re = (const float*)d_in[18]; p.c_im = (const float*)d_in[19];
    p.ssm_d = (const float*)d_in[20]; p.glu_w = (const float*)d_in[21]; p.final_g = (const float*)d_in[22];
    p.out = (float*)d_out; p.ws = (unsigned char*)d_ws;
    void* args[] = {&p};
    hipError_t e = hipLaunchCooperativeKernel((const void*)fwd_megakernel, dim3(grid_blocks), dim3(NT), args, kLds, stream);
    if (e != hipSuccess) fprintf(stderr, "cooperative launch failed: %s (grid %d)\n", hipGetErrorString(e), grid_blocks);
}
```

```cpp
#include <hip/hip_runtime.h>
#include <hip/hip_cooperative_groups.h>
#include <cstdio>
namespace cg = cooperative_groups;

#define LAS __attribute__((address_space(3)))
typedef unsigned short bf16_t;
typedef short bf16x8 __attribute__((ext_vector_type(8)));
typedef float f32x4 __attribute__((ext_vector_type(4)));
typedef float f32x16 __attribute__((ext_vector_type(16)));
typedef unsigned u32x4 __attribute__((ext_vector_type(4)));
typedef unsigned u32x2 __attribute__((ext_vector_type(2)));

constexpr int NT = 512;
constexpr int DM_ = 1024, SEQ_ = 4096, NB_ = 4, CTXL = 256, FF = 2816;
constexpr int NLAT = NB_ * SEQ_;
constexpr int NCTX = NB_ * CTXL;
constexpr int NTOK = NLAT + NCTX;
constexpr int GROWS = 1088;
constexpr int SROWS = 1280;

constexpr size_t MiB = 1u << 20;
constexpr size_t O_WINA = 0;
constexpr size_t O_WINB = O_WINA + 1280ull * 1024 * 2;
constexpr size_t O_WOUT = O_WINB + 768ull * 1024 * 2;
constexpr size_t O_WGU0 = O_WOUT + 1024ull * 1024 * 2;
constexpr size_t O_WD0 = O_WGU0 + 5632ull * 1024 * 2;
constexpr size_t O_WGU1 = O_WD0 + 1024ull * 2816 * 2;
constexpr size_t O_WD1 = O_WGU1 + 5632ull * 1024 * 2;
constexpr size_t O_GLU = O_WD1 + 1024ull * 2816 * 2;
constexpr size_t O_WST = O_GLU + 2048ull * 1024 * 2;
constexpr size_t O_TT = O_WST + 64ull * 256 * 256 * 2;
constexpr size_t O_MODS = O_TT + 64ull * 256 * 512 * 2;
constexpr size_t O_ROPE = O_MODS + 2ull * 5 * 6144 * 4;
constexpr size_t O_DC = O_ROPE + 2ull * 1024 * 4;
constexpr size_t O_HCTX = O_DC + 256ull * 512 * 2;
constexpr size_t O_VTC = O_HCTX + 1024ull * 1024 * 4;
constexpr size_t O_BAR = O_VTC + 4ull * 128 * 256 * 2;
constexpr size_t O_PCNT = O_BAR + 16384;
constexpr size_t O_D256 = O_PCNT + 64ull * 256;
constexpr size_t O_XSS = O_D256 + 512ull * 512 * 2;
constexpr size_t O_RA = 73 * MiB;
static_assert(O_XSS + 16384ull * 4 * 4 <= O_RA, "R_W overflow");
constexpr size_t O_XN = O_RA;
constexpr size_t O_MIX = O_RA + 34 * MiB;
constexpr size_t O_I2 = O_RA + 68 * MiB;
constexpr size_t O_XNP = O_I2;
constexpr size_t O_ZT = O_RA + 100 * MiB;
constexpr size_t O_ZTC = O_RA + 132 * MiB;
constexpr size_t O_Q = O_RA + 134 * MiB;
constexpr size_t O_K = O_RA + 151 * MiB;
constexpr size_t O_VT = O_K + 17408ull * 128 * 2;
constexpr size_t O_ACT = O_RA + 34 * MiB;
constexpr size_t O_A2 = O_RA;
constexpr size_t O_S = O_RA + 69 * MiB;
constexpr size_t O_GY = O_RA + 149 * MiB;
constexpr size_t O_PART = O_RA + 128 * MiB;
constexpr size_t WS_NEED = O_RA + 181 * MiB;

struct Params {
    const float* x; const float* c; const float* ctx; const float* c_ctx; const float* mod_w; const float* mod_b; const float* norm_g;
    const float* ffn_g; const float* ffn_u; const float* ffn_d; const float* w_in; const float* w_out; const float* sink;
    const float* a_re; const float* a_im; const float* log_dt; const float* b_re; const float* b_im; const float* c_re; const float* c_im;
    const float* ssm_d; const float* glu_w; const float* final_g;
    float* out; unsigned char* ws;
};

__device__ __forceinline__ int otid() { int t = threadIdx.x; asm volatile("" : "+v"(t)); return t; }
__device__ __forceinline__ int obid() { int t = blockIdx.x; asm volatile("" : "+s"(t)); return t; }
__device__ __forceinline__ unsigned cvt_pk_bf16(float lo, float hi) { unsigned r; asm volatile("v_cvt_pk_bf16_f32 %0, %1, %2" : "=v"(r) : "v"(lo), "v"(hi)); return r; }
__device__ __forceinline__ bf16_t f2bf(float f) { unsigned u = __float_as_uint(f); u += 0x7FFFu + ((u >> 16) & 1u); return (bf16_t)(u >> 16); }
__device__ __forceinline__ float sigmoidf_(float v) { return __builtin_amdgcn_rcpf(1.0f + __builtin_amdgcn_exp2f(-1.4426950408889634f * v)); }
__device__ __forceinline__ float siluf_(float v) { return v * sigmoidf_(v); }
__device__ __forceinline__ float gelu_tanh(float v) { const float u = 0.7978845608028654f * (v + 0.044715f * v * v * v); return v * sigmoidf_(2.0f * u); }
__device__ __forceinline__ u32x4 pack8(const f32x4 a, const f32x4 b) { u32x4 w; w.x = cvt_pk_bf16(a[0], a[1]); w.y = cvt_pk_bf16(a[2], a[3]); w.z = cvt_pk_bf16(b[0], b[1]); w.w = cvt_pk_bf16(b[2], b[3]); return w; }

namespace pg8 {
constexpr int BM = 256, BK = 64, HALF = 128, HTB = HALF * BK * 2, STAGE_BYTES = 8 * HTB, NXCD = 8, WGM = 8;
__device__ __forceinline__ int lds_byte(int r, int c) { const int st = (r >> 4) * 2 + (c >> 5), rr = r & 15, cc = c & 31, ob = rr * 64 + cc * 2; return st * 1024 + (ob ^ (((ob >> 9) & 1) << 5)); }
__device__ __forceinline__ void stage_rc(int b, int& R, int& C) { const int st = b / 1024, sb = b % 1024, swz = sb ^ (((sb >> 9) & 1) << 5); R = (st >> 1) * 16 + swz / 64; C = (st & 1) * 32 + (swz % 64) / 2; }
__device__ __forceinline__ int perm32(int rho) { const int n = rho >> 4, i = rho & 15; return 8 * (i >> 2) + 4 * n + (i & 3); }

struct Unit { int arow, brow, pm, pn, kofs; size_t aoff, boff; };
struct Gemm { const bf16_t* A; const bf16_t* Bt; int K, lda, ldb; };

struct Sched {
    int nM, nN, nwg, G, c, mode, lda, ldb, base;
    __device__ void init(int nM_, int nN_, int G_, int c_, int mode_, int lda_, int ldb_) { nM = nM_; nN = nN_; nwg = nM_ * nN_; G = G_; c = c_; mode = mode_; lda = lda_; ldb = ldb_; base = 0; }
    __device__ bool next(int i, Unit& u) const {
        const long L = (long)base + (long)i * G + c; if (L >= nwg) return false;
        if (mode == 4) {
            { const int x = (int)L & 7, o = ((int)L & 255) >> 3; u.pm = ((int)L >> 8) * 32 + x * 4 + (o >> 3); u.pn = o & 7; }
            u.arow = u.pm * BM; u.brow = u.pn * BM; u.kofs = 0;
            u.aoff = (size_t)u.arow * lda; u.boff = (size_t)u.brow * ldb; return true;
        }
        if (mode == 0 || mode == 3) {
            int wgid = (int)L; { const int q = nwg / NXCD, r = nwg % NXCD, xcd = wgid % NXCD, off = wgid / NXCD; wgid = (xcd < r ? xcd * (q + 1) : r * (q + 1) + (xcd - r) * q) + off; }
            const int nig = WGM * nN, gid = wgid / nig, fm = gid * WGM, gsz = (nM - fm) < WGM ? (nM - fm) : WGM;
            u.pm = fm + ((wgid % nig) % gsz); u.pn = (wgid % nig) / gsz; u.arow = u.pm * BM; u.brow = u.pn * BM; u.kofs = 0;
        } else if (mode == 1) {
            const int g = (int)L / nM, mi = (int)L % nM; u.pm = mi; u.pn = g; u.arow = g * GROWS + mi * BM; u.brow = g * BM; u.kofs = 0;
        } else {
            const int tile = (int)L % nM, ks = (int)L / nM; u.pm = tile >> 2; u.pn = tile & 3; u.arow = u.pm * BM; u.brow = u.pn * BM; u.kofs = ks * 256;
        }
        u.aoff = (size_t)u.arow * lda + u.kofs;
        u.boff = (mode == 3) ? (size_t)((u.pn >> 4) * 4096 + (u.pn & 15)) * 1024 : (size_t)u.brow * ldb + u.kofs;
        return true;
    }
};

template <class T, class = void> struct epi_after_drain { static constexpr bool value = false; };
template <class T> struct epi_after_drain<T, decltype((void)T::AFTER_DRAIN)> { static constexpr bool value = T::AFTER_DRAIN; };
#ifndef GP_ALIGN
#define GP_ALIGN true
#endif
#ifndef GP_SP2
#define GP_SP2 true
#endif
template <class Epi, bool ALIGN_EPI = GP_ALIGN, bool SP2 = GP_SP2>
__device__ __forceinline__ void gemm_phase(LAS unsigned char* lds, const Gemm g, const Sched& S, const Epi& E) {
    const int tid = otid(), wid = __builtin_amdgcn_readfirstlane(tid >> 6), lane = tid & 63, wr = wid >> 2, wc = wid & 3, fr = lane & 15, fq = lane >> 4;
    const int K = g.K, nt = K / BK;
    unsigned voffA[2], voffB[2];
#pragma unroll
    for (int i = 0; i < 2; ++i) { int R, C; stage_rc(tid * 16 + i * 8192, R, C); const int Rb = (R & ~31) + perm32(R & 31);
        voffA[i] = (unsigned)(R * g.lda + C) * 2u; voffB[i] = (unsigned)(Rb * g.ldb + C) * 2u; }
    const size_t kstep = (size_t)(BK * 2);
    const size_t hstepA = (size_t)HALF * g.lda * 2, hstepB = (size_t)HALF * g.ldb * 2;
    const unsigned ldsw = (unsigned)wid * 1024u;
    const int aoff = lds_byte(wr * 64 + fr, fq * 8), boff = lds_byte(wc * 32 + fr, fq * 8);
#define PG8_SA(b, h) (((b) * 2 + (h)) * HTB)
#define PG8_SB(b, h) ((4 + (b) * 2 + (h)) * HTB)
#define PG8_STAGE(bufoff, gbase, voff) do { _Pragma("unroll") for (int _i = 0; _i < 2; ++_i) \
        __builtin_amdgcn_global_load_lds((const unsigned*)((const char*)(gbase) + (voff)[_i]), (LAS unsigned*)(lds + (bufoff) + ldsw + _i * 8192), 16, 0, 0); } while (0)
#define PG8_LDA(dst, b, h) do { _Pragma("unroll") for (int m = 0; m < 4; ++m) _Pragma("unroll") for (int k = 0; k < 2; ++k) dst[m][k] = *(const LAS bf16x8*)(lds + PG8_SA(b, h) + aoff + m * 2048 + k * 1024); } while (0)
#define PG8_LDB(dst, b, h) do { _Pragma("unroll") for (int n = 0; n < 2; ++n) _Pragma("unroll") for (int k = 0; k < 2; ++k) dst[n][k] = *(const LAS bf16x8*)(lds + PG8_SB(b, h) + boff + n * 2048 + k * 1024); } while (0)
#define PG8_MMA(ai, bj, At, Bt) do { __builtin_amdgcn_s_setprio(1); _Pragma("unroll") for (int m = 0; m < 4; ++m) _Pragma("unroll") for (int n = 0; n < 2; ++n) _Pragma("unroll") for (int k = 0; k < 2; ++k) \
        acc[ai][bj][m][n] = __builtin_amdgcn_mfma_f32_16x16x32_bf16(Bt[n][k], At[m][k], acc[ai][bj][m][n], 0, 0, 0); __builtin_amdgcn_s_setprio(0); } while (0)
#define PG8_WAIT_V(n) asm volatile("s_waitcnt vmcnt(" #n ")" ::: "memory")
#define PG8_WAIT_L(n) asm volatile("s_waitcnt lgkmcnt(" #n ")" ::: "memory")
#define PG8_BAR __builtin_amdgcn_s_barrier()
#define PG8_SCHED __builtin_amdgcn_sched_barrier(0)
    Unit cur, nxt; int ui = 0;
    if (!S.next(0, cur)) return;
    f32x4 acc[2][2][4][2];
#pragma unroll
    for (int a = 0; a < 2; ++a)
#pragma unroll
        for (int b = 0; b < 2; ++b)
#pragma unroll
            for (int m = 0; m < 4; ++m)
#pragma unroll
                for (int n = 0; n < 2; ++n) acc[a][b][m][n] = (f32x4){0.f, 0.f, 0.f, 0.f};
    bf16x8 At[4][2], B0[2][2], B1[2][2];
    const char* cA = (const char*)g.A + cur.aoff * 2; const char* cB = (const char*)g.Bt + cur.boff * 2;
    if constexpr (SP2) {
        PG8_STAGE(PG8_SB(0, 0), cB, voffB); PG8_STAGE(PG8_SB(0, 1), cB + hstepB, voffB); PG8_STAGE(PG8_SA(0, 0), cA, voffA); PG8_STAGE(PG8_SA(0, 1), cA + hstepA, voffA);
        if (wr == 1) PG8_BAR;
        PG8_WAIT_V(2); PG8_BAR;
        PG8_STAGE(PG8_SB(1, 0), cB + kstep, voffB); PG8_STAGE(PG8_SA(1, 0), cA + kstep, voffA); PG8_STAGE(PG8_SB(1, 1), cB + hstepB + kstep, voffB);
        PG8_WAIT_V(6); PG8_BAR;
    } else {
        PG8_STAGE(PG8_SB(0, 0), cB, voffB); PG8_STAGE(PG8_SA(0, 0), cA, voffA); PG8_STAGE(PG8_SB(0, 1), cB + hstepB, voffB); PG8_STAGE(PG8_SA(0, 1), cA + hstepA, voffA);
        if (wr == 1) PG8_BAR;
        PG8_WAIT_V(4); PG8_BAR;
        PG8_STAGE(PG8_SB(1, 0), cB + kstep, voffB); PG8_STAGE(PG8_SA(1, 0), cA + kstep, voffA); PG8_STAGE(PG8_SB(1, 1), cB + hstepB + kstep, voffB);
        PG8_WAIT_V(6); PG8_BAR;
    }
    for (;;) {
        const bool has_next = S.next(ui + 1, nxt);
        const char* nA = has_next ? (const char*)g.A + nxt.aoff * 2 : cA; const char* nB = has_next ? (const char*)g.Bt + nxt.boff * 2 : cB;
        for (int t = 0; t < nt; t += 2) {
            const bool last = (t == nt - 2);
            const char* a1 = cA + (size_t)(t + 1) * kstep;
            const char* a2 = last ? nA : cA + (size_t)(t + 2) * kstep; const char* b2 = last ? nB : cB + (size_t)(t + 2) * kstep;
            const char* a3 = a2 + kstep; const char* b3 = b2 + kstep;
            if constexpr (SP2) {
            PG8_LDB(B0, 0, 0); PG8_LDB(B1, 0, 1); PG8_SCHED; PG8_LDA(At, 0, 0); PG8_STAGE(PG8_SA(1, 1), a1 + hstepA, voffA);
            PG8_WAIT_V(8); PG8_WAIT_L(0); PG8_BAR; PG8_MMA(0, 0, At, B0); PG8_MMA(0, 1, At, B1); PG8_BAR; PG8_SCHED;
            PG8_LDA(At, 0, 1); PG8_STAGE(PG8_SB(0, 0), b2, voffB); PG8_STAGE(PG8_SB(0, 1), b2 + hstepB, voffB); PG8_STAGE(PG8_SA(0, 0), a2, voffA);
            PG8_WAIT_V(8); PG8_WAIT_L(0); PG8_BAR; PG8_MMA(1, 0, At, B0); PG8_MMA(1, 1, At, B1); PG8_BAR; PG8_SCHED;
            PG8_LDB(B0, 1, 0); PG8_LDB(B1, 1, 1); PG8_SCHED; PG8_LDA(At, 1, 0); PG8_STAGE(PG8_SA(0, 1), a2 + hstepA, voffA);
            PG8_WAIT_V(8); PG8_WAIT_L(0); PG8_BAR; PG8_MMA(0, 0, At, B0); PG8_MMA(0, 1, At, B1); PG8_BAR; PG8_SCHED;
            PG8_LDA(At, 1, 1); PG8_STAGE(PG8_SB(1, 0), b3, voffB); PG8_STAGE(PG8_SB(1, 1), b3 + hstepB, voffB); PG8_STAGE(PG8_SA(1, 0), a3, voffA);
            PG8_WAIT_V(8); PG8_WAIT_L(0); PG8_BAR; PG8_MMA(1, 0, At, B0); PG8_MMA(1, 1, At, B1); PG8_BAR; PG8_SCHED;
            } else {
            PG8_LDB(B0, 0, 0); PG8_SCHED; PG8_LDA(At, 0, 0); PG8_STAGE(PG8_SA(1, 1), a1 + hstepA, voffA);
            PG8_WAIT_L(8); PG8_BAR; PG8_WAIT_L(0); PG8_MMA(0, 0, At, B0); PG8_BAR; PG8_SCHED;
            PG8_LDB(B1, 0, 1); PG8_STAGE(PG8_SB(0, 0), b2, voffB);
            PG8_BAR; PG8_WAIT_L(0); PG8_MMA(0, 1, At, B1); PG8_BAR;
            PG8_LDA(At, 0, 1); PG8_STAGE(PG8_SA(0, 0), a2, voffA);
            PG8_BAR; PG8_WAIT_L(0); PG8_MMA(1, 0, At, B0); PG8_BAR; PG8_SCHED;
            PG8_STAGE(PG8_SB(0, 1), b2 + hstepB, voffB);
            PG8_WAIT_V(6); PG8_BAR; PG8_MMA(1, 1, At, B1); PG8_BAR;
            PG8_LDB(B0, 1, 0); PG8_SCHED; PG8_LDA(At, 1, 0); PG8_STAGE(PG8_SA(0, 1), a2 + hstepA, voffA);
            PG8_WAIT_L(8); PG8_BAR; PG8_WAIT_L(0); PG8_MMA(0, 0, At, B0); PG8_BAR; PG8_SCHED;
            PG8_LDB(B1, 1, 1); PG8_STAGE(PG8_SB(1, 0), b3, voffB);
            PG8_BAR; PG8_WAIT_L(0); PG8_MMA(0, 1, At, B1); PG8_BAR;
            PG8_LDA(At, 1, 1); PG8_STAGE(PG8_SA(1, 0), a3, voffA);
            PG8_BAR; PG8_WAIT_L(0); PG8_MMA(1, 0, At, B0); PG8_BAR; PG8_SCHED;
            PG8_STAGE(PG8_SB(1, 1), b3 + hstepB, voffB);
            PG8_WAIT_V(6); PG8_BAR; PG8_MMA(1, 1, At, B1); PG8_BAR;
                    }
        }
        if constexpr (ALIGN_EPI) { if (wr == 0) PG8_BAR; }
        if constexpr (!epi_after_drain<Epi>::value) E(acc, cur, wr, wc, fr, fq);
        if (!has_next) break;
#pragma unroll
        for (int a = 0; a < 2; ++a)
#pragma unroll
            for (int b = 0; b < 2; ++b)
#pragma unroll
                for (int m = 0; m < 4; ++m)
#pragma unroll
                    for (int n = 0; n < 2; ++n) acc[a][b][m][n] = (f32x4){0.f, 0.f, 0.f, 0.f};
        cur = nxt; cA = nA; cB = nB; ++ui;
        if constexpr (ALIGN_EPI) { if (wr == 1) PG8_BAR; }
    }
    PG8_WAIT_V(0);
    if constexpr (!ALIGN_EPI) { if (wr == 0) PG8_BAR; }
    PG8_BAR;
    if constexpr (epi_after_drain<Epi>::value) E.fused(acc, cur, wr, wc, fr, fq, lds, wid, lane);
#undef PG8_SA
#undef PG8_SB
#undef PG8_STAGE
#undef PG8_LDA
#undef PG8_LDB
#undef PG8_MMA
#undef PG8_WAIT_V
#undef PG8_WAIT_L
#undef PG8_BAR
#undef PG8_SCHED
}
}
using pg8::Unit;
typedef f32x4 Acc[2][2][4][2];

struct EpiInA {
    bf16_t *ZT, *ZTc; int tk0, perm;
    __device__ __forceinline__ void operator()(const Acc& acc, const Unit& u, int wr, int wc, int fr, int fq) const {
#pragma unroll
        for (int ai = 0; ai < 2; ++ai)
#pragma unroll
            for (int m = 0; m < 4; ++m) {
                const int r = u.arow + ai * 128 + wr * 64 + m * 16 + fr;
                const int c = r & 511, cs = r >> 9;
#pragma unroll
                for (int bj = 0; bj < 2; ++bj) {
                    const int tk = tk0 + u.brow + bj * 128 + wc * 32 + fq * 8;
                    bf16_t* dst;
                    if (perm) { const int b = tk >> 12, rr = (tk >> 8) & 15, tp = tk & 255; dst = ZT + ((size_t)((b * 512 + c) * 16 + rr) * 512 + cs * 256 + tp); }
                    else { const int b = (tk - NLAT) >> 8, t = tk & 255; dst = ZTc + ((size_t)(b * 512 + c) * 512 + cs * 256 + t); }
                    *(u32x4*)dst = pack8(acc[ai][bj][m][0], acc[ai][bj][m][1]);
                }
            }
    }
};
struct EpiInB {
    bf16_t *Q, *Kb; const float *ropeC, *ropeS; bf16_t *VT, *VTc;
    __device__ __forceinline__ void operator()(const Acc& acc, const Unit& u, int wr, int wc, int fr, int fq) const {
#pragma unroll
        for (int ai = 0; ai < 2; ++ai)
#pragma unroll
            for (int m = 0; m < 4; ++m) {
                const int tok = u.arow + ai * 128 + wr * 64 + m * 16 + fr;
                const bool lat = tok < NLAT; const int pos = tok & 4095, prow = pos >> 6, pcol = pos & 63;
#pragma unroll
                for (int bj = 0; bj < 2; ++bj) {
                    const int col = u.brow + bj * 128 + wc * 32 + fq * 8;
                    f32x4 v0 = acc[ai][bj][m][0], v1 = acc[ai][bj][m][1];
                    if (col >= 640) {
                        const int dv = col - 640, kvh = dv >> 6, d = dv & 63, dt = d >> 5, rl0 = d & 31;
                        int b, t; if (lat) { b = tok >> 12; t = tok & 4095; } else { b = (tok - NLAT) >> 8; t = tok & 255; }
                        const int tile = t >> 5, s = (t >> 4) & 1, k16 = t & 15, hh = (k16 >> 2) & 1, j = ((k16 >> 3) << 2) | (k16 & 3);
                        bf16_t* vb = (lat ? VT + (size_t)((b * 2 + kvh) * 128 + tile) * 2048 : VTc + (size_t)((b * 2 + kvh) * 8 + tile) * 2048) + (dt * 2 + s) * 512 + (hh * 32 + rl0) * 8 + j;
                        const u32x4 w = pack8(v0, v1);
                        vb[0] = (bf16_t)(w.x & 0xFFFFu); vb[8] = (bf16_t)(w.x >> 16); vb[16] = (bf16_t)(w.y & 0xFFFFu); vb[24] = (bf16_t)(w.y >> 16);
                        vb[32] = (bf16_t)(w.z & 0xFFFFu); vb[40] = (bf16_t)(w.z >> 16); vb[48] = (bf16_t)(w.w & 0xFFFFu); vb[56] = (bf16_t)(w.w >> 16);
                        continue;
                    }
                    if (lat) {
                        const int i0 = (col & 63) >> 1, pp = (i0 < 16) ? prow : pcol, f0 = i0 & 15;
                        const f32x4 cs = *(const f32x4*)(ropeC + pp * 16 + f0), sn = *(const f32x4*)(ropeS + pp * 16 + f0);
                        f32x4 w0, w1;
                        w0[0] = v0[0] * cs[0] - v0[1] * sn[0]; w0[1] = v0[0] * sn[0] + v0[1] * cs[0];
                        w0[2] = v0[2] * cs[1] - v0[3] * sn[1]; w0[3] = v0[2] * sn[1] + v0[3] * cs[1];
                        w1[0] = v1[0] * cs[2] - v1[1] * sn[2]; w1[1] = v1[0] * sn[2] + v1[1] * cs[2];
                        w1[2] = v1[2] * cs[3] - v1[3] * sn[3]; w1[3] = v1[2] * sn[3] + v1[3] * cs[3];
                        v0 = w0; v1 = w1;
                    }
                    bf16_t* dst = (col < 512) ? Q + (size_t)tok * 512 + col : Kb + (size_t)tok * 128 + (col - 512);
                    *(u32x4*)dst = pack8(v0, v1);
                }
            }
    }
};
struct EpiDft {
    bf16_t* MIX; int isctx;
    __device__ __forceinline__ void operator()(const Acc& acc, const Unit& u, int wr, int wc, int fr, int fq) const {
#pragma unroll
        for (int ai = 0; ai < 2; ++ai)
#pragma unroll
            for (int m = 0; m < 4; ++m) {
                const int k = u.arow + ai * 128 + wr * 64 + m * 16 + fr;
#pragma unroll
                for (int bj = 0; bj < 2; ++bj) {
                    const int col = u.brow + bj * 128 + wc * 32 + fq * 8; const int b = col >> 9, c = col & 511;
                    const size_t trow = isctx ? (size_t)(NLAT + b * 256 + k) : (size_t)(b * 4096 + k);
                    *(u32x4*)(MIX + trow * 1024 + c) = pack8(acc[ai][bj][m][0], acc[ai][bj][m][1]);
                }
            }
    }
};
struct EpiI2 {
    bf16_t* I2;
    __device__ __forceinline__ void operator()(const Acc& acc, const Unit& u, int wr, int wc, int fr, int fq) const {
#pragma unroll
        for (int ai = 0; ai < 2; ++ai)
#pragma unroll
            for (int m = 0; m < 4; ++m) {
                const int row = u.arow + ai * 128 + wr * 64 + m * 16 + fr;
#pragma unroll
                for (int bj = 0; bj < 2; ++bj) {
                    const int col = u.brow + bj * 128 + wc * 32 + fq * 8;
                    *(u32x4*)(I2 + (size_t)row * 32768 + col) = pack8(acc[ai][bj][m][0], acc[ai][bj][m][1]);
                }
            }
    }
};
struct EpiRes {
    const float *in_lat, *in_ctx; float *out_lat, *out_ctx; const float* gate;
    __device__ __forceinline__ void operator()(const Acc& acc, const Unit& u, int wr, int wc, int fr, int fq) const {
        const int row0 = u.arow + wr * 64 + fr, col0 = u.brow + wc * 32 + fq * 8;
        const bool lat = row0 < NLAT;
        const int b = lat ? (row0 >> 12) : 4;
        const float* ip = lat ? in_lat + (size_t)row0 * 1024 + col0 : in_ctx + (size_t)(row0 - NLAT) * 1024 + col0;
        float* op = lat ? out_lat + (size_t)row0 * 1024 + col0 : out_ctx + (size_t)(row0 - NLAT) * 1024 + col0;
        const float* gp = gate + b * 6144 + col0;
        f32x4 gv[2][2];
#pragma unroll
        for (int bj = 0; bj < 2; ++bj)
#pragma unroll
            for (int n = 0; n < 2; ++n) gv[bj][n] = *(const f32x4*)(gp + bj * 128 + 4 * n);
#pragma unroll
        for (int ai = 0; ai < 2; ++ai)
#pragma unroll
            for (int mh = 0; mh < 2; ++mh) {
                f32x4 hv[2][2][2];
#pragma unroll
                for (int mm = 0; mm < 2; ++mm)
#pragma unroll
                    for (int bj = 0; bj < 2; ++bj)
#pragma unroll
                        for (int n = 0; n < 2; ++n) hv[mm][bj][n] = *(const f32x4*)(ip + (size_t)(ai * 128 + (mh * 2 + mm) * 16) * 1024 + bj * 128 + 4 * n);
#pragma unroll
                for (int mm = 0; mm < 2; ++mm)
#pragma unroll
                    for (int bj = 0; bj < 2; ++bj)
#pragma unroll
                        for (int n = 0; n < 2; ++n) *(f32x4*)(op + (size_t)(ai * 128 + (mh * 2 + mm) * 16) * 1024 + bj * 128 + 4 * n) = hv[mm][bj][n] + gv[bj][n] * acc[ai][bj][mh * 2 + mm][n];
            }
    }
};
struct EpiResFinal {
    static constexpr bool AFTER_DRAIN = true;
    const float* H; float* out; const float* gate; const float* fg; float* xss; unsigned* pcnt; unsigned* tmo;
    __device__ __forceinline__ void fused(Acc& acc, const Unit& u, int wr, int wc, int fr, int fq, LAS unsigned char* lds, int wid, int lane) const {
        LAS float* P = (LAS float*)lds;
        LAS float* S = (LAS float*)(lds + 8192);
        const int row0 = u.arow + wr * 64 + fr, col0 = u.brow + wc * 32 + fq * 8;
        const float* ip = H + (size_t)row0 * 1024 + col0; float* op = out + (size_t)row0 * 1024 + col0;
        const float* gp = gate + (row0 >> 12) * 6144 + col0;
        f32x4 gv[2][2];
#pragma unroll
        for (int bj = 0; bj < 2; ++bj)
#pragma unroll
            for (int n = 0; n < 2; ++n) gv[bj][n] = *(const f32x4*)(gp + bj * 128 + 4 * n);
#pragma unroll
        for (int ai = 0; ai < 2; ++ai)
#pragma unroll
            for (int m = 0; m < 4; ++m) {
                float s = 0.f;
#pragma unroll
                for (int bj = 0; bj < 2; ++bj)
#pragma unroll
                    for (int n = 0; n < 2; ++n) {
                        const f32x4 hv = *(const f32x4*)(ip + (size_t)(ai * 128 + m * 16) * 1024 + bj * 128 + 4 * n);
                        const f32x4 h = hv + gv[bj][n] * acc[ai][bj][m][n]; acc[ai][bj][m][n] = h;
                        s += (h[0] * h[0] + h[1] * h[1]) + (h[2] * h[2] + h[3] * h[3]);
                    }
                s += __shfl_xor(s, 16); s += __shfl_xor(s, 32);
                if (fq == 0) P[(ai * 128 + wr * 64 + m * 16 + fr) * 4 + wc] = s;
            }
        asm volatile("s_waitcnt lgkmcnt(0)" ::: "memory"); __builtin_amdgcn_s_barrier(); asm volatile("" ::: "memory");
        const int row = wid * 32 + (lane & 31);
        if (lane < 32) {
            const float t = (P[row * 4 + 0] + P[row * 4 + 1]) + (P[row * 4 + 2] + P[row * 4 + 3]);
            __hip_atomic_store((unsigned*)xss + ((size_t)(u.arow + row) * 4 + u.pn), __float_as_uint(t), __ATOMIC_RELAXED, __HIP_MEMORY_SCOPE_AGENT);
        }
        asm volatile("s_waitcnt vmcnt(0)" ::: "memory");
        if (lane == 0) __hip_atomic_fetch_add(pcnt + 64 * u.pm, 1u, __ATOMIC_RELAXED, __HIP_MEMORY_SCOPE_AGENT);
        if (wid == 0) {
            unsigned sp = 0;
            while ((unsigned)__builtin_amdgcn_readfirstlane(__hip_atomic_load(pcnt + 64 * u.pm, __ATOMIC_RELAXED, __HIP_MEMORY_SCOPE_AGENT)) < 32u) {
                __builtin_amdgcn_s_sleep(2);
                if ((++sp & 1023u) == 0u) { if (__hip_atomic_load(tmo, __ATOMIC_RELAXED, __HIP_MEMORY_SCOPE_AGENT) != 0u) break; if (sp > (1u << 22)) { if (lane == 0) atomicAdd(tmo, 1u); break; } }
            }
            __builtin_amdgcn_fence(__ATOMIC_ACQUIRE, "agent");
        }
        asm volatile("s_waitcnt vmcnt(0) lgkmcnt(0)" ::: "memory"); __builtin_amdgcn_s_barrier(); asm volatile("" ::: "memory");
        if (lane < 32) {
            const unsigned* slot = (const unsigned*)xss + (size_t)(u.arow + row) * 4; float t = 0.f;
#pragma unroll
            for (int q = 0; q < 4; ++q) t += __uint_as_float(__hip_atomic_load(slot + q, __ATOMIC_RELAXED, __HIP_MEMORY_SCOPE_AGENT));
            S[row] = rsqrtf(t * (1.0f / 1024.0f) + 1e-6f);
        }
        asm volatile("s_waitcnt lgkmcnt(0)" ::: "memory"); __builtin_amdgcn_s_barrier(); asm volatile("" ::: "memory");
        f32x4 fv[2][2];
#pragma unroll
        for (int bj = 0; bj < 2; ++bj)
#pragma unroll
            for (int n = 0; n < 2; ++n) fv[bj][n] = *(const f32x4*)(fg + col0 + bj * 128 + 4 * n);
#pragma unroll
        for (int ai = 0; ai < 2; ++ai)
#pragma unroll
            for (int m = 0; m < 4; ++m) {
                const float rinv = S[ai * 128 + wr * 64 + m * 16 + fr];
#pragma unroll
                for (int bj = 0; bj < 2; ++bj)
#pragma unroll
                    for (int n = 0; n < 2; ++n) *(f32x4*)(op + (size_t)(ai * 128 + m * 16) * 1024 + bj * 128 + 4 * n) = acc[ai][bj][m][n] * rinv * fv[bj][n];
            }
    }
};
struct EpiResNorm {
    static constexpr bool AFTER_DRAIN = true;
    const float* X; float* H; const float* gate; const float* ng; const float* mods_l; bf16_t* XNo; float* xss; unsigned* pcnt; unsigned* tmo;
    __device__ __forceinline__ void fused(Acc& acc, const Unit& u, int wr, int wc, int fr, int fq, LAS unsigned char* lds, int wid, int lane) const {
        LAS float* P = (LAS float*)lds; LAS float* S = (LAS float*)(lds + 8192);
        const int row0 = u.arow + wr * 64 + fr, col0 = u.brow + wc * 32 + fq * 8, b = row0 >> 12;
        const float* ip = X + (size_t)row0 * 1024 + col0; float* op = H + (size_t)row0 * 1024 + col0;
        {
            const float* gp = gate + b * 6144 + col0; f32x4 gv[2][2];
#pragma unroll
            for (int bj = 0; bj < 2; ++bj)
#pragma unroll
                for (int n = 0; n < 2; ++n) gv[bj][n] = *(const f32x4*)(gp + bj * 128 + 4 * n);
#pragma unroll
            for (int ai = 0; ai < 2; ++ai)
#pragma unroll
                for (int m = 0; m < 4; ++m) {
                    float s = 0.f;
#pragma unroll
                    for (int bj = 0; bj < 2; ++bj)
#pragma unroll
                        for (int n = 0; n < 2; ++n) {
                            const f32x4 hv = *(const f32x4*)(ip + (size_t)(ai * 128 + m * 16) * 1024 + bj * 128 + 4 * n);
                            const f32x4 h = hv + gv[bj][n] * acc[ai][bj][m][n]; acc[ai][bj][m][n] = h;
                            *(f32x4*)(op + (size_t)(ai * 128 + m * 16) * 1024 + bj * 128 + 4 * n) = h;
                            s += (h[0] * h[0] + h[1] * h[1]) + (h[2] * h[2] + h[3] * h[3]);
                        }
                    s += __shfl_xor(s, 16); s += __shfl_xor(s, 32);
                    if (fq == 0) P[(ai * 128 + wr * 64 + m * 16 + fr) * 4 + wc] = s;
                }
        }
        asm volatile("s_waitcnt lgkmcnt(0)" ::: "memory"); __builtin_amdgcn_s_barrier(); asm volatile("" ::: "memory");
        const int row = wid * 32 + (lane & 31);
        if (lane < 32) {
            const float t = (P[row * 4 + 0] + P[row * 4 + 1]) + (P[row * 4 + 2] + P[row * 4 + 3]);
            __hip_atomic_store((unsigned*)xss + ((size_t)(u.arow + row) * 4 + u.pn), __float_as_uint(t), __ATOMIC_RELAXED, __HIP_MEMORY_SCOPE_AGENT);
        }
        asm volatile("s_waitcnt vmcnt(0)" ::: "memory");
        if (lane == 0) __hip_atomic_fetch_add(pcnt + 64 * u.pm, 1u, __ATOMIC_RELAXED, __HIP_MEMORY_SCOPE_AGENT);
        if (wid == 0) {
            unsigned sp = 0;
            while ((unsigned)__builtin_amdgcn_readfirstlane(__hip_atomic_load(pcnt + 64 * u.pm, __ATOMIC_RELAXED, __HIP_MEMORY_SCOPE_AGENT)) < 32u) {
                __builtin_amdgcn_s_sleep(2);
                if ((++sp & 1023u) == 0u) { if (__hip_atomic_load(tmo, __ATOMIC_RELAXED, __HIP_MEMORY_SCOPE_AGENT) != 0u) break; if (sp > (1u << 22)) { if (lane == 0) atomicAdd(tmo, 1u); break; } }
            }
            __builtin_amdgcn_fence(__ATOMIC_ACQUIRE, "agent");
        }
        asm volatile("s_waitcnt vmcnt(0) lgkmcnt(0)" ::: "memory"); __builtin_amdgcn_s_barrier(); asm volatile("" ::: "memory");
        if (lane < 32) {
            const unsigned* slot = (const unsigned*)xss + (size_t)(u.arow + row) * 4; float t = 0.f;
#pragma unroll
            for (int q = 0; q < 4; ++q) t += __uint_as_float(__hip_atomic_load(slot + q, __ATOMIC_RELAXED, __HIP_MEMORY_SCOPE_AGENT));
            S[row] = rsqrtf(t * (1.0f / 1024.0f) + 1e-6f);
        }
        asm volatile("s_waitcnt lgkmcnt(0)" ::: "memory"); __builtin_amdgcn_s_barrier(); asm volatile("" ::: "memory");
        bf16_t* xp = XNo + (size_t)row0 * 1024 + col0;
#pragma unroll
        for (int bj = 0; bj < 2; ++bj) {
            f32x4 mv[2], sv[2];
#pragma unroll
            for (int n = 0; n < 2; ++n) { const int c = col0 + bj * 128 + 4 * n; const f32x4 g4 = *(const f32x4*)(ng + c), s4 = *(const f32x4*)(mods_l + (size_t)b * 6144 + 4 * 1024 + c); sv[n] = *(const f32x4*)(mods_l + (size_t)b * 6144 + 3 * 1024 + c);
#pragma unroll
                for (int j = 0; j < 4; ++j) mv[n][j] = g4[j] * (1.0f + s4[j]); }
#pragma unroll
            for (int ai = 0; ai < 2; ++ai)
#pragma unroll
                for (int m = 0; m < 4; ++m) {
                    const float rinv = S[ai * 128 + wr * 64 + m * 16 + fr];
                    const f32x4 y0 = acc[ai][bj][m][0] * rinv * mv[0] + sv[0], y1 = acc[ai][bj][m][1] * rinv * mv[1] + sv[1];
                    *(u32x4*)(xp + (size_t)(ai * 128 + m * 16) * 1024 + bj * 128) = pack8(y0, y1);
                }
        }
    }
};
struct EpiPart {
    float* slab;
    __device__ __forceinline__ void operator()(const Acc& acc, const Unit& u, int wr, int wc, int fr, int fq) const {
        float* base = slab + (size_t)(u.kofs >> 8) * 1024 * 1024;
#pragma unroll
        for (int ai = 0; ai < 2; ++ai)
#pragma unroll
            for (int m = 0; m < 4; ++m) {
                const int row = u.arow + ai * 128 + wr * 64 + m * 16 + fr;
                float* op = base + (size_t)row * 1024;
#pragma unroll
                for (int bj = 0; bj < 2; ++bj) {
                    const int col = u.brow + bj * 128 + wc * 32 + fq * 8;
                    *(f32x4*)(op + col) = acc[ai][bj][m][0]; *(f32x4*)(op + col + 4) = acc[ai][bj][m][1];
                }
            }
    }
};
struct EpiSwiglu {
    bf16_t* ACT;
    __device__ __forceinline__ void operator()(const Acc& acc, const Unit& u, int wr, int wc, int fr, int fq) const {
#pragma unroll
        for (int ai = 0; ai < 2; ++ai)
#pragma unroll
            for (int m = 0; m < 4; ++m) {
                const int row = u.arow + ai * 128 + wr * 64 + m * 16 + fr;
                const int col = u.pn * 128 + wc * 32 + fq * 8;
                f32x4 o0, o1;
#pragma unroll
                for (int j = 0; j < 4; ++j) { o0[j] = siluf_(acc[ai][0][m][0][j]) * acc[ai][1][m][0][j]; o1[j] = siluf_(acc[ai][0][m][1][j]) * acc[ai][1][m][1][j]; }
                *(u32x4*)(ACT + (size_t)row * FF + col) = pack8(o0, o1);
            }
    }
};
struct EpiGlu {
    float* H; const float* gate;
    __device__ __forceinline__ void operator()(const Acc& acc, const Unit& u, int wr, int wc, int fr, int fq) const {
        const int b = u.arow >> 12; const int col = u.pn * 128 + wc * 32 + fq * 8;
        const float* gp = gate + b * 6144 + col;
        float* hp0 = H + (size_t)(u.arow + wr * 64 + fr) * 1024 + col;
        f32x4 gv[2];
#pragma unroll
        for (int n = 0; n < 2; ++n) gv[n] = *(const f32x4*)(gp + 4 * n);
#pragma unroll
        for (int ai = 0; ai < 2; ++ai) {
            f32x4 hv[4][2];
#pragma unroll
            for (int m = 0; m < 4; ++m)
#pragma unroll
                for (int n = 0; n < 2; ++n) hv[m][n] = *(const f32x4*)(hp0 + (size_t)(ai * 128 + m * 16) * 1024 + 4 * n);
#pragma unroll
            for (int m = 0; m < 4; ++m)
#pragma unroll
                for (int n = 0; n < 2; ++n) {
                    f32x4 o;
#pragma unroll
                    for (int j = 0; j < 4; ++j) o[j] = hv[m][n][j] + gv[n][j] * (acc[ai][0][m][n][j] * sigmoidf_(acc[ai][1][m][n][j]));
                    *(f32x4*)(hp0 + (size_t)(ai * 128 + m * 16) * 1024 + 4 * n) = o;
                }
        }
    }
};
struct EpiGluNorm {
    static constexpr bool AFTER_DRAIN = true;
    float* H; const float* gate; const float* ng; const float* mods_l; bf16_t* XNo; float* xss; unsigned* pcnt; unsigned* tmo;
    __device__ __forceinline__ void fused(Acc& acc, const Unit& u, int wr, int wc, int fr, int fq, LAS unsigned char* lds, int wid, int lane) const {
        LAS float* P = (LAS float*)lds; LAS float* S = (LAS float*)(lds + 8192);
        const int row0 = u.arow + wr * 64 + fr, col = u.pn * 128 + wc * 32 + fq * 8, b = row0 >> 12;
        float* hp = H + (size_t)row0 * 1024 + col;
        {
            const float* gp = gate + b * 6144 + col; f32x4 gv[2];
#pragma unroll
            for (int n = 0; n < 2; ++n) gv[n] = *(const f32x4*)(gp + 4 * n);
#pragma unroll
            for (int ai = 0; ai < 2; ++ai)
#pragma unroll
                for (int m = 0; m < 4; ++m) {
                    float s = 0.f;
#pragma unroll
                    for (int n = 0; n < 2; ++n) {
                        const f32x4 hv = *(const f32x4*)(hp + (size_t)(ai * 128 + m * 16) * 1024 + 4 * n); f32x4 o;
#pragma unroll
                        for (int j = 0; j < 4; ++j) o[j] = hv[j] + gv[n][j] * (acc[ai][0][m][n][j] * sigmoidf_(acc[ai][1][m][n][j]));
                        *(f32x4*)(hp + (size_t)(ai * 128 + m * 16) * 1024 + 4 * n) = o; acc[ai][0][m][n] = o;
                        s += (o[0] * o[0] + o[1] * o[1]) + (o[2] * o[2] + o[3] * o[3]);
                    }
                    s += __shfl_xor(s, 16); s += __shfl_xor(s, 32);
                    if (fq == 0) P[(ai * 128 + wr * 64 + m * 16 + fr) * 4 + wc] = s;
                }
        }
        asm volatile("s_waitcnt lgkmcnt(0)" ::: "memory"); __builtin_amdgcn_s_barrier(); asm volatile("" ::: "memory");
        const int row = wid * 32 + (lane & 31);
        if (lane < 32) {
            const float t = (P[row * 4 + 0] + P[row * 4 + 1]) + (P[row * 4 + 2] + P[row * 4 + 3]);
            __hip_atomic_store((unsigned*)xss + ((size_t)(u.arow + row) * 8 + u.pn), __float_as_uint(t), __ATOMIC_RELAXED, __HIP_MEMORY_SCOPE_AGENT);
        }
        asm volatile("s_waitcnt vmcnt(0)" ::: "memory");
        if (lane == 0) __hip_atomic_fetch_add(pcnt + 64 * u.pm, 1u, __ATOMIC_RELAXED, __HIP_MEMORY_SCOPE_AGENT);
        if (wid == 0) {
            unsigned sp = 0;
            while ((unsigned)__builtin_amdgcn_readfirstlane(__hip_atomic_load(pcnt + 64 * u.pm, __ATOMIC_RELAXED, __HIP_MEMORY_SCOPE_AGENT)) < 64u) {
                __builtin_amdgcn_s_sleep(2);
                if ((++sp & 1023u) == 0u) { if (__hip_atomic_load(tmo, __ATOMIC_RELAXED, __HIP_MEMORY_SCOPE_AGENT) != 0u) break; if (sp > (1u << 22)) { if (lane == 0) atomicAdd(tmo, 1u); break; } }
            }
            __builtin_amdgcn_fence(__ATOMIC_ACQUIRE, "agent");
        }
        asm volatile("s_waitcnt vmcnt(0) lgkmcnt(0)" ::: "memory"); __builtin_amdgcn_s_barrier(); asm volatile("" ::: "memory");
        if (lane < 32) {
            const unsigned* slot = (const unsigned*)xss + (size_t)(u.arow + row) * 8; float t = 0.f;
#pragma unroll
            for (int q = 0; q < 8; ++q) t += __uint_as_float(__hip_atomic_load(slot + q, __ATOMIC_RELAXED, __HIP_MEMORY_SCOPE_AGENT));
            S[row] = rsqrtf(t * (1.0f / 1024.0f) + 1e-6f);
        }
        asm volatile("s_waitcnt lgkmcnt(0)" ::: "memory"); __builtin_amdgcn_s_barrier(); asm volatile("" ::: "memory");
        f32x4 mv[2], sv[2];
#pragma unroll
        for (int n = 0; n < 2; ++n) { const int c = col + 4 * n; const f32x4 g4 = *(const f32x4*)(ng + c), s4 = *(const f32x4*)(mods_l + (size_t)b * 6144 + 4 * 1024 + c); sv[n] = *(const f32x4*)(mods_l + (size_t)b * 6144 + 3 * 1024 + c);
#pragma unroll
            for (int j = 0; j < 4; ++j) mv[n][j] = g4[j] * (1.0f + s4[j]); }
        bf16_t* xp = XNo + (size_t)row0 * 1024 + col;
#pragma unroll
        for (int ai = 0; ai < 2; ++ai)
#pragma unroll
            for (int m = 0; m < 4; ++m) {
                const float rinv = S[ai * 128 + wr * 64 + m * 16 + fr];
                const f32x4 y0 = acc[ai][0][m][0] * rinv * mv[0] + sv[0], y1 = acc[ai][0][m][1] * rinv * mv[1] + sv[1];
                *(u32x4*)(xp + (size_t)(ai * 128 + m * 16) * 1024) = pack8(y0, y1);
            }
    }
};
struct EpiState {
    bf16_t* S;
    __device__ __forceinline__ void operator()(const Acc& acc, const Unit& u, int wr, int wc, int fr, int fq) const {
        bf16_t* base = S + (size_t)u.pn * SROWS * 256;
#pragma unroll
        for (int ai = 0; ai < 2; ++ai)
#pragma unroll
            for (int m = 0; m < 4; ++m) {
                const int lrow = u.pm * 256 + ai * 128 + wr * 64 + m * 16 + fr;
                bf16_t* op = base + (size_t)lrow * 256;
#pragma unroll
                for (int bj = 0; bj < 2; ++bj) *(u32x4*)(op + bj * 128 + wc * 32 + fq * 8) = pack8(acc[ai][bj][m][0], acc[ai][bj][m][1]);
            }
    }
};
struct EpiSout {
    bf16_t* GY;
    __device__ __forceinline__ void operator()(const Acc& acc, const Unit& u, int wr, int wc, int fr, int fq) const {
#pragma unroll
        for (int ai = 0; ai < 2; ++ai)
#pragma unroll
            for (int m = 0; m < 4; ++m) {
                const int lrow = u.pm * 256 + ai * 128 + wr * 64 + m * 16 + fr;
                const int b = lrow >> 8, ch = lrow & 255;
#pragma unroll
                for (int bj = 0; bj < 2; ++bj) {
                    const int n = bj * 128 + wc * 32 + fq * 8; const int t = n >> 4, h0 = n & 15;
                    f32x4 o0, o1;
#pragma unroll
                    for (int j = 0; j < 4; ++j) { o0[j] = gelu_tanh(acc[ai][bj][m][0][j]); o1[j] = gelu_tanh(acc[ai][bj][m][1][j]); }
                    *(u32x4*)(GY + (size_t)(b * 4096 + ch * 16 + t) * 1024 + u.pn * 16 + h0) = pack8(o0, o1);
                }
            }
    }
};

__device__ __forceinline__ void p0_transpose(const float* src, int ld, int K, int c0, bf16_t* dst, float scale, LAS float* tile) {
    const int tid = otid();
    const int lkk = tid >> 7, lcc = tid & 127;
    float r[16];
#pragma unroll
    for (int i = 0; i < 16; ++i) r[i] = __builtin_nontemporal_load(src + (size_t)(lkk + 4 * i) * ld + c0 + lcc);
    for (int k0 = 0; k0 < K; k0 += 64) {
        __syncthreads();
#pragma unroll
        for (int i = 0; i < 16; ++i) tile[(lkk + 4 * i) * 129 + lcc] = r[i];
        if (k0 + 64 < K) {
#pragma unroll
            for (int i = 0; i < 16; ++i) r[i] = __builtin_nontemporal_load(src + (size_t)(k0 + 64 + lkk + 4 * i) * ld + c0 + lcc);
        }
        __syncthreads();
        { const int cc = tid >> 2, kk0 = (tid & 3) * 16; float v[16];
#pragma unroll
          for (int j = 0; j < 16; ++j) v[j] = tile[(kk0 + j) * 129 + cc] * scale;
          u32x4 w0, w1; w0.x = cvt_pk_bf16(v[0], v[1]); w0.y = cvt_pk_bf16(v[2], v[3]); w0.z = cvt_pk_bf16(v[4], v[5]); w0.w = cvt_pk_bf16(v[6], v[7]);
          w1.x = cvt_pk_bf16(v[8], v[9]); w1.y = cvt_pk_bf16(v[10], v[11]); w1.z = cvt_pk_bf16(v[12], v[13]); w1.w = cvt_pk_bf16(v[14], v[15]);
          bf16_t* dp = dst + (size_t)cc * K + k0 + kk0; *(u32x4*)dp = w0; *(u32x4*)(dp + 8) = w1; }
    }
    __syncthreads();
}

__device__ __forceinline__ void p0_s5_item(const Params& p, int g, LAS float* L) {
    const int tid = otid();
    LAS float* pw_re = L;
    LAS float* pw_im = L + 2176;
    LAS float* bb_re = L + 4352;
    LAS float* bb_im = L + 6400;
    LAS float* cc_re = L + 8448;
    LAS float* cc_im = L + 10528;
    LAS float* Kt = L + 12608;
    __syncthreads();
    if (tid < 128) {
        const int dir = tid >> 6, pp = tid & 63;
        const float dt = expf(p.log_dt[dir * 64 + g]);
        const float are = p.a_re[(dir * 64 + g) * 64 + pp], aim = p.a_im[(dir * 64 + g) * 64 + pp];
        for (int tau = 0; tau <= 16; ++tau) {
            const float mag = expf(are * dt * (float)tau); float s, c; sincosf(aim * dt * (float)tau, &s, &c);
            pw_re[(dir * 64 + pp) * 17 + tau] = mag * c; pw_im[(dir * 64 + pp) * 17 + tau] = mag * s;
        }
        const float abr = pw_re[(dir * 64 + pp) * 17 + 1], abi = pw_im[(dir * 64 + pp) * 17 + 1];
        const float nr = abr - 1.0f, ni = abi, den = are * are + aim * aim;
        const float fre = (nr * are + ni * aim) / den, fim = (ni * are - nr * aim) / den;
        for (int h = 0; h < 16; ++h) {
            const float br = p.b_re[((size_t)(dir * 64 + g) * 64 + pp) * 16 + h], bi = p.b_im[((size_t)(dir * 64 + g) * 64 + pp) * 16 + h];
            bb_re[(dir * 64 + pp) * 16 + h] = fre * br - fim * bi; bb_im[(dir * 64 + pp) * 16 + h] = fre * bi + fim * br;
        }
    }
    for (int idx = tid; idx < 2048; idx += NT) {
        const int dir = idx >> 10, h = (idx >> 6) & 15, pp = idx & 63;
        cc_re[(dir * 16 + h) * 65 + pp] = p.c_re[((size_t)(dir * 64 + g) * 16 + h) * 64 + pp]; cc_im[(dir * 16 + h) * 65 + pp] = p.c_im[((size_t)(dir * 64 + g) * 16 + h) * 64 + pp];
    }
    __syncthreads();
    {
        const int dir = tid >> 8, tau = (tid >> 4) & 15, h = tid & 15;
        float a[16];
#pragma unroll
        for (int j = 0; j < 16; ++j) a[j] = 0.f;
        for (int pp = 0; pp < 64; ++pp) {
            const float cr = cc_re[(dir * 16 + h) * 65 + pp], ci = cc_im[(dir * 16 + h) * 65 + pp];
            const float pr = pw_re[(dir * 64 + pp) * 17 + tau], pi = pw_im[(dir * 64 + pp) * 17 + tau];
            const float xr = cr * pr - ci * pi, xi = cr * pi + ci * pr;
#pragma unroll
            for (int j = 0; j < 16; ++j) a[j] += xr * bb_re[(dir * 64 + pp) * 16 + j] - xi * bb_im[(dir * 64 + pp) * 16 + j];
        }
#pragma unroll
        for (int j = 0; j < 16; ++j) Kt[tid * 16 + j] = a[j];
    }
    __syncthreads();
    bf16_t* Wst = (bf16_t*)(p.ws + O_WST) + (size_t)g * 256 * 256;
    for (int ch = tid; ch < 8192; ch += NT) {
        const int n = ch >> 5, k0 = (ch & 31) * 8; const int dir = n >> 7, ri = (n >> 6) & 1, pp = n & 63, s = k0 >> 4, h0 = k0 & 15; const int e = dir ? s : 15 - s;
        const float pr = pw_re[(dir * 64 + pp) * 17 + e], pi = pw_im[(dir * 64 + pp) * 17 + e];
        float v[8];
#pragma unroll
        for (int j = 0; j < 8; ++j) { const float br = bb_re[(dir * 64 + pp) * 16 + h0 + j], bi = bb_im[(dir * 64 + pp) * 16 + h0 + j]; v[j] = ri ? (pr * bi + pi * br) : (pr * br - pi * bi); }
        u32x4 w; w.x = cvt_pk_bf16(v[0], v[1]); w.y = cvt_pk_bf16(v[2], v[3]); w.z = cvt_pk_bf16(v[4], v[5]); w.w = cvt_pk_bf16(v[6], v[7]);
        *(u32x4*)(Wst + (size_t)n * 256 + k0) = w;
    }
    bf16_t* Tt = (bf16_t*)(p.ws + O_TT) + (size_t)g * 256 * 512;
    for (int ch = tid; ch < 16384; ch += NT) {
        const int n = ch >> 6, k0 = (ch & 63) * 8; const int t = n >> 4, h = n & 15; float v[8];
        if (k0 < 256) {
            const int s = k0 >> 4, h0 = k0 & 15;
#pragma unroll
            for (int j = 0; j < 8; ++j) {
                float x = 0.f;
                if (s <= t) x += Kt[((0 * 16 + (t - s)) * 16 + h) * 16 + h0 + j];
                if (s >= t) x += Kt[((1 * 16 + (s - t)) * 16 + h) * 16 + h0 + j];
                if (s == t && h == h0 + j) x += p.ssm_d[g * 16 + h];
                v[j] = x;
            }
        } else {
            const int kk = k0 - 256, dir = kk >> 7, ri = (kk >> 6) & 1, p0 = kk & 63; const int e = dir ? 16 - t : t + 1;
#pragma unroll
            for (int j = 0; j < 8; ++j) {
                const int pp = p0 + j;
                const float cr = cc_re[(dir * 16 + h) * 65 + pp], ci = cc_im[(dir * 16 + h) * 65 + pp], pr = pw_re[(dir * 64 + pp) * 17 + e], pi = pw_im[(dir * 64 + pp) * 17 + e];
                v[j] = ri ? -(cr * pi + ci * pr) : (cr * pr - ci * pi);
            }
        }
        u32x4 w; w.x = cvt_pk_bf16(v[0], v[1]); w.y = cvt_pk_bf16(v[2], v[3]); w.z = cvt_pk_bf16(v[4], v[5]); w.w = cvt_pk_bf16(v[6], v[7]);
        *(u32x4*)(Tt + (size_t)n * 512 + k0) = w;
    }
    __syncthreads();
}

__device__ __forceinline__ void p0_adaln_item(const Params& p, int it, LAS float* L) {
    const int tid = otid(); const int l = it / 96, n0 = (it % 96) * 64;
    LAS float* sc = L;
    LAS float* red = L + 5120;
    __syncthreads();
    for (int idx = tid; idx < 5120; idx += NT) { const int r = idx >> 10, k = idx & 1023; const float v = (r < 4) ? p.c[r * 1024 + k] : p.c_ctx[k]; sc[idx] = siluf_(v); }
    __syncthreads();
    const int n = tid & 63, kq = tid >> 6; float a[5] = {0.f, 0.f, 0.f, 0.f, 0.f};
    const float* wp = p.mod_w + (size_t)l * 1024 * 6144 + n0 + n;
    for (int k = kq; k < 1024; k += 128) {
        float w[16];
#pragma unroll
        for (int u = 0; u < 16; ++u) w[u] = __builtin_nontemporal_load(wp + (size_t)(k + 8 * u) * 6144);
#pragma unroll
        for (int u = 0; u < 16; ++u)
#pragma unroll
            for (int r = 0; r < 5; ++r) a[r] += sc[r * 1024 + k + 8 * u] * w[u];
    }
#pragma unroll
    for (int r = 0; r < 5; ++r) red[(kq * 5 + r) * 64 + n] = a[r];
    __syncthreads();
    if (tid < 320) { const int r = tid >> 6, nn = tid & 63; float s = p.mod_b[l * 6144 + n0 + nn];
#pragma unroll
        for (int q = 0; q < 8; ++q) s += red[(q * 5 + r) * 64 + nn];
        ((float*)(p.ws + O_MODS))[(size_t)(l * 5 + r) * 6144 + n0 + nn] = s; }
    __syncthreads();
}

__device__ __forceinline__ void p0_fold_item(const Params& p, int it, LAS float* L) {
    const int tid = otid(); const int grp = it >> 4, kt = it & 15;
    LAS float* w = L;
    LAS float* cT = L + 4160;
    LAS float* sT = L + 4224;
    __syncthreads();
#pragma unroll
    for (int i = 0; i < 8; ++i) { const int idx = tid + i * NT, kk = idx >> 6, j = idx & 63; w[kk * 65 + j] = p.w_in[(size_t)(kt * 64 + kk) * 1280 + grp * 64 + j]; }
    if (tid < 64) { cT[tid] = cospif((float)tid / 32.0f); sT[tid] = sinpif((float)tid / 32.0f); }
    __syncthreads();
    const int kk = tid & 63, q = tid >> 6; bf16_t* WinA = (bf16_t*)(p.ws + O_WINA);
    for (int i = 0; i < 8; ++i) {
        const int n = q + 8 * i; float ac = 0.f, as = 0.f; int ph = 0;
        for (int j = 0; j < 64; ++j) { const float wv = w[kk * 65 + j]; ac += wv * cT[ph]; as += wv * sT[ph]; ph = (ph + n) & 63; }
        WinA[(size_t)(grp * 64 + n) * 1024 + kt * 64 + kk] = f2bf(ac);
        WinA[(size_t)(512 + grp * 64 + n) * 1024 + kt * 64 + kk] = f2bf(as);
    }
    __syncthreads();
}

__device__ __forceinline__ void p0_dft_item(const Params& p, int it, LAS float* L) {
    const int tid = otid();
    __syncthreads();
    for (int i = tid; i < 256; i += NT) L[i] = cospif((float)i / 128.0f);
    __syncthreads();
    if (it == 0) {
        bf16_t* D = (bf16_t*)(p.ws + O_D256);
        for (int idx = tid; idx < 512 * 512; idx += NT) {
            const int row = idx >> 9, col = idx & 511; const int ro = row >> 8, k = row & 255, cs = col >> 8, t = col & 255; const int ph = (k * t) & 255;
            const float C = L[ph], S = L[(ph - 64) & 255];
            const float v = ro == 0 ? (cs == 0 ? C : -S) : (cs == 0 ? -S : -C);
            D[idx] = f2bf(v);
        }
    } else {
        bf16_t* Dc = (bf16_t*)(p.ws + O_DC);
        for (int idx = tid; idx < 256 * 512; idx += NT) {
            const int k = idx >> 9, j = idx & 511, t = j & 255, cs = j >> 8; const int ph = (k * t) & 255;
            Dc[idx] = f2bf((cs ? -L[(ph - 64) & 255] : L[ph]) * (1.0f / 128.0f));
        }
    }
    __syncthreads();
}

constexpr int P0_S5 = 64, P0_ADA = 192, P0_FOLD = 128, P0_TR = 134, P0_DFT = 2, P0_MISC = 1;
constexpr int P0_ITEMS = P0_S5 + P0_ADA + P0_FOLD + P0_TR + P0_DFT + P0_MISC;

__device__ __forceinline__ void p0_transpose_dispatch(const Params& p, int it, LAS float* L) {
    unsigned char* ws = p.ws;
    const float* src; int ld, K, c0; bf16_t* dst; float scale = 1.0f;
    if (it < 16) { const int l = it >> 3; it &= 7; src = p.ffn_d + (size_t)l * FF * 1024; ld = 1024; K = FF; c0 = 128 * it; dst = (bf16_t*)(ws + (l ? O_WD1 : O_WD0)) + (size_t)(128 * it) * FF; }
    else {
        it -= 16;
        if (it < 4) { src = p.w_in; ld = 1280; K = 1024; c0 = 512 + 128 * it; dst = (bf16_t*)(ws + O_WINB) + (size_t)(128 * it) * 1024; scale = 0.125f * 1.4426950408889634f; }
        else if (it < 5) { src = p.w_in; ld = 1280; K = 1024; c0 = 1024; dst = (bf16_t*)(ws + O_WINB) + (size_t)512 * 1024; }
        else if (it < 6) { src = p.w_in; ld = 1280; K = 1024; c0 = 1152; dst = (bf16_t*)(ws + O_WINB) + (size_t)640 * 1024; }
        else if (it < 14) { it -= 6; src = p.w_out; ld = 1024; K = 1024; c0 = 128 * it; dst = (bf16_t*)(ws + O_WOUT) + (size_t)(128 * it) * 1024; }
        else if (it < 14 + 88) {
            it -= 14; const int l = it / 44; it -= l * 44;
            bf16_t* wgu = (bf16_t*)(ws + (l ? O_WGU1 : O_WGU0));
            const int up = it / 22, tile = it % 22;
            src = (up ? p.ffn_u : p.ffn_g) + (size_t)l * 1024 * FF; ld = FF; K = 1024; c0 = 128 * tile; dst = wgu + (size_t)(tile * 256 + up * 128) * 1024;
        } else {
            it -= 102; c0 = 128 * it; const int half = c0 >> 10, j = c0 & 1023;
            src = p.glu_w; ld = 2048; K = 1024; dst = (bf16_t*)(ws + O_GLU) + (size_t)((j >> 7) * 256 + half * 128) * 1024;
        }
    }
    p0_transpose(src, ld, K, c0, dst, scale, L);
}

__device__ __forceinline__ void p0_misc(const Params& p) {
    const int tid = otid();
    float* rc = (float*)(p.ws + O_ROPE); float* rs = rc + 1024;
    for (int i = tid; i < 1024; i += NT) { const int pp = i >> 4, f = i & 15; const float inv = powf(10000.0f, -(float)f / 16.0f); const float ang = (float)pp * inv; float s, c; sincosf(ang, &s, &c); rc[i] = c; rs[i] = s; }
}

__device__ __forceinline__ void p0_dispatch(const Params& p, int it, LAS float* L) {
    int i = it;
    if (i < 64) { p0_s5_item(p, i, L); return; } i -= 64;
    if (i < 16) { p0_transpose_dispatch(p, i, L); return; } i -= 16;
    if (i < 128) { p0_fold_item(p, i, L); return; } i -= 128;
    if (i < 118) { p0_transpose_dispatch(p, 16 + i, L); return; } i -= 118;
    if (i < 192) { p0_adaln_item(p, i, L); return; } i -= 192;
    if (i < 2) { p0_dft_item(p, i, L); return; } i -= 2;
    p0_misc(p);
}
__device__ __forceinline__ void phase_p0(const Params& p, LAS float* L, unsigned* qhead, volatile LAS unsigned* qslot) {
    for (;;) {
        __syncthreads();
        if (threadIdx.x == 0) qslot[0] = __hip_atomic_fetch_add(qhead, 1u, __ATOMIC_RELAXED, __HIP_MEMORY_SCOPE_AGENT);
        __syncthreads();
        const int it = (int)qslot[0];
        if (it >= P0_ITEMS) break;
        p0_dispatch(p, it, L);
    }
}

template <int MODE>
__device__ __forceinline__ void phase_norm(const float* src_lat, const float* src_ctx, int nrows, const float* ng, const float* mods_l, int sh_idx, int sc_idx, bf16_t* dstb, float* dstf,
                                           const float* part = nullptr, int npart = 0, const float* pgate = nullptr, float* hstore = nullptr, int row_first = 0) {
    const int tid_ = otid(); const int lane = tid_ & 63, wv = obid() * 8 + (tid_ >> 6), nw = gridDim.x * 8;
    for (int row = row_first + wv; row < nrows; row += nw) {
        const float* sp; int mr;
        if (row < NLAT) { sp = src_lat + (size_t)row * 1024; mr = row >> 12; } else { sp = src_ctx + (size_t)(row - NLAT) * 1024; mr = 4; }
        f32x4 v[4]; float ss = 0.f;
#pragma unroll
        for (int i = 0; i < 4; ++i) v[i] = *(const f32x4*)(sp + i * 256 + lane * 4);
        if (npart > 0 && row >= NLAT) {
#pragma unroll
            for (int i = 0; i < 4; ++i) {
                const int col = i * 256 + lane * 4; f32x4 s = {0.f, 0.f, 0.f, 0.f};
#pragma unroll 2
                for (int k = 0; k < npart; ++k) s += *(const f32x4*)(part + ((size_t)k * 1024 + (row - NLAT)) * 1024 + col);
                v[i] += *(const f32x4*)(pgate + col) * s;
                if (hstore) *(f32x4*)(hstore + (size_t)(row - NLAT) * 1024 + col) = v[i];
            }
        }
#pragma unroll
        for (int i = 0; i < 4; ++i) ss += v[i][0] * v[i][0] + v[i][1] * v[i][1] + v[i][2] * v[i][2] + v[i][3] * v[i][3];
#pragma unroll
        for (int o = 32; o >= 1; o >>= 1) ss += __shfl_xor(ss, o);
        const float rinv = rsqrtf(ss * (1.0f / 1024.0f) + 1e-6f);
#pragma unroll
        for (int i = 0; i < 4; ++i) {
            const int col = i * 256 + lane * 4; const f32x4 gv = *(const f32x4*)(ng + col); f32x4 y;
            if (MODE == 2) {
#pragma unroll
                for (int j = 0; j < 4; ++j) y[j] = v[i][j] * rinv * gv[j];
                *(f32x4*)(dstf + (size_t)row * 1024 + col) = y;
            } else {
                const f32x4 sh = *(const f32x4*)(mods_l + (size_t)mr * 6144 + sh_idx * 1024 + col), sc = *(const f32x4*)(mods_l + (size_t)mr * 6144 + sc_idx * 1024 + col);
#pragma unroll
                for (int j = 0; j < 4; ++j) y[j] = v[i][j] * rinv * gv[j] * (1.0f + sc[j]) + sh[j];
                u32x2 w; w.x = cvt_pk_bf16(y[0], y[1]); w.y = cvt_pk_bf16(y[2], y[3]);
                if (MODE == 0) *(u32x2*)(dstb + (size_t)row * 1024 + col) = w;
                else {
                    int lrow, s;
                    if (row < NLAT) { const int b = row >> 12, t = row & 4095; lrow = b * 256 + (t >> 4); s = t & 15; } else { const int r2 = row - NLAT, b = r2 >> 8, t = r2 & 255; lrow = 1024 + b * 16 + (t >> 4); s = t & 15; }
                    const int g = col >> 4, h2 = col & 15;
                    *(u32x2*)(dstb + ((size_t)g * GROWS + lrow) * 512 + s * 16 + h2) = w;
                }
            }
        }
    }
}

struct AttnFr { bf16x8 k[4]; bf16x8 v[4]; };
__device__ __forceinline__ void attn_load(AttnFr& f, const bf16_t* kp, const bf16_t* vp) {
#pragma unroll
    for (int kk = 0; kk < 4; ++kk) f.k[kk] = *(const bf16x8*)(kp + 16 * kk);
#pragma unroll
    for (int q = 0; q < 4; ++q) f.v[q] = *(const bf16x8*)(vp + q * 512);
}

__device__ __forceinline__ void attn_item(const Params& p, int item) {
    const int lane = otid() & 63, r = lane & 31, h = lane >> 5;
    const bf16_t* Q = (const bf16_t*)(p.ws + O_Q); const bf16_t* Kb = (const bf16_t*)(p.ws + O_K);
    const bf16_t* VT = (const bf16_t*)(p.ws + O_VT); const bf16_t* VTc = (const bf16_t*)(p.ws + O_VTC);
    bf16_t* MIX = (bf16_t*)(p.ws + O_MIX);
    int b, qt, hq, tok0, q0, ntile; bool isctx;
    if (item < 4096) { isctx = false; b = item >> 10; qt = (item >> 3) & 127; hq = item & 7; q0 = qt * 32; tok0 = b * 4096 + q0; ntile = 17; }
    else { const int it = item - 4096; isctx = true; b = it >> 6; qt = (it >> 3) & 7; hq = it & 7; q0 = qt * 32; tok0 = NLAT + b * 256 + q0; ntile = 8; }
    const int kvh = hq >> 2;
    bf16x8 qf[4];
    { const bf16_t* qp = Q + (size_t)(tok0 + r) * 512 + hq * 64 + h * 8;
#pragma unroll
      for (int kk = 0; kk < 4; ++kk) qf[kk] = *(const bf16x8*)(qp + 16 * kk); }
    float mrun = p.sink[hq] * 1.4426950408889634f, lrun = 1.0f;
    f32x16 o0, o1;
#pragma unroll
    for (int i = 0; i < 16; ++i) { o0[i] = 0.f; o1[i] = 0.f; }
    const int qpos = q0 + r;
    auto tile_ptrs = [&](int ti, const bf16_t*& kp, const bf16_t*& vp) {
        if (ti < 8) { kp = Kb + (size_t)(NLAT + b * 256 + 32 * ti + r) * 128 + kvh * 64 + h * 8; vp = VTc + (size_t)((b * 2 + kvh) * 8 + ti) * 2048 + lane * 8; }
        else { const int kbase = q0 - 128 + 32 * (ti - 8); const int kc = kbase < 0 ? 0 : (kbase > 4064 ? 4064 : kbase);
               kp = Kb + (size_t)(b * 4096 + kc + r) * 128 + kvh * 64 + h * 8; vp = VT + (size_t)((b * 2 + kvh) * 128 + (kc >> 5)) * 2048 + lane * 8; }
    };
    AttnFr cur, nxt;
    { const bf16_t *kp, *vp; tile_ptrs(0, kp, vp); attn_load(cur, kp, vp); }
    for (int ti = 0; ti < ntile; ++ti) {
        if (ti + 1 < ntile) { const bf16_t *kp, *vp; tile_ptrs(ti + 1, kp, vp); attn_load(nxt, kp, vp); }
        f32x16 s;
#pragma unroll
        for (int i = 0; i < 16; ++i) s[i] = 0.f;
#pragma unroll
        for (int kk = 0; kk < 4; ++kk) s = __builtin_amdgcn_mfma_f32_32x32x16_bf16(cur.k[kk], qf[kk], s, 0, 0, 0);
        if (ti >= 8) {
            const int kbase = q0 - 128 + 32 * (ti - 8);
            if (ti == 8 || ti == 16 || kbase < 0 || kbase > 4064) {
#pragma unroll
                for (int i = 0; i < 16; ++i) { const int kpos = kbase + (i & 3) + 8 * (i >> 2) + 4 * h; const int d = kpos - qpos; const bool ok = (kpos >= 0) && (kpos < 4096) && (d <= 128) && (d >= -128); s[i] = ok ? s[i] : -1e30f; }
            }
        }
        float mx = s[0];
#pragma unroll
        for (int i = 1; i < 16; ++i) mx = fmaxf(mx, s[i]);
        mx = fmaxf(mx, __shfl_xor(mx, 32));
        const float mnew = fmaxf(mrun, mx), alpha = __builtin_amdgcn_exp2f(mrun - mnew);
        float ps = 0.f; float pv[16];
#pragma unroll
        for (int i = 0; i < 16; ++i) { pv[i] = __builtin_amdgcn_exp2f(s[i] - mnew); ps += pv[i]; }
        ps += __shfl_xor(ps, 32);
        lrun = lrun * alpha + ps;
        if (__builtin_amdgcn_ballot_w64(mnew != mrun) != 0ull) {
#pragma unroll
            for (int i = 0; i < 16; ++i) { o0[i] *= alpha; o1[i] *= alpha; }
        }
        mrun = mnew;
        bf16x8 pf[2];
#pragma unroll
        for (int sidx = 0; sidx < 2; ++sidx) { u32x4 w; w.x = cvt_pk_bf16(pv[8 * sidx + 0], pv[8 * sidx + 1]); w.y = cvt_pk_bf16(pv[8 * sidx + 2], pv[8 * sidx + 3]); w.z = cvt_pk_bf16(pv[8 * sidx + 4], pv[8 * sidx + 5]); w.w = cvt_pk_bf16(pv[8 * sidx + 6], pv[8 * sidx + 7]); pf[sidx] = __builtin_bit_cast(bf16x8, w); }
#pragma unroll
        for (int sidx = 0; sidx < 2; ++sidx) {
            o0 = __builtin_amdgcn_mfma_f32_32x32x16_bf16(cur.v[sidx], pf[sidx], o0, 0, 0, 0);
            o1 = __builtin_amdgcn_mfma_f32_32x32x16_bf16(cur.v[2 + sidx], pf[sidx], o1, 0, 0, 0);
        }
        cur = nxt;
    }
    const float inv = 1.0f / lrun;
    bf16_t* op = MIX + (size_t)(tok0 + r) * 1024 + 512 + hq * 64;
#pragma unroll
    for (int rg = 0; rg < 4; ++rg) {
        const int d0 = 8 * rg + 4 * h;
        u32x2 w0, w1;
        w0.x = cvt_pk_bf16(o0[4 * rg] * inv, o0[4 * rg + 1] * inv); w0.y = cvt_pk_bf16(o0[4 * rg + 2] * inv, o0[4 * rg + 3] * inv);
        w1.x = cvt_pk_bf16(o1[4 * rg] * inv, o1[4 * rg + 1] * inv); w1.y = cvt_pk_bf16(o1[4 * rg + 2] * inv, o1[4 * rg + 3] * inv);
        *(u32x2*)(op + d0) = w0; *(u32x2*)(op + 32 + d0) = w1;
    }
}


__device__ __forceinline__ void phase_dft_combine(const Params& p, LAS float* L) {
    const int tid = otid(); const int G = gridDim.x, bx = obid();
    const bf16_t* I2 = (const bf16_t*)(p.ws + O_I2); bf16_t* MIX = (bf16_t*)(p.ws + O_MIX);
    constexpr float C16[16] = {1.0f, 0.92387953251f, 0.70710678119f, 0.38268343237f, 0.0f, -0.38268343237f, -0.70710678119f, -0.92387953251f, -1.0f, -0.92387953251f, -0.70710678119f, -0.38268343237f, 0.0f, 0.38268343237f, 0.70710678119f, 0.92387953251f};
    constexpr float S16[16] = {0.0f, 0.38268343237f, 0.70710678119f, 0.92387953251f, 1.0f, 0.92387953251f, 0.70710678119f, 0.38268343237f, 0.0f, -0.38268343237f, -0.70710678119f, -0.92387953251f, -1.0f, -0.92387953251f, -0.70710678119f, -0.38268343237f};
    for (int pair = bx; pair < 1024; pair += G) {
        const int b = pair >> 8, kp = pair & 255;
        __syncthreads();
        if (tid < 16) { float s, c; sincospif((float)(kp * tid) / 2048.0f, &s, &c); L[tid] = c; L[16 + tid] = s; }
        __syncthreads();
        const int c = tid;
        const u32x4* pr = (const u32x4*)(I2 + (size_t)kp * 32768 + (size_t)(b * 512 + c) * 16);
        const u32x4* pi = (const u32x4*)(I2 + (size_t)(256 + kp) * 32768 + (size_t)(b * 512 + c) * 16);
        const u32x4 r0 = pr[0], r1 = pr[1], i0 = pi[0], i1 = pi[1];
        const unsigned rw[8] = {r0.x, r0.y, r0.z, r0.w, r1.x, r1.y, r1.z, r1.w}, iw[8] = {i0.x, i0.y, i0.z, i0.w, i1.x, i1.y, i1.z, i1.w};
        float xr[16], xi[16];
#pragma unroll
        for (int r = 0; r < 16; ++r) {
            const float ire = __uint_as_float((r & 1) ? (rw[r >> 1] & 0xFFFF0000u) : (rw[r >> 1] << 16));
            const float iim = __uint_as_float((r & 1) ? (iw[r >> 1] & 0xFFFF0000u) : (iw[r >> 1] << 16));
            const float ct = L[r], st = L[16 + r];
            xr[r] = ire * ct + iim * st; xi[r] = iim * ct - ire * st;
        }
#pragma unroll
        for (int j = 0; j < 16; ++j) {
            float y = 0.f;
#pragma unroll
            for (int r = 0; r < 16; ++r) y += xr[r] * C16[(j * r) & 15] + xi[r] * S16[(j * r) & 15];
            MIX[(size_t)(b * 4096 + kp + 256 * j) * 1024 + c] = f2bf(y * (1.0f / 512.0f));
        }
    }
}

__device__ __forceinline__ void phase_scan(const Params& p, unsigned* gcnt, unsigned* tmo, int first_block) {
    const int tid_ = otid(); const int lane = tid_ & 63, wave = tid_ >> 6;
    const int nb = (int)gridDim.x - first_block, rb = obid() - first_block;
    if (rb < 0) return;
    const bf16_t* S = (const bf16_t*)(p.ws + O_S); bf16_t* A2 = (bf16_t*)(p.ws + O_A2);
    const int nitems = 512;
    for (int item = rb + nb * wave; item < nitems; item += nb * 8) {
        const int b = item >> 7, g = (item >> 1) & 63, dir = item & 1, pp = lane;
        if (gcnt) {
            if (lane == 0) { unsigned sp = 0; while (__hip_atomic_load(gcnt + 64 * g, __ATOMIC_RELAXED, __HIP_MEMORY_SCOPE_AGENT) < 5u) { __builtin_amdgcn_s_sleep(2);
                if ((++sp & 1023u) == 0u) { if (__hip_atomic_load(tmo, __ATOMIC_RELAXED, __HIP_MEMORY_SCOPE_AGENT) != 0u) break; if (sp > (1u << 22)) { atomicAdd(tmo, 1u); break; } } } }
            __builtin_amdgcn_fence(__ATOMIC_ACQUIRE, "agent");
        }
        const float dt = expf(p.log_dt[dir * 64 + g]);
        const float are = p.a_re[(dir * 64 + g) * 64 + pp], aim = p.a_im[(dir * 64 + g) * 64 + pp];
        const float mag = expf(are * dt * 16.0f); float sn, cs; sincosf(aim * dt * 16.0f, &sn, &cs);
        const float ar = mag * cs, ai = mag * sn;
        float hr = 0.f, hi = 0.f;
        const bf16_t* Sg = S + (size_t)g * SROWS * 256 + dir * 128 + pp;
        bf16_t* Ag = A2 + (size_t)g * GROWS * 512 + 256 + dir * 128 + pp;
        for (int i = 0; i < 16; ++i) {
            const int ch = dir ? 15 - i : i; const size_t lrow = 1024 + b * 16 + ch;
            const float sr = __uint_as_float((unsigned)Sg[lrow * 256] << 16), si = __uint_as_float((unsigned)Sg[lrow * 256 + 64] << 16);
            const float nr = ar * hr - ai * hi + sr, ni = ar * hi + ai * hr + si; hr = nr; hi = ni;
        }
        for (int i0 = 0; i0 < 256; i0 += 8) {
            float sr[8], si[8];
#pragma unroll
            for (int j = 0; j < 8; ++j) { const int ch = dir ? 255 - (i0 + j) : (i0 + j); const size_t lrow = b * 256 + ch; sr[j] = __uint_as_float((unsigned)Sg[lrow * 256] << 16); si[j] = __uint_as_float((unsigned)Sg[lrow * 256 + 64] << 16); }
#pragma unroll
            for (int j = 0; j < 8; ++j) {
                const int ch = dir ? 255 - (i0 + j) : (i0 + j); const size_t lrow = b * 256 + ch;
                Ag[lrow * 512] = f2bf(hr); Ag[lrow * 512 + 64] = f2bf(hi);
                const float nr = ar * hr - ai * hi + sr[j], ni = ar * hi + ai * hr + si[j]; hr = nr; hi = ni;
            }
        }
    }
}


#define XB_TMO      128
#define XB_XCNT(j)  (256  + 64 * (j))
#define XB_XSUB(j)  (1280 + 64 * (j))
#define XB_XGEN(j)  (2304 + 64 * (j))
#define XB_TOP      3328
#define XB_TOPGEN   3392
#define XCD_BAR_WORDS 3456
#define XB_SPIN_CAP (1u << 22)
__device__ __forceinline__ unsigned xb_ld(unsigned* p)              { return __hip_atomic_load(p, __ATOMIC_RELAXED, __HIP_MEMORY_SCOPE_AGENT); }
__device__ __forceinline__ unsigned xb_add(unsigned* p, unsigned v) { return __hip_atomic_fetch_add(p, v, __ATOMIC_RELAXED, __HIP_MEMORY_SCOPE_AGENT); }
__device__ __forceinline__ unsigned xb_xcc_id() { return (unsigned)__builtin_amdgcn_s_getreg((3 << 11) | 20) & 0xFu; }
#define XB_SPIN(cond, bar) do { unsigned _sp = 0; while (cond) { __builtin_amdgcn_s_sleep(1); \
    if ((++_sp & 255u) == 0u) { if (xb_ld(&(bar)[XB_TMO])) break; if (_sp > XB_SPIN_CAP) { atomicAdd(&(bar)[XB_TMO], 1u); break; } } } } while (0)
__device__ __forceinline__ unsigned xcd_barrier_complete(unsigned* bar, unsigned x) {
    const unsigned G = gridDim.x;
    unsigned sum, cnt, mine, sp = 0u;
    for (;;) {
        sum = 0u; cnt = 0u; mine = 0u;
        for (unsigned j = 0; j < 16; ++j) { const unsigned c = xb_ld(&bar[XB_XCNT(j)]); sum += c; cnt += (c > 0u) ? 1u : 0u; mine = (j == x) ? c : mine; }
        if (sum == G) break;
        __builtin_amdgcn_s_sleep(1);
        if ((++sp & 255u) == 0u) { if (xb_ld(&bar[XB_TMO])) break; if (sp > XB_SPIN_CAP) { atomicAdd(&bar[XB_TMO], 1u); break; } }
    }
    const unsigned nloc = mine > 0u ? mine : 1u, nx = cnt > 0u ? cnt : 1u;
    return nloc | (nx << 16);
}
__device__ __forceinline__ void xcd_barrier(unsigned* bar, volatile LAS unsigned* st) {
    asm volatile("s_waitcnt vmcnt(0)" ::: "memory");
    __syncthreads();
    if (threadIdx.x == 0) {
        __builtin_amdgcn_s_waitcnt(0);
        const unsigned x = xb_xcc_id();
        unsigned nloc = st[0], nx = st[1];
        if (nloc == 0u) { const unsigned pk = xcd_barrier_complete(bar, x); nloc = pk & 0xFFFFu; nx = pk >> 16; st[0] = nloc; st[1] = nx; }
        const unsigned old = xb_add(&bar[XB_XSUB(x)], 1u);
        const unsigned gen = old / nloc;
        if (old + 1u == (gen + 1u) * nloc) {
            __builtin_amdgcn_fence(__ATOMIC_RELEASE, "agent");
            asm volatile("s_waitcnt vmcnt(0)" ::: "memory");
            const unsigned og = xb_add(&bar[XB_TOP], 1u);
            const unsigned tg = og / nx;
            if (og + 1u == (tg + 1u) * nx) xb_add(&bar[XB_TOPGEN], 1u);
            else XB_SPIN(xb_ld(&bar[XB_TOPGEN]) == tg, bar);
            __builtin_amdgcn_fence(__ATOMIC_ACQUIRE, "agent");
            xb_add(&bar[XB_XGEN(x)], 1u);
            asm volatile("s_waitcnt vmcnt(0)" ::: "memory");
        } else {
            XB_SPIN(xb_ld(&bar[XB_XGEN(x)]) == gen, bar);
            __builtin_amdgcn_fence(__ATOMIC_ACQUIRE, "agent");
            asm volatile("s_waitcnt vmcnt(0)" ::: "memory");
        }
    }
    __syncthreads();
}

__global__ void __launch_bounds__(NT) fwd_megakernel(Params p) {
    extern __shared__ __attribute__((aligned(16))) unsigned char shm[];
    cg::grid_group grid = cg::this_grid();
    LAS unsigned char* lds = (LAS unsigned char*)shm;
    LAS float* L = (LAS float*)shm;
    unsigned char* ws = p.ws;
    const int G = gridDim.x;
    float* mods = (float*)(ws + O_MODS);
    float* hctx = (float*)(ws + O_HCTX);
    bf16_t* XN = (bf16_t*)(ws + O_XN);
    bf16_t* ACT = (bf16_t*)(ws + O_ACT);
    const float* mods1 = mods + 5 * 6144;
    unsigned* bar = (unsigned*)(ws + O_BAR);
    volatile LAS unsigned* bst = (volatile LAS unsigned*)(lds + pg8::STAGE_BYTES);
    if (threadIdx.x < 4) bst[threadIdx.x] = 0u;
    __syncthreads();
    if (threadIdx.x == 0) (void)xb_add(&bar[XB_XCNT(xb_xcc_id())], 1u);
#define GRID_BAR() xcd_barrier(bar, bst)

    {
    phase_p0(p, L, bar + 0, bst + 2);
    }
    grid.sync();
    {
    phase_norm<0>(p.x, p.ctx, NTOK, p.norm_g + 0, mods, 0, 1, XN, nullptr);
    }
    GRID_BAR();
    {
    const int bx = obid();
    {
        const bf16_t* WinA = (const bf16_t*)(ws + O_WINA);
        bf16_t *ZT = (bf16_t*)(ws + O_ZT), *ZTc = (bf16_t*)(ws + O_ZTC), *VT = (bf16_t*)(ws + O_VT), *VTc = (bf16_t*)(ws + O_VTC);
        { pg8::Gemm g1{WinA, XN, 1024, 1024, 16384}; pg8::Sched s1; s1.init(4, 64, G, bx, 3, 1024, 16384);
          EpiInA e1{ZT, ZTc, 0, 1}; pg8::gemm_phase(lds, g1, s1, e1); }
        { pg8::Gemm gb{XN, (const bf16_t*)(ws + O_WINB), 1024, 1024, 1024}; pg8::Sched sb; sb.init(68, 3, G, bx, 0, 1024, 1024);
          EpiInB eb{(bf16_t*)(ws + O_Q), (bf16_t*)(ws + O_K), (const float*)(ws + O_ROPE), (const float*)(ws + O_ROPE) + 1024, VT, VTc}; pg8::gemm_phase(lds, gb, sb, eb); }
        { pg8::Gemm g3{WinA, XN + (size_t)NLAT * 1024, 1024, 1024, 1024}; pg8::Sched s3; s3.init(4, 4, G, (bx + G - (204 % G)) % G, 0, 1024, 1024);
          EpiInA e3{ZT, ZTc, NLAT, 0}; pg8::gemm_phase(lds, g3, s3, e3); }
    }
    }
    GRID_BAR();
    {
    const int bx = obid();
    {
        { pg8::Gemm gd{(const bf16_t*)(ws + O_D256), (const bf16_t*)(ws + O_ZT), 512, 512, 512}; pg8::Sched sd; sd.init(2, 128, G, bx, 0, 512, 512);
          EpiI2 ed{(bf16_t*)(ws + O_I2)}; pg8::gemm_phase(lds, gd, sd, ed); }
        const int wv = bx * 8 + (otid() >> 6), nw = G * 8;
        for (int item = wv; item < 4352; item += nw) attn_item(p, item);
        __syncthreads();
        { pg8::Gemm gc{(const bf16_t*)(ws + O_DC), (const bf16_t*)(ws + O_ZTC), 512, 512, 512}; pg8::Sched sc; sc.init(1, 8, G, (bx + 8) % G, 0, 512, 512);
          EpiDft ec{(bf16_t*)(ws + O_MIX), 1}; pg8::gemm_phase(lds, gc, sc, ec); }
    }
    }
    GRID_BAR();
    phase_dft_combine(p, L);
    GRID_BAR();
    {
    const int bx = obid();
    {
        const bf16_t* MIX = (const bf16_t*)(ws + O_MIX);
        pg8::Gemm g{MIX, (const bf16_t*)(ws + O_WOUT), 1024, 1024, 1024}; pg8::Sched s; s.init(64, 4, G, bx, 0, 1024, 1024);
        if (G == 256) {
            EpiResNorm e{p.x, p.out, mods + 2 * 1024, p.norm_g + 1024, mods, XN, (float*)(ws + O_XSS), (unsigned*)(ws + O_PCNT) + 32, bar + XB_TMO};
            pg8::gemm_phase<EpiResNorm, true>(lds, g, s, e);
            __syncthreads();
        } else {
            EpiRes e{p.x, p.ctx, p.out, hctx, mods + 2 * 1024};
            pg8::gemm_phase(lds, g, s, e);
        }
        pg8::Gemm gc{MIX + (size_t)NLAT * 1024, (const bf16_t*)(ws + O_WOUT), 256, 1024, 1024}; pg8::Sched sc; sc.init(16, 4, G, bx, 2, 1024, 1024);
        EpiPart ec{(float*)(ws + O_XNP)};
        pg8::gemm_phase<EpiPart, false>(lds, gc, sc, ec);
    }
    }
    GRID_BAR();
    {
    phase_norm<0>(p.out, p.ctx, NTOK, p.norm_g + 1024, mods, 3, 4, XN, nullptr, (const float*)(ws + O_XNP), 4, mods + 4 * 6144 + 2 * 1024, hctx, G == 256 ? NLAT : 0);
    }
    GRID_BAR();
    {
    const int bx = obid();
    {
        pg8::Gemm g{XN, (const bf16_t*)(ws + O_WGU0), 1024, 1024, 1024}; pg8::Sched s; s.init(68, 22, G, bx, 0, 1024, 1024);
        EpiSwiglu e{ACT};
        pg8::gemm_phase(lds, g, s, e);
    }
    }
    GRID_BAR();
    {
    const int bx = obid();
    {
        pg8::Gemm g{ACT, (const bf16_t*)(ws + O_WD0), FF, FF, FF}; pg8::Sched s; s.init(64, 4, G, bx, 0, FF, FF);
        EpiRes e{p.out, hctx, p.out, hctx, mods + 5 * 1024};
        pg8::gemm_phase(lds, g, s, e);
        pg8::Gemm gc{ACT + (size_t)NLAT * FF, (const bf16_t*)(ws + O_WD0), 256, FF, FF}; pg8::Sched sc; sc.init(16, 11, G, bx, 2, FF, FF);
        EpiPart ec{(float*)(ws + O_PART)};
        pg8::gemm_phase<EpiPart, false>(lds, gc, sc, ec);
    }
    }
    GRID_BAR();
    {
    phase_norm<1>(p.out, hctx, NTOK, p.norm_g + 2048, mods1, 0, 1, (bf16_t*)(ws + O_A2), nullptr, (const float*)(ws + O_PART), 11, mods + 4 * 6144 + 5 * 1024, nullptr);
    }
    GRID_BAR();
    {
    const int bx = obid();
    {
        pg8::Gemm g{(const bf16_t*)(ws + O_A2), (const bf16_t*)(ws + O_WST), 256, 512, 256}; pg8::Sched s; s.init(5, 64, G, bx, 1, 512, 256);
        EpiState e{(bf16_t*)(ws + O_S)};
        pg8::gemm_phase<EpiState, false>(lds, g, s, e);
        unsigned* gcnt = (unsigned*)(ws + O_PCNT) + 48;
        asm volatile("s_waitcnt vmcnt(0)" ::: "memory");
        __syncthreads();
        if (threadIdx.x == 0) {
            __builtin_amdgcn_fence(__ATOMIC_RELEASE, "agent");
            asm volatile("s_waitcnt vmcnt(0)" ::: "memory");
            for (int L = bx; L < 320; L += G) (void)__hip_atomic_fetch_add(gcnt + 64 * (L / 5), 1u, __ATOMIC_RELAXED, __HIP_MEMORY_SCOPE_AGENT);
        }
        phase_scan(p, gcnt, bar + XB_TMO, G >= 128 ? 320 - G > 0 ? 320 - G : 0 : 0);
    }
    }
    GRID_BAR();
    {
    const int bx = obid();
    {
        pg8::Gemm g{(const bf16_t*)(ws + O_A2), (const bf16_t*)(ws + O_TT), 512, 512, 512}; pg8::Sched s; s.init(4, 64, G, bx, 1, 512, 512);
        EpiSout e{(bf16_t*)(ws + O_GY)};
        pg8::gemm_phase(lds, g, s, e);
    }
    }
    GRID_BAR();
    {
    const int bx = obid();
    {
        pg8::Gemm g{(const bf16_t*)(ws + O_GY), (const bf16_t*)(ws + O_GLU), 1024, 1024, 1024};
        if (G == 256) {
            EpiGluNorm e{p.out, mods1 + 2 * 1024, p.norm_g + 3072, mods1, XN, (float*)(ws + O_S), (unsigned*)(ws + O_PCNT) + 16, bar + XB_TMO};
            pg8::Sched s; s.init(64, 8, G, bx, 4, 1024, 1024); s.nwg = 256;
            pg8::gemm_phase<EpiGluNorm, true>(lds, g, s, e);
            __syncthreads();
            pg8::Sched s2; s2.init(64, 8, G, bx, 4, 1024, 1024); s2.base = 256;
            pg8::gemm_phase<EpiGluNorm, true>(lds, g, s2, e);
        } else {
            pg8::Sched s; s.init(64, 8, G, bx, 0, 1024, 1024);
            EpiGlu e{p.out, mods1 + 2 * 1024};
            pg8::gemm_phase(lds, g, s, e);
        }
    }
    }
    GRID_BAR();
    if (G != 256) {
    phase_norm<0>(p.out, hctx, NLAT, p.norm_g + 3072, mods1, 3, 4, XN, nullptr);
    GRID_BAR();
    }
    {
    const int bx = obid();
    {
        pg8::Gemm g{XN, (const bf16_t*)(ws + O_WGU1), 1024, 1024, 1024}; pg8::Sched s; s.init(64, 22, G, bx, 0, 1024, 1024);
        EpiSwiglu e{ACT};
        pg8::gemm_phase(lds, g, s, e);
    }
    }
    GRID_BAR();
    {
    const int bx = obid();
    {
        pg8::Gemm g{ACT, (const bf16_t*)(ws + O_WD1), FF, FF, FF}; pg8::Sched s; s.init(64, 4, G, bx, 0, FF, FF);
        if (G == 256) {
            EpiResFinal e{p.out, p.out, mods1 + 5 * 1024, p.final_g, (float*)(ws + O_XSS), (unsigned*)(ws + O_PCNT), bar + XB_TMO};
            pg8::gemm_phase<EpiResFinal, true>(lds, g, s, e);
        } else {
            EpiRes e{p.out, hctx, p.out, hctx, mods1 + 5 * 1024};
            pg8::gemm_phase(lds, g, s, e);
        }
    }
    }
    if (G != 256) {
    GRID_BAR();
    phase_norm<2>(p.out, hctx, NLAT, p.final_g, nullptr, 0, 0, nullptr, p.out);
    }
}

extern "C" void kernel_launch(void* const* d_in, const int* in_sizes, int n_in, void* d_out, int out_size, void* d_ws, size_t ws_size, hipStream_t stream) {
    constexpr int kLds = pg8::STAGE_BYTES + 16;
    static int grid_blocks = 0;
    if (grid_blocks == 0) {
        if (n_in != 23 || ws_size < WS_NEED) { fprintf(stderr, "kernel_launch: unexpected n_in %d or workspace %zu < %zu\n", n_in, ws_size, (size_t)WS_NEED); grid_blocks = -1; return; }
        int dev = 0, cus = 0, per_cu = 0;
        hipGetDevice(&dev);
        hipDeviceGetAttribute(&cus, hipDeviceAttributeMultiprocessorCount, dev);
        hipFuncSetAttribute((const void*)fwd_megakernel, hipFuncAttributeMaxDynamicSharedMemorySize, kLds);
        hipOccupancyMaxActiveBlocksPerMultiprocessor(&per_cu, (const void*)fwd_megakernel, NT, kLds);
        if (per_cu < 1) { fprintf(stderr, "kernel_launch: occupancy query says %d blocks/CU\n", per_cu); per_cu = 1; }
        grid_blocks = cus;
        (void)hipGetLastError();
    }
    if (grid_blocks < 0) return;
    if (hipMemsetAsync((char*)d_ws + O_BAR, 0, 16384 + 64 * 256, stream) != hipSuccess) { fprintf(stderr, "kernel_launch: memset of barrier words failed\n"); return; }
    Params p{};
    p.x = (const float*)d_in[0]; p.c = (const float*)d_in[1]; p.ctx = (const float*)d_in[2]; p.c_ctx = (const float*)d_in[3];
    p.mod_w = (const float*)d_in[4]; p.mod_b = (const float*)d_in[5]; p.norm_g = (const float*)d_in[6];
    p.ffn_g = (const float*)d_in[7]; p.ffn_u = (const float*)d_in[8]; p.ffn_d = (const float*)d_in[9];
    p.w_in = (const float*)d_in[10]; p.w_out = (const float*)d_in[11]; p.sink = (const float*)d_in[12];
    p.a_re = (const float*)d_in[13]; p.a_im = (const float*)d_in[14]; p.log_dt = (const float*)d_in[15];
    p.b_re = (const float*)d_in[16]; p.b_im = (const float*)d_in[17]; p.c_re = (const float*)d_in[18]; p.c_im = (const float*)d_in[19];
    p.ssm_d = (const float*)d_in[20]; p.glu_w = (const float*)d_in[21]; p.final_g = (const float*)d_in[22];
    p.out = (float*)d_out; p.ws = (unsigned char*)d_ws;
    void* args[] = {&p};
    hipError_t e = hipLaunchCooperativeKernel((const void*)fwd_megakernel, dim3(grid_blocks), dim3(NT), args, kLds, stream);
    if (e != hipSuccess) fprintf(stderr, "cooperative launch failed: %s (grid %d)\n", hipGetErrorString(e), grid_blocks);
}
```

```cpp
#include <hip/hip_runtime.h>
#include <hip/hip_cooperative_groups.h>
#include <cstdio>
namespace cg = cooperative_groups;

#define LAS __attribute__((address_space(3)))
typedef unsigned short bf16_t;
typedef short bf16x8 __attribute__((ext_vector_type(8)));
typedef float f32x4 __attribute__((ext_vector_type(4)));
typedef float f32x16 __attribute__((ext_vector_type(16)));
typedef unsigned u32x4 __attribute__((ext_vector_type(4)));
typedef unsigned u32x2 __attribute__((ext_vector_type(2)));

constexpr int NT = 512;
constexpr int DM_ = 1024, SEQ_ = 4096, NB_ = 4, CTXL = 256, FF = 2816;
constexpr int NLAT = NB_ * SEQ_;
constexpr int NCTX = NB_ * CTXL;
constexpr int NTOK = NLAT + NCTX;
constexpr int GROWS = 1088;
constexpr int SROWS = 1280;

constexpr size_t MiB = 1u << 20;
constexpr size_t O_WINA = 0;
constexpr size_t O_WINB = O_WINA + 1280ull * 1024 * 2;
constexpr size_t O_WOUT = O_WINB + 768ull * 1024 * 2;
constexpr size_t O_WGU0 = O_WOUT + 1024ull * 1024 * 2;
constexpr size_t O_WD0 = O_WGU0 + 5632ull * 1024 * 2;
constexpr size_t O_WGU1 = O_WD0 + 1024ull * 2816 * 2;
constexpr size_t O_WD1 = O_WGU1 + 5632ull * 1024 * 2;
constexpr size_t O_GLU = O_WD1 + 1024ull * 2816 * 2;
constexpr size_t O_WST = O_GLU + 2048ull * 1024 * 2;
constexpr size_t O_TT = O_WST + 64ull * 256 * 256 * 2;
constexpr size_t O_MODS = O_TT + 64ull * 256 * 512 * 2;
constexpr size_t O_ROPE = O_MODS + 2ull * 5 * 6144 * 4;
constexpr size_t O_DC = O_ROPE + 2ull * 1024 * 4;
constexpr size_t O_HCTX = O_DC + 256ull * 512 * 2;
constexpr size_t O_VTC = O_HCTX + 1024ull * 1024 * 4;
constexpr size_t O_BAR = O_VTC + 4ull * 128 * 256 * 2;
constexpr size_t O_PCNT = O_BAR + 16384;
constexpr size_t O_D256 = O_PCNT + 64ull * 256;
constexpr size_t O_XSS = O_D256 + 512ull * 512 * 2;
constexpr size_t O_RA = 73 * MiB;
static_assert(O_XSS + 16384ull * 4 * 4 <= O_RA, "R_W overflow");
constexpr size_t O_XN = O_RA;
constexpr size_t O_MIX = O_RA + 34 * MiB;
constexpr size_t O_I2 = O_RA + 68 * MiB;
constexpr size_t O_XNP = O_I2;
constexpr size_t O_ZT = O_RA + 100 * MiB;
constexpr size_t O_ZTC = O_RA + 132 * MiB;
constexpr size_t O_Q = O_RA + 134 * MiB;
constexpr size_t O_K = O_RA + 151 * MiB;
constexpr size_t O_VT = O_K + 17408ull * 128 * 2;
constexpr size_t O_ACT = O_RA + 34 * MiB;
constexpr size_t O_A2 = O_RA;
constexpr size_t O_S = O_RA + 69 * MiB;
constexpr size_t O_GY = O_RA + 149 * MiB;
constexpr size_t O_PART = O_RA + 128 * MiB;
constexpr size_t WS_NEED = O_RA + 181 * MiB;

struct Params {
    const float* x; const float* c; const float* ctx; const float* c_ctx; const float* mod_w; const float* mod_b; const float* norm_g;
    const float* ffn_g; const float* ffn_u; const float* ffn_d; const float* w_in; const float* w_out; const float* sink;
    const float* a_re; const float* a_im; const float* log_dt; const float* b_re; const float* b_im; const float* c_re; const float* c_im;
    const float* ssm_d; const float* glu_w; const float* final_g;
    float* out; unsigned char* ws;
};

__device__ __forceinline__ int otid() { int t = threadIdx.x; asm volatile("" : "+v"(t)); return t; }
__device__ __forceinline__ int obid() { int t = blockIdx.x; asm volatile("" : "+s"(t)); return t; }
__device__ __forceinline__ unsigned cvt_pk_bf16(float lo, float hi) { unsigned r; asm volatile("v_cvt_pk_bf16_f32 %0, %1, %2" : "=v"(r) : "v"(lo), "v"(hi)); return r; }
__device__ __forceinline__ bf16_t f2bf(float f) { unsigned u = __float_as_uint(f); u += 0x7FFFu + ((u >> 16) & 1u); return (bf16_t)(u >> 16); }
__device__ __forceinline__ float sigmoidf_(float v) { return __builtin_amdgcn_rcpf(1.0f + __builtin_amdgcn_exp2f(-1.4426950408889634f * v)); }
__device__ __forceinline__ float siluf_(float v) { return v * sigmoidf_(v); }
__device__ __forceinline__ float gelu_tanh(float v) { const float u = 0.7978845608028654f * (v + 0.044715f * v * v * v); return v * sigmoidf_(2.0f * u); }
__device__ __forceinline__ u32x4 pack8(const f32x4 a, const f32x4 b) { u32x4 w; w.x = cvt_pk_bf16(a[0], a[1]); w.y = cvt_pk_bf16(a[2], a[3]); w.z = cvt_pk_bf16(b[0], b[1]); w.w = cvt_pk_bf16(b[2], b[3]); return w; }

namespace pg8 {
constexpr int BM = 256, BK = 64, HALF = 128, HTB = HALF * BK * 2, STAGE_BYTES = 8 * HTB, NXCD = 8, WGM = 8;
__device__ __forceinline__ int lds_byte(int r, int c) { const int st = (r >> 4) * 2 + (c >> 5), rr = r & 15, cc = c & 31, ob = rr * 64 + cc * 2; return st * 1024 + (ob ^ (((ob >> 9) & 1) << 5)); }
__device__ __forceinline__ void stage_rc(int b, int& R, int& C) { const int st = b / 1024, sb = b % 1024, swz = sb ^ (((sb >> 9) & 1) << 5); R = (st >> 1) * 16 + swz / 64; C = (st & 1) * 32 + (swz % 64) / 2; }
__device__ __forceinline__ int perm32(int rho) { const int n = rho >> 4, i = rho & 15; return 8 * (i >> 2) + 4 * n + (i & 3); }

struct Unit { int arow, brow, pm, pn, kofs; size_t aoff, boff; };
struct Gemm { const bf16_t* A; const bf16_t* Bt; int K, lda, ldb; };

struct Sched {
    int nM, nN, nwg, G, c, mode, lda, ldb, base;
    __device__ void init(int nM_, int nN_, int G_, int c_, int mode_, int lda_, int ldb_) { nM = nM_; nN = nN_; nwg = nM_ * nN_; G = G_; c = c_; mode = mode_; lda = lda_; ldb = ldb_; base = 0; }
    __device__ bool next(int i, Unit& u) const {
        const long L = (long)base + (long)i * G + c; if (L >= nwg) return false;
        if (mode == 4) {
            { const int x = (int)L & 7, o = ((int)L & 255) >> 3; u.pm = ((int)L >> 8) * 32 + x * 4 + (o >> 3); u.pn = o & 7; }
            u.arow = u.pm * BM; u.brow = u.pn * BM; u.kofs = 0;
            u.aoff = (size_t)u.arow * lda; u.boff = (size_t)u.brow * ldb; return true;
        }
        if (mode == 0 || mode == 3) {
            int wgid = (int)L; { const int q = nwg / NXCD, r = nwg % NXCD, xcd = wgid % NXCD, off = wgid / NXCD; wgid = (xcd < r ? xcd * (q + 1) : r * (q + 1) + (xcd - r) * q) + off; }
            const int nig = WGM * nN, gid = wgid / nig, fm = gid * WGM, gsz = (nM - fm) < WGM ? (nM - fm) : WGM;
            u.pm = fm + ((wgid % nig) % gsz); u.pn = (wgid % nig) / gsz; u.arow = u.pm * BM; u.brow = u.pn * BM; u.kofs = 0;
        } else if (mode == 1) {
            const int g = (int)L / nM, mi = (int)L % nM; u.pm = mi; u.pn = g; u.arow = g * GROWS + mi * BM; u.brow = g * BM; u.kofs = 0;
        } else {
            const int tile = (int)L % nM, ks = (int)L / nM; u.pm = tile >> 2; u.pn = tile & 3; u.arow = u.pm * BM; u.brow = u.pn * BM; u.kofs = ks * 256;
        }
        u.aoff = (size_t)u.arow * lda + u.kofs;
        u.boff = (mode == 3) ? (size_t)((u.pn >> 4) * 4096 + (u.pn & 15)) * 1024 : (size_t)u.brow * ldb + u.kofs;
        return true;
    }
};

template <class T, class = void> struct epi_after_drain { static constexpr bool value = false; };
template <class T> struct epi_after_drain<T, decltype((void)T::AFTER_DRAIN)> { static constexpr bool value = T::AFTER_DRAIN; };
#ifndef GP_ALIGN
#define GP_ALIGN true
#endif
#ifndef GP_SP2
#define GP_SP2 true
#endif
template <class Epi, bool ALIGN_EPI = GP_ALIGN, bool SP2 = GP_SP2>
__device__ __forceinline__ void gemm_phase(LAS unsigned char* lds, const Gemm g, const Sched& S, const Epi& E) {
    const int tid = otid(), wid = __builtin_amdgcn_readfirstlane(tid >> 6), lane = tid & 63, wr = wid >> 2, wc = wid & 3, fr = lane & 15, fq = lane >> 4;
    const int K = g.K, nt = K / BK;
    unsigned voffA[2], voffB[2];
#pragma unroll
    for (int i = 0; i < 2; ++i) { int R, C; stage_rc(tid * 16 + i * 8192, R, C); const int Rb = (R & ~31) + perm32(R & 31);
        voffA[i] = (unsigned)(R * g.lda + C) * 2u; voffB[i] = (unsigned)(Rb * g.ldb + C) * 2u; }
    const size_t kstep = (size_t)(BK * 2);
    const size_t hstepA = (size_t)HALF * g.lda * 2, hstepB = (size_t)HALF * g.ldb * 2;
    const unsigned ldsw = (unsigned)wid * 1024u;
    const int aoff = lds_byte(wr * 64 + fr, fq * 8), boff = lds_byte(wc * 32 + fr, fq * 8);
#define PG8_SA(b, h) (((b) * 2 + (h)) * HTB)
#define PG8_SB(b, h) ((4 + (b) * 2 + (h)) * HTB)
#define PG8_STAGE(bufoff, gbase, voff) do { _Pragma("unroll") for (int _i = 0; _i < 2; ++_i) \
        __builtin_amdgcn_global_load_lds((const unsigned*)((const char*)(gbase) + (voff)[_i]), (LAS unsigned*)(lds + (bufoff) + ldsw + _i * 8192), 16, 0, 0); } while (0)
#define PG8_LDA(dst, b, h) do { _Pragma("unroll") for (int m = 0; m < 4; ++m) _Pragma("unroll") for (int k = 0; k < 2; ++k) dst[m][k] = *(const LAS bf16x8*)(lds + PG8_SA(b, h) + aoff + m * 2048 + k * 1024); } while (0)
#define PG8_LDB(dst, b, h) do { _Pragma("unroll") for (int n = 0; n < 2; ++n) _Pragma("unroll") for (int k = 0; k < 2; ++k) dst[n][k] = *(const LAS bf16x8*)(lds + PG8_SB(b, h) + boff + n * 2048 + k * 1024); } while (0)
#define PG8_MMA(ai, bj, At, Bt) do { __builtin_amdgcn_s_setprio(1); _Pragma("unroll") for (int m = 0; m < 4; ++m) _Pragma("unroll") for (int n = 0; n < 2; ++n) _Pragma("unroll") for (int k = 0; k < 2; ++k) \
        acc[ai][bj][m][n] = __builtin_amdgcn_mfma_f32_16x16x32_bf16(Bt[n][k], At[m][k], acc[ai][bj][m][n], 0, 0, 0); __builtin_amdgcn_s_setprio(0); } while (0)
#define PG8_WAIT_V(n) asm volatile("s_waitcnt vmcnt(" #n ")" ::: "memory")
#define PG8_WAIT_L(n) asm volatile("s_waitcnt lgkmcnt(" #n ")" ::: "memory")
#define PG8_BAR __builtin_amdgcn_s_barrier()
#define PG8_SCHED __builtin_amdgcn_sched_barrier(0)
    Unit cur, nxt; int ui = 0;
    if (!S.next(0, cur)) return;
    f32x4 acc[2][2][4][2];
#pragma unroll
    for (int a = 0; a < 2; ++a)
#pragma unroll
        for (int b = 0; b < 2; ++b)
#pragma unroll
            for (int m = 0; m < 4; ++m)
#pragma unroll
                for (int n = 0; n < 2; ++n) acc[a][b][m][n] = (f32x4){0.f, 0.f, 0.f, 0.f};
    bf16x8 At[4][2], B0[2][2], B1[2][2];
    const char* cA = (const char*)g.A + cur.aoff * 2; const char* cB = (const char*)g.Bt + cur.boff * 2;
    if constexpr (SP2) {
        PG8_STAGE(PG8_SB(0, 0), cB, voffB); PG8_STAGE(PG8_SB(0, 1), cB + hstepB, voffB); PG8_STAGE(PG8_SA(0, 0), cA, voffA); PG8_STAGE(PG8_SA(0, 1), cA + hstepA, voffA);
        if (wr == 1) PG8_BAR;
        PG8_WAIT_V(2); PG8_BAR;
        PG8_STAGE(PG8_SB(1, 0), cB + kstep, voffB); PG8_STAGE(PG8_SA(1, 0), cA + kstep, voffA); PG8_STAGE(PG8_SB(1, 1), cB + hstepB + kstep, voffB);
        PG8_WAIT_V(6); PG8_BAR;
    } else {
        PG8_STAGE(PG8_SB(0, 0), cB, voffB); PG8_STAGE(PG8_SA(0, 0), cA, voffA); PG8_STAGE(PG8_SB(0, 1), cB + hstepB, voffB); PG8_STAGE(PG8_SA(0, 1), cA + hstepA, voffA);
        if (wr == 1) PG8_BAR;
        PG8_WAIT_V(4); PG8_BAR;
        PG8_STAGE(PG8_SB(1, 0), cB + kstep, voffB); PG8_STAGE(PG8_SA(1, 0), cA + kstep, voffA); PG8_STAGE(PG8_SB(1, 1), cB + hstepB + kstep, voffB);
        PG8_WAIT_V(6); PG8_BAR;
    }
    for (;;) {
        const bool has_next = S.next(ui + 1, nxt);
        const char* nA = has_next ? (const char*)g.A + nxt.aoff * 2 : cA; const char* nB = has_next ? (const char*)g.Bt + nxt.boff * 2 : cB;
        for (int t = 0; t < nt; t += 2) {
            const bool last = (t == nt - 2);
            const char* a1 = cA + (size_t)(t + 1) * kstep;
            const char* a2 = last ? nA : cA + (size_t)(t + 2) * kstep; const char* b2 = last ? nB : cB + (size_t)(t + 2) * kstep;
            const char* a3 = a2 + kstep; const char* b3 = b2 + kstep;
            if constexpr (SP2) {
            PG8_LDB(B0, 0, 0); PG8_LDB(B1, 0, 1); PG8_SCHED; PG8_LDA(At, 0, 0); PG8_STAGE(PG8_SA(1, 1), a1 + hstepA, voffA);
            PG8_WAIT_V(8); PG8_WAIT_L(0); PG8_BAR; PG8_MMA(0, 0, At, B0); PG8_MMA(0, 1, At, B1); PG8_BAR; PG8_SCHED;
            PG8_LDA(At, 0, 1); PG8_STAGE(PG8_SB(0, 0), b2, voffB); PG8_STAGE(PG8_SB(0, 1), b2 + hstepB, voffB); PG8_STAGE(PG8_SA(0, 0), a2, voffA);
            PG8_WAIT_V(8); PG8_WAIT_L(0); PG8_BAR; PG8_MMA(1, 0, At, B0); PG8_MMA(1, 1, At, B1); PG8_BAR; PG8_SCHED;
            PG8_LDB(B0, 1, 0); PG8_LDB(B1, 1, 1); PG8_SCHED; PG8_LDA(At, 1, 0); PG8_STAGE(PG8_SA(0, 1), a2 + hstepA, voffA);
            PG8_WAIT_V(8); PG8_WAIT_L(0); PG8_BAR; PG8_MMA(0, 0, At, B0); PG8_MMA(0, 1, At, B1); PG8_BAR; PG8_SCHED;
            PG8_LDA(At, 1, 1); PG8_STAGE(PG8_SB(1, 0), b3, voffB); PG8_STAGE(PG8_SB(1, 1), b3 + hstepB, voffB); PG8_STAGE(PG8_SA(1, 0), a3, voffA);
            PG8_WAIT_V(8); PG8_WAIT_L(0); PG8_BAR; PG8_MMA(1, 0, At, B0); PG8_MMA(1, 1, At, B1); PG8_BAR; PG8_SCHED;
            } else {
            PG8_LDB(B0, 0, 0); PG8_SCHED; PG8_LDA(At, 0, 0); PG8_STAGE(PG8_SA(1, 1), a1 + hstepA, voffA);
            PG8_WAIT_L(8); PG8_BAR; PG8_WAIT_L(0); PG8_MMA(0, 0, At, B0); PG8_BAR; PG8_SCHED;
            PG8_LDB(B1, 0, 1); PG8_STAGE(PG8_SB(0, 0), b2, voffB);
            PG8_BAR; PG8_WAIT_L(0); PG8_MMA(0, 1, At, B1); PG8_BAR;
            PG8_LDA(At, 0, 1); PG8_STAGE(PG8_SA(0, 0), a2, voffA);
            PG8_BAR; PG8_WAIT_L(0); PG8_MMA(1, 0, At, B0); PG8_BAR; PG8_SCHED;
            PG8_STAGE(PG8_SB(0, 1), b2 + hstepB, voffB);
            PG8_WAIT_V(6); PG8_BAR; PG8_MMA(1, 1, At, B1); PG8_BAR;
            PG8_LDB(B0, 1, 0); PG8_SCHED; PG8_LDA(At, 1, 0); PG8_STAGE(PG8_SA(0, 1), a2 + hstepA, voffA);
            PG8_WAIT_L(8); PG8_BAR; PG8_WAIT_L(0); PG8_MMA(0, 0, At, B0); PG8_BAR; PG8_SCHED;
            PG8_LDB(B1, 1, 1); PG8_STAGE(PG8_SB(1, 0), b3, voffB);
            PG8_BAR; PG8_WAIT_L(0); PG8_MMA(0, 1, At, B1); PG8_BAR;
            PG8_LDA(At, 1, 1); PG8_STAGE(PG8_SA(1, 0), a3, voffA);
            PG8_BAR; PG8_WAIT_L(0); PG8_MMA(1, 0, At, B0); PG8_BAR; PG8_SCHED;
            PG8_STAGE(PG8_SB(1, 1), b3 + hstepB, voffB);
            PG8_WAIT_V(6); PG8_BAR; PG8_MMA(1, 1, At, B1); PG8_BAR;
                    }
        }
        if constexpr (ALIGN_EPI) { if (wr == 0) PG8_BAR; }
        if constexpr (!epi_after_drain<Epi>::value) E(acc, cur, wr, wc, fr, fq);
        if (!has_next) break;
#pragma unroll
        for (int a = 0; a < 2; ++a)
#pragma unroll
            for (int b = 0; b < 2; ++b)
#pragma unroll
                for (int m = 0; m < 4; ++m)
#pragma unroll
                    for (int n = 0; n < 2; ++n) acc[a][b][m][n] = (f32x4){0.f, 0.f, 0.f, 0.f};
        cur = nxt; cA = nA; cB = nB; ++ui;
        if constexpr (ALIGN_EPI) { if (wr == 1) PG8_BAR; }
    }
    PG8_WAIT_V(0);
    if constexpr (!ALIGN_EPI) { if (wr == 0) PG8_BAR; }
    PG8_BAR;
    if constexpr (epi_after_drain<Epi>::value) E.fused(acc, cur, wr, wc, fr, fq, lds, wid, lane);
#undef PG8_SA
#undef PG8_SB
#undef PG8_STAGE
#undef PG8_LDA
#undef PG8_LDB
#undef PG8_MMA
#undef PG8_WAIT_V
#undef PG8_WAIT_L
#undef PG8_BAR
#undef PG8_SCHED
}
}
using pg8::Unit;
typedef f32x4 Acc[2][2][4][2];

struct EpiInA {
    bf16_t *ZT, *ZTc; int tk0, perm;
    __device__ __forceinline__ void operator()(const Acc& acc, const Unit& u, int wr, int wc, int fr, int fq) const {
#pragma unroll
        for (int ai = 0; ai < 2; ++ai)
#pragma unroll
            for (int m = 0; m < 4; ++m) {
                const int r = u.arow + ai * 128 + wr * 64 + m * 16 + fr;
                const int c = r & 511, cs = r >> 9;
#pragma unroll
                for (int bj = 0; bj < 2; ++bj) {
                    const int tk = tk0 + u.brow + bj * 128 + wc * 32 + fq * 8;
                    bf16_t* dst;
                    if (perm) { const int b = tk >> 12, rr = (tk >> 8) & 15, tp = tk & 255; dst = ZT + ((size_t)((b * 512 + c) * 16 + rr) * 512 + cs * 256 + tp); }
                    else { const int b = (tk - NLAT) >> 8, t = tk & 255; dst = ZTc + ((size_t)(b * 512 + c) * 512 + cs * 256 + t); }
                    *(u32x4*)dst = pack8(acc[ai][bj][m][0], acc[ai][bj][m][1]);
                }
            }
    }
};
struct EpiInB {
    bf16_t *Q, *Kb; const float *ropeC, *ropeS; bf16_t *VT, *VTc;
    __device__ __forceinline__ void operator()(const Acc& acc, const Unit& u, int wr, int wc, int fr, int fq) const {
#pragma unroll
        for (int ai = 0; ai < 2; ++ai)
#pragma unroll
            for (int m = 0; m < 4; ++m) {
                const int tok = u.arow + ai * 128 + wr * 64 + m * 16 + fr;
                const bool lat = tok < NLAT; const int pos = tok & 4095, prow = pos >> 6, pcol = pos & 63;
#pragma unroll
                for (int bj = 0; bj < 2; ++bj) {
                    const int col = u.brow + bj * 128 + wc * 32 + fq * 8;
                    f32x4 v0 = acc[ai][bj][m][0], v1 = acc[ai][bj][m][1];
                    if (col >= 640) {
                        const int dv = col - 640, kvh = dv >> 6, d = dv & 63, dt = d >> 5, rl0 = d & 31;
                        int b, t; if (lat) { b = tok >> 12; t = tok & 4095; } else { b = (tok - NLAT) >> 8; t = tok & 255; }
                        const int tile = t >> 5, s = (t >> 4) & 1, k16 = t & 15, hh = (k16 >> 2) & 1, j = ((k16 >> 3) << 2) | (k16 & 3);
                        bf16_t* vb = (lat ? VT + (size_t)((b * 2 + kvh) * 128 + tile) * 2048 : VTc + (size_t)((b * 2 + kvh) * 8 + tile) * 2048) + (dt * 2 + s) * 512 + (hh * 32 + rl0) * 8 + j;
                        const u32x4 w = pack8(v0, v1);
                        vb[0] = (bf16_t)(w.x & 0xFFFFu); vb[8] = (bf16_t)(w.x >> 16); vb[16] = (bf16_t)(w.y & 0xFFFFu); vb[24] = (bf16_t)(w.y >> 16);
                        vb[32] = (bf16_t)(w.z & 0xFFFFu); vb[40] = (bf16_t)(w.z >> 16); vb[48] = (bf16_t)(w.w & 0xFFFFu); vb[56] = (bf16_t)(w.w >> 16);
                        continue;
                    }
                    if (lat) {
                        const int i0 = (col & 63) >> 1, pp = (i0 < 16) ? prow : pcol, f0 = i0 & 15;
                        const f32x4 cs = *(const f32x4*)(ropeC + pp * 16 + f0), sn = *(const f32x4*)(ropeS + pp * 16 + f0);
                        f32x4 w0, w1;
                        w0[0] = v0[0] * cs[0] - v0[1] * sn[0]; w0[1] = v0[0] * sn[0] + v0[1] * cs[0];
                        w0[2] = v0[2] * cs[1] - v0[3] * sn[1]; w0[3] = v0[2] * sn[1] + v0[3] * cs[1];
                        w1[0] = v1[0] * cs[2] - v1[1] * sn[2]; w1[1] = v1[0] * sn[2] + v1[1] * cs[2];
                        w1[2] = v1[2] * cs[3] - v1[3] * sn[3]; w1[3] = v1[2] * sn[3] + v1[3] * cs[3];
                        v0 = w0; v1 = w1;
                    }
                    bf16_t* dst = (col < 512) ? Q + (size_t)tok * 512 + col : Kb + (size_t)tok * 128 + (col - 512);
                    *(u32x4*)dst = pack8(v0, v1);
                }
            }
    }
};
struct EpiDft {
    bf16_t* MIX; int isctx;
    __device__ __forceinline__ void operator()(const Acc& acc, const Unit& u, int wr, int wc, int fr, int fq) const {
#pragma unroll
        for (int ai = 0; ai < 2; ++ai)
#pragma unroll
            for (int m = 0; m < 4; ++m) {
                const int k = u.arow + ai * 128 + wr * 64 + m * 16 + fr;
#pragma unroll
                for (int bj = 0; bj < 2; ++bj) {
                    const int col = u.brow + bj * 128 + wc * 32 + fq * 8; const int b = col >> 9, c = col & 511;
                    const size_t trow = isctx ? (size_t)(NLAT + b * 256 + k) : (size_t)(b * 4096 + k);
                    *(u32x4*)(MIX + trow * 1024 + c) = pack8(acc[ai][bj][m][0], acc[ai][bj][m][1]);
                }
            }
    }
};
struct EpiI2 {
    bf16_t* I2;
    __device__ __forceinline__ void operator()(const Acc& acc, const Unit& u, int wr, int wc, int fr, int fq) const {
#pragma unroll
        for (int ai = 0; ai < 2; ++ai)
#pragma unroll
            for (int m = 0; m < 4; ++m) {
                const int row = u.arow + ai * 128 + wr * 64 + m * 16 + fr;
#pragma unroll
                for (int bj = 0; bj < 2; ++bj) {
                    const int col = u.brow + bj * 128 + wc * 32 + fq * 8;
                    *(u32x4*)(I2 + (size_t)row * 32768 + col) = pack8(acc[ai][bj][m][0], acc[ai][bj][m][1]);
                }
            }
    }
};
struct EpiRes {
    const float *in_lat, *in_ctx; float *out_lat, *out_ctx; const float* gate;
    __device__ __forceinline__ void operator()(const Acc& acc, const Unit& u, int wr, int wc, int fr, int fq) const {
        const int row0 = u.arow + wr * 64 + fr, col0 = u.brow + wc * 32 + fq * 8;
        const bool lat = row0 < NLAT;
        const int b = lat ? (row0 >> 12) : 4;
        const float* ip = lat ? in_lat + (size_t)row0 * 1024 + col0 : in_ctx + (size_t)(row0 - NLAT) * 1024 + col0;
        float* op = lat ? out_lat + (size_t)row0 * 1024 + col0 : out_ctx + (size_t)(row0 - NLAT) * 1024 + col0;
        const float* gp = gate + b * 6144 + col0;
        f32x4 gv[2][2];
#pragma unroll
        for (int bj = 0; bj < 2; ++bj)
#pragma unroll
            for (int n = 0; n < 2; ++n) gv[bj][n] = *(const f32x4*)(gp + bj * 128 + 4 * n);
#pragma unroll
        for (int ai = 0; ai < 2; ++ai)
#pragma unroll
            for (int mh = 0; mh < 2; ++mh) {
                f32x4 hv[2][2][2];
#pragma unroll
                for (int mm = 0; mm < 2; ++mm)
#pragma unroll
                    for (int bj = 0; bj < 2; ++bj)
#pragma unroll
                        for (int n = 0; n < 2; ++n) hv[mm][bj][n] = *(const f32x4*)(ip + (size_t)(ai * 128 + (mh * 2 + mm) * 16) * 1024 + bj * 128 + 4 * n);
#pragma unroll
                for (int mm = 0; mm < 2; ++mm)
#pragma unroll
                    for (int bj = 0; bj < 2; ++bj)
#pragma unroll
                        for (int n = 0; n < 2; ++n) *(f32x4*)(op + (size_t)(ai * 128 + (mh * 2 + mm) * 16) * 1024 + bj * 128 + 4 * n) = hv[mm][bj][n] + gv[bj][n] * acc[ai][bj][mh * 2 + mm][n];
            }
    }
};
struct EpiResFinal {
    static constexpr bool AFTER_DRAIN = true;
    const float* H; float* out; const float* gate; const float* fg; float* xss; unsigned* pcnt; unsigned* tmo;
    __device__ __forceinline__ void fused(Acc& acc, const Unit& u, int wr, int wc, int fr, int fq, LAS unsigned char* lds, int wid, int lane) const {
        LAS float* P = (LAS float*)lds;
        LAS float* S = (LAS float*)(lds + 8192);
        const int row0 = u.arow + wr * 64 + fr, col0 = u.brow + wc * 32 + fq * 8;
        const float* ip = H + (size_t)row0 * 1024 + col0; float* op = out + (size_t)row0 * 1024 + col0;
        const float* gp = gate + (row0 >> 12) * 6144 + col0;
        f32x4 gv[2][2];
#pragma unroll
        for (int bj = 0; bj < 2; ++bj)
#pragma unroll
            for (int n = 0; n < 2; ++n) gv[bj][n] = *(const f32x4*)(gp + bj * 128 + 4 * n);
#pragma unroll
        for (int ai = 0; ai < 2; ++ai)
#pragma unroll
            for (int m = 0; m < 4; ++m) {
                float s = 0.f;
#pragma unroll
                for (int bj = 0; bj < 2; ++bj)
#pragma unroll
                    for (int n = 0; n < 2; ++n) {
                        const f32x4 hv = *(const f32x4*)(ip + (size_t)(ai * 128 + m * 16) * 1024 + bj * 128 + 4 * n);
                        const f32x4 h = hv + gv[bj][n] * acc[ai][bj][m][n]; acc[ai][bj][m][n] = h;
                        s += (h[0] * h[0] + h[1] * h[1]) + (h[2] * h[2] + h[3] * h[3]);
                    }
                s += __shfl_xor(s, 16); s += __shfl_xor(s, 32);
                if (fq == 0) P[(ai * 128 + wr * 64 + m * 16 + fr) * 4 + wc] = s;
            }
        asm volatile("s_waitcnt lgkmcnt(0)" ::: "memory"); __builtin_amdgcn_s_barrier(); asm volatile("" ::: "memory");
        const int row = wid * 32 + (lane & 31);
        if (lane < 32) {
            const float t = (P[row * 4 + 0] + P[row * 4 + 1]) + (P[row * 4 + 2] + P[row * 4 + 3]);
            __hip_atomic_store((unsigned*)xss + ((size_t)(u.arow + row) * 4 + u.pn), __float_as_uint(t), __ATOMIC_RELAXED, __HIP_MEMORY_SCOPE_AGENT);
        }
        asm volatile("s_waitcnt vmcnt(0)" ::: "memory");
        if (lane == 0) __hip_atomic_fetch_add(pcnt + 64 * u.pm, 1u, __ATOMIC_RELAXED, __HIP_MEMORY_SCOPE_AGENT);
        if (wid == 0) {
            unsigned sp = 0;
            while ((unsigned)__builtin_amdgcn_readfirstlane(__hip_atomic_load(pcnt + 64 * u.pm, __ATOMIC_RELAXED, __HIP_MEMORY_SCOPE_AGENT)) < 32u) {
                __builtin_amdgcn_s_sleep(2);
                if ((++sp & 1023u) == 0u) { if (__hip_atomic_load(tmo, __ATOMIC_RELAXED, __HIP_MEMORY_SCOPE_AGENT) != 0u) break; if (sp > (1u << 22)) { if (lane == 0) atomicAdd(tmo, 1u); break; } }
            }
            __builtin_amdgcn_fence(__ATOMIC_ACQUIRE, "agent");
        }
        asm volatile("s_waitcnt vmcnt(0) lgkmcnt(0)" ::: "memory"); __builtin_amdgcn_s_barrier(); asm volatile("" ::: "memory");
        if (lane < 32) {
            const unsigned* slot = (const unsigned*)xss + (size_t)(u.arow + row) * 4; float t = 0.f;
#pragma unroll
            for (int q = 0; q < 4; ++q) t += __uint_as_float(__hip_atomic_load(slot + q, __ATOMIC_RELAXED, __HIP_MEMORY_SCOPE_AGENT));
            S[row] = rsqrtf(t * (1.0f / 1024.0f) + 1e-6f);
        }
        asm volatile("s_waitcnt lgkmcnt(0)" ::: "memory"); __builtin_amdgcn_s_barrier(); asm volatile("" ::: "memory");
        f32x4 fv[2][2];
#pragma unroll
        for (int bj = 0; bj < 2; ++bj)
#pragma unroll
            for (int n = 0; n < 2; ++n) fv[bj][n] = *(const f32x4*)(fg + col0 + bj * 128 + 4 * n);
#pragma unroll
        for (int ai = 0; ai < 2; ++ai)
#pragma unroll
            for (int m = 0; m < 4; ++m) {
                const float rinv = S[ai * 128 + wr * 64 + m * 16 + fr];
#pragma unroll
                for (int bj = 0; bj < 2; ++bj)
#pragma unroll
                    for (int n = 0; n < 2; ++n) *(f32x4*)(op + (size_t)(ai * 128 + m * 16) * 1024 + bj * 128 + 4 * n) = acc[ai][bj][m][n] * rinv * fv[bj][n];
            }
    }
};
struct EpiResNorm {
    static constexpr bool AFTER_DRAIN = true;
    const float* X; float* H; const float* gate; const float* ng; const float* mods_l; bf16_t* XNo; float* xss; unsigned* pcnt; unsigned* tmo;
    __device__ __forceinline__ void fused(Acc& acc, const Unit& u, int wr, int wc, int fr, int fq, LAS unsigned char* lds, int wid, int lane) const {
        LAS float* P = (LAS float*)lds; LAS float* S = (LAS float*)(lds + 8192);
        const int row0 = u.arow + wr * 64 + fr, col0 = u.brow + wc * 32 + fq * 8, b = row0 >> 12;
        const float* ip = X + (size_t)row0 * 1024 + col0; float* op = H + (size_t)row0 * 1024 + col0;
        {
            const float* gp = gate + b * 6144 + col0; f32x4 gv[2][2];
#pragma unroll
            for (int bj = 0; bj < 2; ++bj)
#pragma unroll
                for (int n = 0; n < 2; ++n) gv[bj][n] = *(const f32x4*)(gp + bj * 128 + 4 * n);
#pragma unroll
            for (int ai = 0; ai < 2; ++ai)
#pragma unroll
                for (int m = 0; m < 4; ++m) {
                    float s = 0.f;
#pragma unroll
                    for (int bj = 0; bj < 2; ++bj)
#pragma unroll
                        for (int n = 0; n < 2; ++n) {
                            const f32x4 hv = *(const f32x4*)(ip + (size_t)(ai * 128 + m * 16) * 1024 + bj * 128 + 4 * n);
                            const f32x4 h = hv + gv[bj][n] * acc[ai][bj][m][n]; acc[ai][bj][m][n] = h;
                            *(f32x4*)(op + (size_t)(ai * 128 + m * 16) * 1024 + bj * 128 + 4 * n) = h;
                            s += (h[0] * h[0] + h[1] * h[1]) + (h[2] * h[2] + h[3] * h[3]);
                        }
                    s += __shfl_xor(s, 16); s += __shfl_xor(s, 32);
                    if (fq == 0) P[(ai * 128 + wr * 64 + m * 16 + fr) * 4 + wc] = s;
                }
        }
        asm volatile("s_waitcnt lgkmcnt(0)" ::: "memory"); __builtin_amdgcn_s_barrier(); asm volatile("" ::: "memory");
        const int row = wid * 32 + (lane & 31);
        if (lane < 32) {
            const float t = (P[row * 4 + 0] + P[row * 4 + 1]) + (P[row * 4 + 2] + P[row * 4 + 3]);
            __hip_atomic_store((unsigned*)xss + ((size_t)(u.arow + row) * 4 + u.pn), __float_as_uint(t), __ATOMIC_RELAXED, __HIP_MEMORY_SCOPE_AGENT);
        }
        asm volatile("s_waitcnt vmcnt(0)" ::: "memory");
        if (lane == 0) __hip_atomic_fetch_add(pcnt + 64 * u.pm, 1u, __ATOMIC_RELAXED, __HIP_MEMORY_SCOPE_AGENT);
        if (wid == 0) {
            unsigned sp = 0;
            while ((unsigned)__builtin_amdgcn_readfirstlane(__hip_atomic_load(pcnt + 64 * u.pm, __ATOMIC_RELAXED, __HIP_MEMORY_SCOPE_AGENT)) < 32u) {
                __builtin_amdgcn_s_sleep(2);
                if ((++sp & 1023u) == 0u) { if (__hip_atomic_load(tmo, __ATOMIC_RELAXED, __HIP_MEMORY_SCOPE_AGENT) != 0u) break; if (sp > (1u << 22)) { if (lane == 0) atomicAdd(tmo, 1u); break; } }
            }
            __builtin_amdgcn_fence(__ATOMIC_ACQUIRE, "agent");
        }
        asm volatile("s_waitcnt vmcnt(0) lgkmcnt(0)" ::: "memory"); __builtin_amdgcn_s_barrier(); asm volatile("" ::: "memory");
        if (lane < 32) {
            const unsigned* slot = (const unsigned*)xss + (size_t)(u.arow + row) * 4; float t = 0.f;
#pragma unroll
            for (int q = 0; q < 4; ++q) t += __uint_as_float(__hip_atomic_load(slot + q, __ATOMIC_RELAXED, __HIP_MEMORY_SCOPE_AGENT));
            S[row] = rsqrtf(t * (1.0f / 1024.0f) + 1e-6f);
        }
        asm volatile("s_waitcnt lgkmcnt(0)" ::: "memory"); __builtin_amdgcn_s_barrier(); asm volatile("" ::: "memory");
        bf16_t* xp = XNo + (size_t)row0 * 1024 + col0;
#pragma unroll
        for (int bj = 0; bj < 2; ++bj) {
            f32x4 mv[2], sv[2];
#pragma unroll
            for (int n = 0; n < 2; ++n) { const int c = col0 + bj * 128 + 4 * n; const f32x4 g4 = *(const f32x4*)(ng + c), s4 = *(const f32x4*)(mods_l + (size_t)b * 6144 + 4 * 1024 + c); sv[n] = *(const f32x4*)(mods_l + (size_t)b * 6144 + 3 * 1024 + c);
#pragma unroll
                for (int j = 0; j < 4; ++j) mv[n][j] = g4[j] * (1.0f + s4[j]); }
#pragma unroll
            for (int ai = 0; ai < 2; ++ai)
#pragma unroll
                for (int m = 0; m < 4; ++m) {
                    const float rinv = S[ai * 128 + wr * 64 + m * 16 + fr];
                    const f32x4 y0 = acc[ai][bj][m][0] * rinv * mv[0] + sv[0], y1 = acc[ai][bj][m][1] * rinv * mv[1] + sv[1];
                    *(u32x4*)(xp + (size_t)(ai * 128 + m * 16) * 1024 + bj * 128) = pack8(y0, y1);
                }
        }
    }
};
struct EpiPart {
    bf16_t* slab;
    __device__ __forceinline__ void operator()(const Acc& acc, const Unit& u, int wr, int wc, int fr, int fq) const {
        bf16_t* base = slab + (size_t)(u.kofs >> 8) * 1024 * 1024;
#pragma unroll
        for (int ai = 0; ai < 2; ++ai)
#pragma unroll
            for (int m = 0; m < 4; ++m) {
                const int row = u.arow + ai * 128 + wr * 64 + m * 16 + fr;
                bf16_t* op = base + (size_t)row * 1024;
#pragma unroll
                for (int bj = 0; bj < 2; ++bj) *(u32x4*)(op + u.brow + bj * 128 + wc * 32 + fq * 8) = pack8(acc[ai][bj][m][0], acc[ai][bj][m][1]);
            }
    }
};
struct EpiSwiglu {
    bf16_t* ACT;
    __device__ __forceinline__ void operator()(const Acc& acc, const Unit& u, int wr, int wc, int fr, int fq) const {
#pragma unroll
        for (int ai = 0; ai < 2; ++ai)
#pragma unroll
            for (int m = 0; m < 4; ++m) {
                const int row = u.arow + ai * 128 + wr * 64 + m * 16 + fr;
                const int col = u.pn * 128 + wc * 32 + fq * 8;
                f32x4 o0, o1;
#pragma unroll
                for (int j = 0; j < 4; ++j) { o0[j] = siluf_(acc[ai][0][m][0][j]) * acc[ai][1][m][0][j]; o1[j] = siluf_(acc[ai][0][m][1][j]) * acc[ai][1][m][1][j]; }
                *(u32x4*)(ACT + (size_t)row * FF + col) = pack8(o0, o1);
            }
    }
};
struct EpiGlu {
    float* H; const float* gate;
    __device__ __forceinline__ void operator()(const Acc& acc, const Unit& u, int wr, int wc, int fr, int fq) const {
        const int b = u.arow >> 12; const int col = u.pn * 128 + wc * 32 + fq * 8;
        const float* gp = gate + b * 6144 + col;
        float* hp0 = H + (size_t)(u.arow + wr * 64 + fr) * 1024 + col;
        f32x4 gv[2];
#pragma unroll
        for (int n = 0; n < 2; ++n) gv[n] = *(const f32x4*)(gp + 4 * n);
#pragma unroll
        for (int ai = 0; ai < 2; ++ai) {
            f32x4 hv[4][2];
#pragma unroll
            for (int m = 0; m < 4; ++m)
#pragma unroll
                for (int n = 0; n < 2; ++n) hv[m][n] = *(const f32x4*)(hp0 + (size_t)(ai * 128 + m * 16) * 1024 + 4 * n);
#pragma unroll
            for (int m = 0; m < 4; ++m)
#pragma unroll
                for (int n = 0; n < 2; ++n) {
                    f32x4 o;
#pragma unroll
                    for (int j = 0; j < 4; ++j) o[j] = hv[m][n][j] + gv[n][j] * (acc[ai][0][m][n][j] * sigmoidf_(acc[ai][1][m][n][j]));
                    *(f32x4*)(hp0 + (size_t)(ai * 128 + m * 16) * 1024 + 4 * n) = o;
                }
        }
    }
};
struct EpiGluNorm {
    static constexpr bool AFTER_DRAIN = true;
    float* H; const float* gate; const float* ng; const float* mods_l; bf16_t* XNo; float* xss; unsigned* pcnt; unsigned* tmo;
    __device__ __forceinline__ void fused(Acc& acc, const Unit& u, int wr, int wc, int fr, int fq, LAS unsigned char* lds, int wid, int lane) const {
        LAS float* P = (LAS float*)lds; LAS float* S = (LAS float*)(lds + 8192);
        const int row0 = u.arow + wr * 64 + fr, col = u.pn * 128 + wc * 32 + fq * 8, b = row0 >> 12;
        float* hp = H + (size_t)row0 * 1024 + col;
        {
            const float* gp = gate + b * 6144 + col; f32x4 gv[2];
#pragma unroll
            for (int n = 0; n < 2; ++n) gv[n] = *(const f32x4*)(gp + 4 * n);
#pragma unroll
            for (int ai = 0; ai < 2; ++ai)
#pragma unroll
                for (int m = 0; m < 4; ++m) {
                    float s = 0.f;
#pragma unroll
                    for (int n = 0; n < 2; ++n) {
                        const f32x4 hv = *(const f32x4*)(hp + (size_t)(ai * 128 + m * 16) * 1024 + 4 * n); f32x4 o;
#pragma unroll
                        for (int j = 0; j < 4; ++j) o[j] = hv[j] + gv[n][j] * (acc[ai][0][m][n][j] * sigmoidf_(acc[ai][1][m][n][j]));
                        *(f32x4*)(hp + (size_t)(ai * 128 + m * 16) * 1024 + 4 * n) = o; acc[ai][0][m][n] = o;
                        s += (o[0] * o[0] + o[1] * o[1]) + (o[2] * o[2] + o[3] * o[3]);
                    }
                    s += __shfl_xor(s, 16); s += __shfl_xor(s, 32);
                    if (fq == 0) P[(ai * 128 + wr * 64 + m * 16 + fr) * 4 + wc] = s;
                }
        }
        asm volatile("s_waitcnt lgkmcnt(0)" ::: "memory"); __builtin_amdgcn_s_barrier(); asm volatile("" ::: "memory");
        const int row = wid * 32 + (lane & 31);
        if (lane < 32) {
            const float t = (P[row * 4 + 0] + P[row * 4 + 1]) + (P[row * 4 + 2] + P[row * 4 + 3]);
            __hip_atomic_store((unsigned*)xss + ((size_t)(u.arow + row) * 8 + u.pn), __float_as_uint(t), __ATOMIC_RELAXED, __HIP_MEMORY_SCOPE_AGENT);
        }
        asm volatile("s_waitcnt vmcnt(0)" ::: "memory");
        if (lane == 0) __hip_atomic_fetch_add(pcnt + 64 * u.pm, 1u, __ATOMIC_RELAXED, __HIP_MEMORY_SCOPE_AGENT);
        if (wid == 0) {
            unsigned sp = 0;
            while ((unsigned)__builtin_amdgcn_readfirstlane(__hip_atomic_load(pcnt + 64 * u.pm, __ATOMIC_RELAXED, __HIP_MEMORY_SCOPE_AGENT)) < 64u) {
                __builtin_amdgcn_s_sleep(2);
                if ((++sp & 1023u) == 0u) { if (__hip_atomic_load(tmo, __ATOMIC_RELAXED, __HIP_MEMORY_SCOPE_AGENT) != 0u) break; if (sp > (1u << 22)) { if (lane == 0) atomicAdd(tmo, 1u); break; } }
            }
            __builtin_amdgcn_fence(__ATOMIC_ACQUIRE, "agent");
        }
        asm volatile("s_waitcnt vmcnt(0) lgkmcnt(0)" ::: "memory"); __builtin_amdgcn_s_barrier(); asm volatile("" ::: "memory");
        if (lane < 32) {
            const unsigned* slot = (const unsigned*)xss + (size_t)(u.arow + row) * 8; float t = 0.f;
#pragma unroll
            for (int q = 0; q < 8; ++q) t += __uint_as_float(__hip_atomic_load(slot + q, __ATOMIC_RELAXED, __HIP_MEMORY_SCOPE_AGENT));
            S[row] = rsqrtf(t * (1.0f / 1024.0f) + 1e-6f);
        }
        asm volatile("s_waitcnt lgkmcnt(0)" ::: "memory"); __builtin_amdgcn_s_barrier(); asm volatile("" ::: "memory");
        f32x4 mv[2], sv[2];
#pragma unroll
        for (int n = 0; n < 2; ++n) { const int c = col + 4 * n; const f32x4 g4 = *(const f32x4*)(ng + c), s4 = *(const f32x4*)(mods_l + (size_t)b * 6144 + 4 * 1024 + c); sv[n] = *(const f32x4*)(mods_l + (size_t)b * 6144 + 3 * 1024 + c);
#pragma unroll
            for (int j = 0; j < 4; ++j) mv[n][j] = g4[j] * (1.0f + s4[j]); }
        bf16_t* xp = XNo + (size_t)row0 * 1024 + col;
#pragma unroll
        for (int ai = 0; ai < 2; ++ai)
#pragma unroll
            for (int m = 0; m < 4; ++m) {
                const float rinv = S[ai * 128 + wr * 64 + m * 16 + fr];
                const f32x4 y0 = acc[ai][0][m][0] * rinv * mv[0] + sv[0], y1 = acc[ai][0][m][1] * rinv * mv[1] + sv[1];
                *(u32x4*)(xp + (size_t)(ai * 128 + m * 16) * 1024) = pack8(y0, y1);
            }
    }
};
struct EpiState {
    bf16_t* S;
    __device__ __forceinline__ void operator()(const Acc& acc, const Unit& u, int wr, int wc, int fr, int fq) const {
        bf16_t* base = S + (size_t)u.pn * SROWS * 256;
#pragma unroll
        for (int ai = 0; ai < 2; ++ai)
#pragma unroll
            for (int m = 0; m < 4; ++m) {
                const int lrow = u.pm * 256 + ai * 128 + wr * 64 + m * 16 + fr;
                bf16_t* op = base + (size_t)lrow * 256;
#pragma unroll
                for (int bj = 0; bj < 2; ++bj) *(u32x4*)(op + bj * 128 + wc * 32 + fq * 8) = pack8(acc[ai][bj][m][0], acc[ai][bj][m][1]);
            }
    }
};
struct EpiSout {
    bf16_t* GY;
    __device__ __forceinline__ void operator()(const Acc& acc, const Unit& u, int wr, int wc, int fr, int fq) const {
#pragma unroll
        for (int ai = 0; ai < 2; ++ai)
#pragma unroll
            for (int m = 0; m < 4; ++m) {
                const int lrow = u.pm * 256 + ai * 128 + wr * 64 + m * 16 + fr;
                const int b = lrow >> 8, ch = lrow & 255;
#pragma unroll
                for (int bj = 0; bj < 2; ++bj) {
                    const int n = bj * 128 + wc * 32 + fq * 8; const int t = n >> 4, h0 = n & 15;
                    f32x4 o0, o1;
#pragma unroll
                    for (int j = 0; j < 4; ++j) { o0[j] = gelu_tanh(acc[ai][bj][m][0][j]); o1[j] = gelu_tanh(acc[ai][bj][m][1][j]); }
                    *(u32x4*)(GY + (size_t)(b * 4096 + ch * 16 + t) * 1024 + u.pn * 16 + h0) = pack8(o0, o1);
                }
            }
    }
};

__device__ __forceinline__ void p0_transpose(const float* src, int ld, int K, int c0, bf16_t* dst, float scale, LAS float* tile) {
    const int tid = otid();
    const int lkk = tid >> 7, lcc = tid & 127;
    float r[16];
#pragma unroll
    for (int i = 0; i < 16; ++i) r[i] = __builtin_nontemporal_load(src + (size_t)(lkk + 4 * i) * ld + c0 + lcc);
    for (int k0 = 0; k0 < K; k0 += 64) {
        __syncthreads();
#pragma unroll
        for (int i = 0; i < 16; ++i) tile[(lkk + 4 * i) * 129 + lcc] = r[i];
        if (k0 + 64 < K) {
#pragma unroll
            for (int i = 0; i < 16; ++i) r[i] = __builtin_nontemporal_load(src + (size_t)(k0 + 64 + lkk + 4 * i) * ld + c0 + lcc);
        }
        __syncthreads();
        { const int cc = tid >> 2, kk0 = (tid & 3) * 16; float v[16];
#pragma unroll
          for (int j = 0; j < 16; ++j) v[j] = tile[(kk0 + j) * 129 + cc] * scale;
          u32x4 w0, w1; w0.x = cvt_pk_bf16(v[0], v[1]); w0.y = cvt_pk_bf16(v[2], v[3]); w0.z = cvt_pk_bf16(v[4], v[5]); w0.w = cvt_pk_bf16(v[6], v[7]);
          w1.x = cvt_pk_bf16(v[8], v[9]); w1.y = cvt_pk_bf16(v[10], v[11]); w1.z = cvt_pk_bf16(v[12], v[13]); w1.w = cvt_pk_bf16(v[14], v[15]);
          bf16_t* dp = dst + (size_t)cc * K + k0 + kk0; *(u32x4*)dp = w0; *(u32x4*)(dp + 8) = w1; }
    }
    __syncthreads();
}

__device__ __forceinline__ void p0_s5_item(const Params& p, int g, LAS float* L) {
    const int tid = otid();
    LAS float* pw_re = L;
    LAS float* pw_im = L + 2176;
    LAS float* bb_re = L + 4352;
    LAS float* bb_im = L + 6400;
    LAS float* cc_re = L + 8448;
    LAS float* cc_im = L + 10528;
    LAS float* Kt = L + 12608;
    __syncthreads();
    if (tid < 128) {
        const int dir = tid >> 6, pp = tid & 63;
        const float dt = expf(p.log_dt[dir * 64 + g]);
        const float are = p.a_re[(dir * 64 + g) * 64 + pp], aim = p.a_im[(dir * 64 + g) * 64 + pp];
        for (int tau = 0; tau <= 16; ++tau) {
            const float mag = expf(are * dt * (float)tau); float s, c; sincosf(aim * dt * (float)tau, &s, &c);
            pw_re[(dir * 64 + pp) * 17 + tau] = mag * c; pw_im[(dir * 64 + pp) * 17 + tau] = mag * s;
        }
        const float abr = pw_re[(dir * 64 + pp) * 17 + 1], abi = pw_im[(dir * 64 + pp) * 17 + 1];
        const float nr = abr - 1.0f, ni = abi, den = are * are + aim * aim;
        const float fre = (nr * are + ni * aim) / den, fim = (ni * are - nr * aim) / den;
        for (int h = 0; h < 16; ++h) {
            const float br = p.b_re[((size_t)(dir * 64 + g) * 64 + pp) * 16 + h], bi = p.b_im[((size_t)(dir * 64 + g) * 64 + pp) * 16 + h];
            bb_re[(dir * 64 + pp) * 16 + h] = fre * br - fim * bi; bb_im[(dir * 64 + pp) * 16 + h] = fre * bi + fim * br;
        }
    }
    for (int idx = tid; idx < 2048; idx += NT) {
        const int dir = idx >> 10, h = (idx >> 6) & 15, pp = idx & 63;
        cc_re[(dir * 16 + h) * 65 + pp] = p.c_re[((size_t)(dir * 64 + g) * 16 + h) * 64 + pp]; cc_im[(dir * 16 + h) * 65 + pp] = p.c_im[((size_t)(dir * 64 + g) * 16 + h) * 64 + pp];
    }
    __syncthreads();
    {
        const int dir = tid >> 8, tau = (tid >> 4) & 15, h = tid & 15;
        float a[16];
#pragma unroll
        for (int j = 0; j < 16; ++j) a[j] = 0.f;
        for (int pp = 0; pp < 64; ++pp) {
            const float cr = cc_re[(dir * 16 + h) * 65 + pp], ci = cc_im[(dir * 16 + h) * 65 + pp];
            const float pr = pw_re[(dir * 64 + pp) * 17 + tau], pi = pw_im[(dir * 64 + pp) * 17 + tau];
            const float xr = cr * pr - ci * pi, xi = cr * pi + ci * pr;
#pragma unroll
            for (int j = 0; j < 16; ++j) a[j] += xr * bb_re[(dir * 64 + pp) * 16 + j] - xi * bb_im[(dir * 64 + pp) * 16 + j];
        }
#pragma unroll
        for (int j = 0; j < 16; ++j) Kt[tid * 16 + j] = a[j];
    }
    __syncthreads();
    bf16_t* Wst = (bf16_t*)(p.ws + O_WST) + (size_t)g * 256 * 256;
    for (int ch = tid; ch < 8192; ch += NT) {
        const int n = ch >> 5, k0 = (ch & 31) * 8; const int dir = n >> 7, ri = (n >> 6) & 1, pp = n & 63, s = k0 >> 4, h0 = k0 & 15; const int e = dir ? s : 15 - s;
        const float pr = pw_re[(dir * 64 + pp) * 17 + e], pi = pw_im[(dir * 64 + pp) * 17 + e];
        float v[8];
#pragma unroll
        for (int j = 0; j < 8; ++j) { const float br = bb_re[(dir * 64 + pp) * 16 + h0 + j], bi = bb_im[(dir * 64 + pp) * 16 + h0 + j]; v[j] = ri ? (pr * bi + pi * br) : (pr * br - pi * bi); }
        u32x4 w; w.x = cvt_pk_bf16(v[0], v[1]); w.y = cvt_pk_bf16(v[2], v[3]); w.z = cvt_pk_bf16(v[4], v[5]); w.w = cvt_pk_bf16(v[6], v[7]);
        *(u32x4*)(Wst + (size_t)n * 256 + k0) = w;
    }
    bf16_t* Tt = (bf16_t*)(p.ws + O_TT) + (size_t)g * 256 * 512;
    for (int ch = tid; ch < 16384; ch += NT) {
        const int n = ch >> 6, k0 = (ch & 63) * 8; const int t = n >> 4, h = n & 15; float v[8];
        if (k0 < 256) {
            const int s = k0 >> 4, h0 = k0 & 15;
#pragma unroll
            for (int j = 0; j < 8; ++j) {
                float x = 0.f;
                if (s <= t) x += Kt[((0 * 16 + (t - s)) * 16 + h) * 16 + h0 + j];
                if (s >= t) x += Kt[((1 * 16 + (s - t)) * 16 + h) * 16 + h0 + j];
                if (s == t && h == h0 + j) x += p.ssm_d[g * 16 + h];
                v[j] = x;
            }
        } else {
            const int kk = k0 - 256, dir = kk >> 7, ri = (kk >> 6) & 1, p0 = kk & 63; const int e = dir ? 16 - t : t + 1;
#pragma unroll
            for (int j = 0; j < 8; ++j) {
                const int pp = p0 + j;
                const float cr = cc_re[(dir * 16 + h) * 65 + pp], ci = cc_im[(dir * 16 + h) * 65 + pp], pr = pw_re[(dir * 64 + pp) * 17 + e], pi = pw_im[(dir * 64 + pp) * 17 + e];
                v[j] = ri ? -(cr * pi + ci * pr) : (cr * pr - ci * pi);
            }
        }
        u32x4 w; w.x = cvt_pk_bf16(v[0], v[1]); w.y = cvt_pk_bf16(v[2], v[3]); w.z = cvt_pk_bf16(v[4], v[5]); w.w = cvt_pk_bf16(v[6], v[7]);
        *(u32x4*)(Tt + (size_t)n * 512 + k0) = w;
    }
    __syncthreads();
}

__device__ __forceinline__ void p0_adaln_item(const Params& p, int it, LAS float* L) {
    const int tid = otid(); const int l = it / 96, n0 = (it % 96) * 64;
    LAS float* sc = L;
    LAS float* red = L + 5120;
    __syncthreads();
    for (int idx = tid; idx < 5120; idx += NT) { const int r = idx >> 10, k = idx & 1023; const float v = (r < 4) ? p.c[r * 1024 + k] : p.c_ctx[k]; sc[idx] = siluf_(v); }
    __syncthreads();
    const int n = tid & 63, kq = tid >> 6; float a[5] = {0.f, 0.f, 0.f, 0.f, 0.f};
    const float* wp = p.mod_w + (size_t)l * 1024 * 6144 + n0 + n;
    for (int k = kq; k < 1024; k += 128) {
        float w[16];
#pragma unroll
        for (int u = 0; u < 16; ++u) w[u] = __builtin_nontemporal_load(wp + (size_t)(k + 8 * u) * 6144);
#pragma unroll
        for (int u = 0; u < 16; ++u)
#pragma unroll
            for (int r = 0; r < 5; ++r) a[r] += sc[r * 1024 + k + 8 * u] * w[u];
    }
#pragma unroll
    for (int r = 0; r < 5; ++r) red[(kq * 5 + r) * 64 + n] = a[r];
    __syncthreads();
    if (tid < 320) { const int r = tid >> 6, nn = tid & 63; float s = p.mod_b[l * 6144 + n0 + nn];
#pragma unroll
        for (int q = 0; q < 8; ++q) s += red[(q * 5 + r) * 64 + nn];
        ((float*)(p.ws + O_MODS))[(size_t)(l * 5 + r) * 6144 + n0 + nn] = s; }
    __syncthreads();
}

__device__ __forceinline__ void p0_fold_item(const Params& p, int it, LAS float* L) {
    const int tid = otid(); const int grp = it >> 4, kt = it & 15;
    LAS float* w = L;
    LAS float* cT = L + 4160;
    LAS float* sT = L + 4224;
    __syncthreads();
#pragma unroll
    for (int i = 0; i < 8; ++i) { const int idx = tid + i * NT, kk = idx >> 6, j = idx & 63; w[kk * 65 + j] = p.w_in[(size_t)(kt * 64 + kk) * 1280 + grp * 64 + j]; }
    if (tid < 64) { cT[tid] = cospif((float)tid / 32.0f); sT[tid] = sinpif((float)tid / 32.0f); }
    __syncthreads();
    const int kk = tid & 63, q = tid >> 6; bf16_t* WinA = (bf16_t*)(p.ws + O_WINA);
    for (int i = 0; i < 8; ++i) {
        const int n = q + 8 * i; float ac = 0.f, as = 0.f; int ph = 0;
        for (int j = 0; j < 64; ++j) { const float wv = w[kk * 65 + j]; ac += wv * cT[ph]; as += wv * sT[ph]; ph = (ph + n) & 63; }
        WinA[(size_t)(grp * 64 + n) * 1024 + kt * 64 + kk] = f2bf(ac);
        WinA[(size_t)(512 + grp * 64 + n) * 1024 + kt * 64 + kk] = f2bf(as);
    }
    __syncthreads();
}

__device__ __forceinline__ void p0_dft_item(const Params& p, int it, LAS float* L) {
    const int tid = otid();
    __syncthreads();
    for (int i = tid; i < 256; i += NT) L[i] = cospif((float)i / 128.0f);
    __syncthreads();
    if (it == 0) {
        bf16_t* D = (bf16_t*)(p.ws + O_D256);
        for (int idx = tid; idx < 512 * 512; idx += NT) {
            const int row = idx >> 9, col = idx & 511; const int ro = row >> 8, k = row & 255, cs = col >> 8, t = col & 255; const int ph = (k * t) & 255;
            const float C = L[ph], S = L[(ph - 64) & 255];
            const float v = ro == 0 ? (cs == 0 ? C : -S) : (cs == 0 ? -S : -C);
            D[idx] = f2bf(v);
        }
    } else {
        bf16_t* Dc = (bf16_t*)(p.ws + O_DC);
        for (int idx = tid; idx < 256 * 512; idx += NT) {
            const int k = idx >> 9, j = idx & 511, t = j & 255, cs = j >> 8; const int ph = (k * t) & 255;
            Dc[idx] = f2bf((cs ? -L[(ph - 64) & 255] : L[ph]) * (1.0f / 128.0f));
        }
    }
    __syncthreads();
}

constexpr int P0_S5 = 64, P0_ADA = 192, P0_FOLD = 128, P0_TR = 134, P0_DFT = 2, P0_MISC = 1;
constexpr int P0_ITEMS = P0_S5 + P0_ADA + P0_FOLD + P0_TR + P0_DFT + P0_MISC;

__device__ __forceinline__ void p0_transpose_dispatch(const Params& p, int it, LAS float* L) {
    unsigned char* ws = p.ws;
    const float* src; int ld, K, c0; bf16_t* dst; float scale = 1.0f;
    if (it < 16) { const int l = it >> 3; it &= 7; src = p.ffn_d + (size_t)l * FF * 1024; ld = 1024; K = FF; c0 = 128 * it; dst = (bf16_t*)(ws + (l ? O_WD1 : O_WD0)) + (size_t)(128 * it) * FF; }
    else {
        it -= 16;
        if (it < 4) { src = p.w_in; ld = 1280; K = 1024; c0 = 512 + 128 * it; dst = (bf16_t*)(ws + O_WINB) + (size_t)(128 * it) * 1024; scale = 0.125f * 1.4426950408889634f; }
        else if (it < 5) { src = p.w_in; ld = 1280; K = 1024; c0 = 1024; dst = (bf16_t*)(ws + O_WINB) + (size_t)512 * 1024; }
        else if (it < 6) { src = p.w_in; ld = 1280; K = 1024; c0 = 1152; dst = (bf16_t*)(ws + O_WINB) + (size_t)640 * 1024; }
        else if (it < 14) { it -= 6; src = p.w_out; ld = 1024; K = 1024; c0 = 128 * it; dst = (bf16_t*)(ws + O_WOUT) + (size_t)(128 * it) * 1024; }
        else if (it < 14 + 88) {
            it -= 14; const int l = it / 44; it -= l * 44;
            bf16_t* wgu = (bf16_t*)(ws + (l ? O_WGU1 : O_WGU0));
            const int up = it / 22, tile = it % 22;
            src = (up ? p.ffn_u : p.ffn_g) + (size_t)l * 1024 * FF; ld = FF; K = 1024; c0 = 128 * tile; dst = wgu + (size_t)(tile * 256 + up * 128) * 1024;
        } else {
            it -= 102; c0 = 128 * it; const int half = c0 >> 10, j = c0 & 1023;
            src = p.glu_w; ld = 2048; K = 1024; dst = (bf16_t*)(ws + O_GLU) + (size_t)((j >> 7) * 256 + half * 128) * 1024;
        }
    }
    p0_transpose(src, ld, K, c0, dst, scale, L);
}

__device__ __forceinline__ void p0_misc(const Params& p) {
    const int tid = otid();
    float* rc = (float*)(p.ws + O_ROPE); float* rs = rc + 1024;
    for (int i = tid; i < 1024; i += NT) { const int pp = i >> 4, f = i & 15; const float inv = powf(10000.0f, -(float)f / 16.0f); const float ang = (float)pp * inv; float s, c; sincosf(ang, &s, &c); rc[i] = c; rs[i] = s; }
}

__device__ __forceinline__ void p0_dispatch(const Params& p, int it, LAS float* L) {
    int i = it;
    if (i < 64) { p0_s5_item(p, i, L); return; } i -= 64;
    if (i < 16) { p0_transpose_dispatch(p, i, L); return; } i -= 16;
    if (i < 128) { p0_fold_item(p, i, L); return; } i -= 128;
    if (i < 118) { p0_transpose_dispatch(p, 16 + i, L); return; } i -= 118;
    if (i < 192) { p0_adaln_item(p, i, L); return; } i -= 192;
    if (i < 2) { p0_dft_item(p, i, L); return; } i -= 2;
    p0_misc(p);
}
__device__ __forceinline__ void phase_p0(const Params& p, LAS float* L, unsigned* qhead, volatile LAS unsigned* qslot) {
    for (;;) {
        __syncthreads();
        if (threadIdx.x == 0) qslot[0] = __hip_atomic_fetch_add(qhead, 1u, __ATOMIC_RELAXED, __HIP_MEMORY_SCOPE_AGENT);
        __syncthreads();
        const int it = (int)qslot[0];
        if (it >= P0_ITEMS) break;
        p0_dispatch(p, it, L);
    }
}

template <int MODE>
__device__ __forceinline__ void phase_norm(const float* src_lat, const float* src_ctx, int nrows, const float* ng, const float* mods_l, int sh_idx, int sc_idx, bf16_t* dstb, float* dstf,
                                           const bf16_t* part = nullptr, int npart = 0, const float* pgate = nullptr, float* hstore = nullptr, int row_first = 0) {
    const int tid_ = otid(); const int lane = tid_ & 63, wv = obid() * 8 + (tid_ >> 6), nw = gridDim.x * 8;
    for (int row = row_first + wv; row < nrows; row += nw) {
        const float* sp; int mr;
        if (row < NLAT) { sp = src_lat + (size_t)row * 1024; mr = row >> 12; } else { sp = src_ctx + (size_t)(row - NLAT) * 1024; mr = 4; }
        f32x4 v[4]; float ss = 0.f;
#pragma unroll
        for (int i = 0; i < 4; ++i) v[i] = *(const f32x4*)(sp + i * 256 + lane * 4);
        if (npart > 0 && row >= NLAT) {
#pragma unroll
            for (int i = 0; i < 4; ++i) {
                const int col = i * 256 + lane * 4; f32x4 s = {0.f, 0.f, 0.f, 0.f};
#pragma unroll 2
                for (int k = 0; k < npart; ++k) { const u32x2 w = *(const u32x2*)(part + ((size_t)k * 1024 + (row - NLAT)) * 1024 + col);
                    s[0] += __uint_as_float(w.x << 16); s[1] += __uint_as_float(w.x & 0xFFFF0000u); s[2] += __uint_as_float(w.y << 16); s[3] += __uint_as_float(w.y & 0xFFFF0000u); }
                v[i] += *(const f32x4*)(pgate + col) * s;
                if (hstore) *(f32x4*)(hstore + (size_t)(row - NLAT) * 1024 + col) = v[i];
            }
        }
#pragma unroll
        for (int i = 0; i < 4; ++i) ss += v[i][0] * v[i][0] + v[i][1] * v[i][1] + v[i][2] * v[i][2] + v[i][3] * v[i][3];
#pragma unroll
        for (int o = 32; o >= 1; o >>= 1) ss += __shfl_xor(ss, o);
        const float rinv = rsqrtf(ss * (1.0f / 1024.0f) + 1e-6f);
#pragma unroll
        for (int i = 0; i < 4; ++i) {
            const int col = i * 256 + lane * 4; const f32x4 gv = *(const f32x4*)(ng + col); f32x4 y;
            if (MODE == 2) {
#pragma unroll
                for (int j = 0; j < 4; ++j) y[j] = v[i][j] * rinv * gv[j];
                *(f32x4*)(dstf + (size_t)row * 1024 + col) = y;
            } else {
                const f32x4 sh = *(const f32x4*)(mods_l + (size_t)mr * 6144 + sh_idx * 1024 + col), sc = *(const f32x4*)(mods_l + (size_t)mr * 6144 + sc_idx * 1024 + col);
#pragma unroll
                for (int j = 0; j < 4; ++j) y[j] = v[i][j] * rinv * gv[j] * (1.0f + sc[j]) + sh[j];
                u32x2 w; w.x = cvt_pk_bf16(y[0], y[1]); w.y = cvt_pk_bf16(y[2], y[3]);
                if (MODE == 0) *(u32x2*)(dstb + (size_t)row * 1024 + col) = w;
                else {
                    int lrow, s;
                    if (row < NLAT) { const int b = row >> 12, t = row & 4095; lrow = b * 256 + (t >> 4); s = t & 15; } else { const int r2 = row - NLAT, b = r2 >> 8, t = r2 & 255; lrow = 1024 + b * 16 + (t >> 4); s = t & 15; }
                    const int g = col >> 4, h2 = col & 15;
                    *(u32x2*)(dstb + ((size_t)g * GROWS + lrow) * 512 + s * 16 + h2) = w;
                }
            }
        }
    }
}

struct AttnFr { bf16x8 k[4]; bf16x8 v[4]; };
__device__ __forceinline__ void attn_load(AttnFr& f, const bf16_t* kp, const bf16_t* vp) {
#pragma unroll
    for (int kk = 0; kk < 4; ++kk) f.k[kk] = *(const bf16x8*)(kp + 16 * kk);
#pragma unroll
    for (int q = 0; q < 4; ++q) f.v[q] = *(const bf16x8*)(vp + q * 512);
}

__device__ __forceinline__ void attn_item(const Params& p, int item) {
    const int lane = otid() & 63, r = lane & 31, h = lane >> 5;
    const bf16_t* Q = (const bf16_t*)(p.ws + O_Q); const bf16_t* Kb = (const bf16_t*)(p.ws + O_K);
    const bf16_t* VT = (const bf16_t*)(p.ws + O_VT); const bf16_t* VTc = (const bf16_t*)(p.ws + O_VTC);
    bf16_t* MIX = (bf16_t*)(p.ws + O_MIX);
    int b, qt, hq, tok0, q0, ntile; bool isctx;
    if (item < 4096) { isctx = false; b = item >> 10; qt = (item >> 3) & 127; hq = item & 7; q0 = qt * 32; tok0 = b * 4096 + q0; ntile = 17; }
    else { const int it = item - 4096; isctx = true; b = it >> 6; qt = (it >> 3) & 7; hq = it & 7; q0 = qt * 32; tok0 = NLAT + b * 256 + q0; ntile = 8; }
    const int kvh = hq >> 2;
    bf16x8 qf[4];
    { const bf16_t* qp = Q + (size_t)(tok0 + r) * 512 + hq * 64 + h * 8;
#pragma unroll
      for (int kk = 0; kk < 4; ++kk) qf[kk] = *(const bf16x8*)(qp + 16 * kk); }
    float mrun = p.sink[hq] * 1.4426950408889634f, lrun = 1.0f;
    f32x16 o0, o1;
#pragma unroll
    for (int i = 0; i < 16; ++i) { o0[i] = 0.f; o1[i] = 0.f; }
    const int qpos = q0 + r;
    auto tile_ptrs = [&](int ti, const bf16_t*& kp, const bf16_t*& vp) {
        if (ti < 8) { kp = Kb + (size_t)(NLAT + b * 256 + 32 * ti + r) * 128 + kvh * 64 + h * 8; vp = VTc + (size_t)((b * 2 + kvh) * 8 + ti) * 2048 + lane * 8; }
        else { const int kbase = q0 - 128 + 32 * (ti - 8); const int kc = kbase < 0 ? 0 : (kbase > 4064 ? 4064 : kbase);
               kp = Kb + (size_t)(b * 4096 + kc + r) * 128 + kvh * 64 + h * 8; vp = VT + (size_t)((b * 2 + kvh) * 128 + (kc >> 5)) * 2048 + lane * 8; }
    };
    AttnFr cur, nxt;
    { const bf16_t *kp, *vp; tile_ptrs(0, kp, vp); attn_load(cur, kp, vp); }
    for (int ti = 0; ti < ntile; ++ti) {
        if (ti + 1 < ntile) { const bf16_t *kp, *vp; tile_ptrs(ti + 1, kp, vp); attn_load(nxt, kp, vp); }
        f32x16 s;
#pragma unroll
        for (int i = 0; i < 16; ++i) s[i] = 0.f;
#pragma unroll
        for (int kk = 0; kk < 4; ++kk) s = __builtin_amdgcn_mfma_f32_32x32x16_bf16(cur.k[kk], qf[kk], s, 0, 0, 0);
        if (ti >= 8) {
            const int kbase = q0 - 128 + 32 * (ti - 8);
            if (ti == 8 || ti == 16 || kbase < 0 || kbase > 4064) {
#pragma unroll
                for (int i = 0; i < 16; ++i) { const int kpos = kbase + (i & 3) + 8 * (i >> 2) + 4 * h; const int d = kpos - qpos; const bool ok = (kpos >= 0) && (kpos < 4096) && (d <= 128) && (d >= -128); s[i] = ok ? s[i] : -1e30f; }
            }
        }
        float mx = s[0];
#pragma unroll
        for (int i = 1; i < 16; ++i) mx = fmaxf(mx, s[i]);
        mx = fmaxf(mx, __shfl_xor(mx, 32));
        const float mnew = fmaxf(mrun, mx), alpha = __builtin_amdgcn_exp2f(mrun - mnew);
        float ps = 0.f; float pv[16];
#pragma unroll
        for (int i = 0; i < 16; ++i) { pv[i] = __builtin_amdgcn_exp2f(s[i] - mnew); ps += pv[i]; }
        ps += __shfl_xor(ps, 32);
        lrun = lrun * alpha + ps;
        if (__builtin_amdgcn_ballot_w64(mnew != mrun) != 0ull) {
#pragma unroll
            for (int i = 0; i < 16; ++i) { o0[i] *= alpha; o1[i] *= alpha; }
        }
        mrun = mnew;
        bf16x8 pf[2];
#pragma unroll
        for (int sidx = 0; sidx < 2; ++sidx) { u32x4 w; w.x = cvt_pk_bf16(pv[8 * sidx + 0], pv[8 * sidx + 1]); w.y = cvt_pk_bf16(pv[8 * sidx + 2], pv[8 * sidx + 3]); w.z = cvt_pk_bf16(pv[8 * sidx + 4], pv[8 * sidx + 5]); w.w = cvt_pk_bf16(pv[8 * sidx + 6], pv[8 * sidx + 7]); pf[sidx] = __builtin_bit_cast(bf16x8, w); }
#pragma unroll
        for (int sidx = 0; sidx < 2; ++sidx) {
            o0 = __builtin_amdgcn_mfma_f32_32x32x16_bf16(cur.v[sidx], pf[sidx], o0, 0, 0, 0);
            o1 = __builtin_amdgcn_mfma_f32_32x32x16_bf16(cur.v[2 + sidx], pf[sidx], o1, 0, 0, 0);
        }
        cur = nxt;
    }
    const float inv = 1.0f / lrun;
    bf16_t* op = MIX + (size_t)(tok0 + r) * 1024 + 512 + hq * 64;
#pragma unroll
    for (int rg = 0; rg < 4; ++rg) {
        const int d0 = 8 * rg + 4 * h;
        u32x2 w0, w1;
        w0.x = cvt_pk_bf16(o0[4 * rg] * inv, o0[4 * rg + 1] * inv); w0.y = cvt_pk_bf16(o0[4 * rg + 2] * inv, o0[4 * rg + 3] * inv);
        w1.x = cvt_pk_bf16(o1[4 * rg] * inv, o1[4 * rg + 1] * inv); w1.y = cvt_pk_bf16(o1[4 * rg + 2] * inv, o1[4 * rg + 3] * inv);
        *(u32x2*)(op + d0) = w0; *(u32x2*)(op + 32 + d0) = w1;
    }
}


__device__ __forceinline__ void phase_dft_combine(const Params& p, LAS float* L) {
    const int tid = otid(); const int G = gridDim.x, bx = obid();
    const bf16_t* I2 = (const bf16_t*)(p.ws + O_I2); bf16_t* MIX = (bf16_t*)(p.ws + O_MIX);
    constexpr float C16[16] = {1.0f, 0.92387953251f, 0.70710678119f, 0.38268343237f, 0.0f, -0.38268343237f, -0.70710678119f, -0.92387953251f, -1.0f, -0.92387953251f, -0.70710678119f, -0.38268343237f, 0.0f, 0.38268343237f, 0.70710678119f, 0.92387953251f};
    constexpr float S16[16] = {0.0f, 0.38268343237f, 0.70710678119f, 0.92387953251f, 1.0f, 0.92387953251f, 0.70710678119f, 0.38268343237f, 0.0f, -0.38268343237f, -0.70710678119f, -0.92387953251f, -1.0f, -0.92387953251f, -0.70710678119f, -0.38268343237f};
    for (int pair = bx; pair < 1024; pair += G) {
        const int b = pair >> 8, kp = pair & 255;
        __syncthreads();
        if (tid < 16) { float s, c; sincospif((float)(kp * tid) / 2048.0f, &s, &c); L[tid] = c; L[16 + tid] = s; }
        __syncthreads();
        const int c = tid;
        const u32x4* pr = (const u32x4*)(I2 + (size_t)kp * 32768 + (size_t)(b * 512 + c) * 16);
        const u32x4* pi = (const u32x4*)(I2 + (size_t)(256 + kp) * 32768 + (size_t)(b * 512 + c) * 16);
        const u32x4 r0 = pr[0], r1 = pr[1], i0 = pi[0], i1 = pi[1];
        const unsigned rw[8] = {r0.x, r0.y, r0.z, r0.w, r1.x, r1.y, r1.z, r1.w}, iw[8] = {i0.x, i0.y, i0.z, i0.w, i1.x, i1.y, i1.z, i1.w};
        float xr[16], xi[16];
#pragma unroll
        for (int r = 0; r < 16; ++r) {
            const float ire = __uint_as_float((r & 1) ? (rw[r >> 1] & 0xFFFF0000u) : (rw[r >> 1] << 16));
            const float iim = __uint_as_float((r & 1) ? (iw[r >> 1] & 0xFFFF0000u) : (iw[r >> 1] << 16));
            const float ct = L[r], st = L[16 + r];
            xr[r] = ire * ct + iim * st; xi[r] = iim * ct - ire * st;
        }
#pragma unroll
        for (int j = 0; j < 16; ++j) {
            float y = 0.f;
#pragma unroll
            for (int r = 0; r < 16; ++r) y += xr[r] * C16[(j * r) & 15] + xi[r] * S16[(j * r) & 15];
            MIX[(size_t)(b * 4096 + kp + 256 * j) * 1024 + c] = f2bf(y * (1.0f / 512.0f));
        }
    }
}

__device__ __forceinline__ void phase_scan(const Params& p) {
    const int tid_ = otid(); const int lane = tid_ & 63, wave = tid_ >> 6;
    const bf16_t* S = (const bf16_t*)(p.ws + O_S); bf16_t* A2 = (bf16_t*)(p.ws + O_A2);
    const int nitems = 512;
    for (int item = obid() + gridDim.x * wave; item < nitems; item += gridDim.x * 8) {
        const int b = item >> 7, g = (item >> 1) & 63, dir = item & 1, pp = lane;
        const float dt = expf(p.log_dt[dir * 64 + g]);
        const float are = p.a_re[(dir * 64 + g) * 64 + pp], aim = p.a_im[(dir * 64 + g) * 64 + pp];
        const float mag = expf(are * dt * 16.0f); float sn, cs; sincosf(aim * dt * 16.0f, &sn, &cs);
        const float ar = mag * cs, ai = mag * sn;
        float hr = 0.f, hi = 0.f;
        const bf16_t* Sg = S + (size_t)g * SROWS * 256 + dir * 128 + pp;
        bf16_t* Ag = A2 + (size_t)g * GROWS * 512 + 256 + dir * 128 + pp;
        for (int i = 0; i < 16; ++i) {
            const int ch = dir ? 15 - i : i; const size_t lrow = 1024 + b * 16 + ch;
            const float sr = __uint_as_float((unsigned)Sg[lrow * 256] << 16), si = __uint_as_float((unsigned)Sg[lrow * 256 + 64] << 16);
            const float nr = ar * hr - ai * hi + sr, ni = ar * hi + ai * hr + si; hr = nr; hi = ni;
        }
        for (int i0 = 0; i0 < 256; i0 += 8) {
            float sr[8], si[8];
#pragma unroll
            for (int j = 0; j < 8; ++j) { const int ch = dir ? 255 - (i0 + j) : (i0 + j); const size_t lrow = b * 256 + ch; sr[j] = __uint_as_float((unsigned)Sg[lrow * 256] << 16); si[j] = __uint_as_float((unsigned)Sg[lrow * 256 + 64] << 16); }
#pragma unroll
            for (int j = 0; j < 8; ++j) {
                const int ch = dir ? 255 - (i0 + j) : (i0 + j); const size_t lrow = b * 256 + ch;
                Ag[lrow * 512] = f2bf(hr); Ag[lrow * 512 + 64] = f2bf(hi);
                const float nr = ar * hr - ai * hi + sr[j], ni = ar * hi + ai * hr + si[j]; hr = nr; hi = ni;
            }
        }
    }
}


#define XB_TMO      128
#define XB_XCNT(j)  (256  + 64 * (j))
#define XB_XSUB(j)  (1280 + 64 * (j))
#define XB_XGEN(j)  (2304 + 64 * (j))
#define XB_TOP      3328
#define XB_TOPGEN   3392
#define XCD_BAR_WORDS 3456
#define XB_SPIN_CAP (1u << 22)
__device__ __forceinline__ unsigned xb_ld(unsigned* p)              { return __hip_atomic_load(p, __ATOMIC_RELAXED, __HIP_MEMORY_SCOPE_AGENT); }
__device__ __forceinline__ unsigned xb_add(unsigned* p, unsigned v) { return __hip_atomic_fetch_add(p, v, __ATOMIC_RELAXED, __HIP_MEMORY_SCOPE_AGENT); }
__device__ __forceinline__ unsigned xb_xcc_id() { return (unsigned)__builtin_amdgcn_s_getreg((3 << 11) | 20) & 0xFu; }
#define XB_SPIN(cond, bar) do { unsigned _sp = 0; while (cond) { __builtin_amdgcn_s_sleep(1); \
    if ((++_sp & 255u) == 0u) { if (xb_ld(&(bar)[XB_TMO])) break; if (_sp > XB_SPIN_CAP) { atomicAdd(&(bar)[XB_TMO], 1u); break; } } } } while (0)
__device__ __forceinline__ unsigned xcd_barrier_complete(unsigned* bar, unsigned x) {
    const unsigned G = gridDim.x;
    unsigned sum, cnt, mine, sp = 0u;
    for (;;) {
        sum = 0u; cnt = 0u; mine = 0u;
        for (unsigned j = 0; j < 16; ++j) { const unsigned c = xb_ld(&bar[XB_XCNT(j)]); sum += c; cnt += (c > 0u) ? 1u : 0u; mine = (j == x) ? c : mine; }
        if (sum == G) break;
        __builtin_amdgcn_s_sleep(1);
        if ((++sp & 255u) == 0u) { if (xb_ld(&bar[XB_TMO])) break; if (sp > XB_SPIN_CAP) { atomicAdd(&bar[XB_TMO], 1u); break; } }
    }
    const unsigned nloc = mine > 0u ? mine : 1u, nx = cnt > 0u ? cnt : 1u;
    return nloc | (nx << 16);
}
__device__ __forceinline__ void xcd_barrier(unsigned* bar, volatile LAS unsigned* st) {
    asm volatile("s_waitcnt vmcnt(0)" ::: "memory");
    __syncthreads();
    if (threadIdx.x == 0) {
        __builtin_amdgcn_s_waitcnt(0);
        const unsigned x = xb_xcc_id();
        unsigned nloc = st[0], nx = st[1];
        if (nloc == 0u) { const unsigned pk = xcd_barrier_complete(bar, x); nloc = pk & 0xFFFFu; nx = pk >> 16; st[0] = nloc; st[1] = nx; }
        const unsigned old = xb_add(&bar[XB_XSUB(x)], 1u);
        const unsigned gen = old / nloc;
        if (old + 1u == (gen + 1u) * nloc) {
            __builtin_amdgcn_fence(__ATOMIC_RELEASE, "agent");
            asm volatile("s_waitcnt vmcnt(0)" ::: "memory");
            const unsigned og = xb_add(&bar[XB_TOP], 1u);
            const unsigned tg = og / nx;
            if (og + 1u == (tg + 1u) * nx) xb_add(&bar[XB_TOPGEN], 1u);
            else XB_SPIN(xb_ld(&bar[XB_TOPGEN]) == tg, bar);
            __builtin_amdgcn_fence(__ATOMIC_ACQUIRE, "agent");
            xb_add(&bar[XB_XGEN(x)], 1u);
            asm volatile("s_waitcnt vmcnt(0)" ::: "memory");
        } else {
            XB_SPIN(xb_ld(&bar[XB_XGEN(x)]) == gen, bar);
            __builtin_amdgcn_fence(__ATOMIC_ACQUIRE, "agent");
            asm volatile("s_waitcnt vmcnt(0)" ::: "memory");
        }
    }
    __syncthreads();
}

__global__ void __launch_bounds__(NT) fwd_megakernel(Params p) {
    extern __shared__ __attribute__((aligned(16))) unsigned char shm[];
    cg::grid_group grid = cg::this_grid();
    LAS unsigned char* lds = (LAS unsigned char*)shm;
    LAS float* L = (LAS float*)shm;
    unsigned char* ws = p.ws;
    const int G = gridDim.x;
    float* mods = (float*)(ws + O_MODS);
    float* hctx = (float*)(ws + O_HCTX);
    bf16_t* XN = (bf16_t*)(ws + O_XN);
    bf16_t* ACT = (bf16_t*)(ws + O_ACT);
    const float* mods1 = mods + 5 * 6144;
    unsigned* bar = (unsigned*)(ws + O_BAR);
    volatile LAS unsigned* bst = (volatile LAS unsigned*)(lds + pg8::STAGE_BYTES);
    if (threadIdx.x < 4) bst[threadIdx.x] = 0u;
    __syncthreads();
    if (threadIdx.x == 0) (void)xb_add(&bar[XB_XCNT(xb_xcc_id())], 1u);
#define GRID_BAR() xcd_barrier(bar, bst)

    {
    phase_p0(p, L, bar + 0, bst + 2);
    }
    grid.sync();
    {
    phase_norm<0>(p.x, p.ctx, NTOK, p.norm_g + 0, mods, 0, 1, XN, nullptr);
    }
    GRID_BAR();
    {
    const int bx = obid();
    {
        const bf16_t* WinA = (const bf16_t*)(ws + O_WINA);
        bf16_t *ZT = (bf16_t*)(ws + O_ZT), *ZTc = (bf16_t*)(ws + O_ZTC), *VT = (bf16_t*)(ws + O_VT), *VTc = (bf16_t*)(ws + O_VTC);
        { pg8::Gemm g1{WinA, XN, 1024, 1024, 16384}; pg8::Sched s1; s1.init(4, 64, G, bx, 3, 1024, 16384);
          EpiInA e1{ZT, ZTc, 0, 1}; pg8::gemm_phase(lds, g1, s1, e1); }
        { pg8::Gemm gb{XN, (const bf16_t*)(ws + O_WINB), 1024, 1024, 1024}; pg8::Sched sb; sb.init(68, 3, G, bx, 0, 1024, 1024);
          EpiInB eb{(bf16_t*)(ws + O_Q), (bf16_t*)(ws + O_K), (const float*)(ws + O_ROPE), (const float*)(ws + O_ROPE) + 1024, VT, VTc}; pg8::gemm_phase(lds, gb, sb, eb); }
        { pg8::Gemm g3{WinA, XN + (size_t)NLAT * 1024, 1024, 1024, 1024}; pg8::Sched s3; s3.init(4, 4, G, (bx + G - (204 % G)) % G, 0, 1024, 1024);
          EpiInA e3{ZT, ZTc, NLAT, 0}; pg8::gemm_phase(lds, g3, s3, e3); }
    }
    }
    GRID_BAR();
    {
    const int bx = obid();
    {
        { pg8::Gemm gd{(const bf16_t*)(ws + O_D256), (const bf16_t*)(ws + O_ZT), 512, 512, 512}; pg8::Sched sd; sd.init(2, 128, G, bx, 0, 512, 512);
          EpiI2 ed{(bf16_t*)(ws + O_I2)}; pg8::gemm_phase(lds, gd, sd, ed); }
        const int wv = bx * 8 + (otid() >> 6), nw = G * 8;
        for (int item = wv; item < 4352; item += nw) attn_item(p, item);
        __syncthreads();
        { pg8::Gemm gc{(const bf16_t*)(ws + O_DC), (const bf16_t*)(ws + O_ZTC), 512, 512, 512}; pg8::Sched sc; sc.init(1, 8, G, (bx + 8) % G, 0, 512, 512);
          EpiDft ec{(bf16_t*)(ws + O_MIX), 1}; pg8::gemm_phase(lds, gc, sc, ec); }
    }
    }
    GRID_BAR();
    phase_dft_combine(p, L);
    GRID_BAR();
    {
    const int bx = obid();
    {
        const bf16_t* MIX = (const bf16_t*)(ws + O_MIX);
        pg8::Gemm g{MIX, (const bf16_t*)(ws + O_WOUT), 1024, 1024, 1024}; pg8::Sched s; s.init(64, 4, G, bx, 0, 1024, 1024);
        if (G == 256) {
            EpiResNorm e{p.x, p.out, mods + 2 * 1024, p.norm_g + 1024, mods, XN, (float*)(ws + O_XSS), (unsigned*)(ws + O_PCNT) + 32, bar + XB_TMO};
            pg8::gemm_phase<EpiResNorm, true>(lds, g, s, e);
            __syncthreads();
        } else {
            EpiRes e{p.x, p.ctx, p.out, hctx, mods + 2 * 1024};
            pg8::gemm_phase(lds, g, s, e);
        }
        pg8::Gemm gc{MIX + (size_t)NLAT * 1024, (const bf16_t*)(ws + O_WOUT), 256, 1024, 1024}; pg8::Sched sc; sc.init(16, 4, G, bx, 2, 1024, 1024);
        EpiPart ec{(bf16_t*)(ws + O_XNP)};
        pg8::gemm_phase<EpiPart, false>(lds, gc, sc, ec);
    }
    }
    GRID_BAR();
    {
    phase_norm<0>(p.out, p.ctx, NTOK, p.norm_g + 1024, mods, 3, 4, XN, nullptr, (const bf16_t*)(ws + O_XNP), 4, mods + 4 * 6144 + 2 * 1024, hctx, G == 256 ? NLAT : 0);
    }
    GRID_BAR();
    {
    const int bx = obid();
    {
        pg8::Gemm g{XN, (const bf16_t*)(ws + O_WGU0), 1024, 1024, 1024}; pg8::Sched s; s.init(68, 22, G, bx, 0, 1024, 1024);
        EpiSwiglu e{ACT};
        pg8::gemm_phase(lds, g, s, e);
    }
    }
    GRID_BAR();
    {
    const int bx = obid();
    {
        pg8::Gemm g{ACT, (const bf16_t*)(ws + O_WD0), FF, FF, FF}; pg8::Sched s; s.init(64, 4, G, bx, 0, FF, FF);
        EpiRes e{p.out, hctx, p.out, hctx, mods + 5 * 1024};
        pg8::gemm_phase(lds, g, s, e);
        pg8::Gemm gc{ACT + (size_t)NLAT * FF, (const bf16_t*)(ws + O_WD0), 256, FF, FF}; pg8::Sched sc; sc.init(16, 11, G, bx, 2, FF, FF);
        EpiPart ec{(bf16_t*)(ws + O_PART)};
        pg8::gemm_phase<EpiPart, false>(lds, gc, sc, ec);
    }
    }
    GRID_BAR();
    {
    phase_norm<1>(p.out, hctx, NTOK, p.norm_g + 2048, mods1, 0, 1, (bf16_t*)(ws + O_A2), nullptr, (const bf16_t*)(ws + O_PART), 11, mods + 4 * 6144 + 5 * 1024, nullptr);
    }
    GRID_BAR();
    {
    const int bx = obid();
    {
        pg8::Gemm g{(const bf16_t*)(ws + O_A2), (const bf16_t*)(ws + O_WST), 256, 512, 256}; pg8::Sched s; s.init(5, 64, G, bx, 1, 512, 256);
        EpiState e{(bf16_t*)(ws + O_S)};
        pg8::gemm_phase<EpiState, false>(lds, g, s, e);
    }
    }
    GRID_BAR();
    {
    phase_scan(p);
    }
    GRID_BAR();
    {
    const int bx = obid();
    {
        pg8::Gemm g{(const bf16_t*)(ws + O_A2), (const bf16_t*)(ws + O_TT), 512, 512, 512}; pg8::Sched s; s.init(4, 64, G, bx, 1, 512, 512);
        EpiSout e{(bf16_t*)(ws + O_GY)};
        pg8::gemm_phase(lds, g, s, e);
    }
    }
    GRID_BAR();
    {
    const int bx = obid();
    {
        pg8::Gemm g{(const bf16_t*)(ws + O_GY), (const bf16_t*)(ws + O_GLU), 1024, 1024, 1024};
        if (G == 256) {
            EpiGluNorm e{p.out, mods1 + 2 * 1024, p.norm_g + 3072, mods1, XN, (float*)(ws + O_S), (unsigned*)(ws + O_PCNT) + 16, bar + XB_TMO};
            pg8::Sched s; s.init(64, 8, G, bx, 4, 1024, 1024); s.nwg = 256;
            pg8::gemm_phase<EpiGluNorm, true>(lds, g, s, e);
            __syncthreads();
            pg8::Sched s2; s2.init(64, 8, G, bx, 4, 1024, 1024); s2.base = 256;
            pg8::gemm_phase<EpiGluNorm, true>(lds, g, s2, e);
        } else {
            pg8::Sched s; s.init(64, 8, G, bx, 0, 1024, 1024);
            EpiGlu e{p.out, mods1 + 2 * 1024};
            pg8::gemm_phase(lds, g, s, e);
        }
    }
    }
    GRID_BAR();
    if (G != 256) {
    phase_norm<0>(p.out, hctx, NLAT, p.norm_g + 3072, mods1, 3, 4, XN, nullptr);
    GRID_BAR();
    }
    {
    const int bx = obid();
    {
        pg8::Gemm g{XN, (const bf16_t*)(ws + O_WGU1), 1024, 1024, 1024}; pg8::Sched s; s.init(64, 22, G, bx, 0, 1024, 1024);
        EpiSwiglu e{ACT};
        pg8::gemm_phase(lds, g, s, e);
    }
    }
    GRID_BAR();
    {
    const int bx = obid();
    {
        pg8::Gemm g{ACT, (const bf16_t*)(ws + O_WD1), FF, FF, FF}; pg8::Sched s; s.init(64, 4, G, bx, 0, FF, FF);
        if (G == 256) {
            EpiResFinal e{p.out, p.out, mods1 + 5 * 1024, p.final_g, (float*)(ws + O_XSS), (unsigned*)(ws + O_PCNT), bar + XB_TMO};
            pg8::gemm_phase<EpiResFinal, true>(lds, g, s, e);
        } else {
            EpiRes e{p.out, hctx, p.out, hctx, mods1 + 5 * 1024};
            pg8::gemm_phase(lds, g, s, e);
        }
    }
    }
    if (G != 256) {
    GRID_BAR();
    phase_norm<2>(p.out, hctx, NLAT, p.final_g, nullptr, 0, 0, nullptr, p.out);
    }
}

extern "C" void kernel_launch(void* const* d_in, const int* in_sizes, int n_in, void* d_out, int out_size, void* d_ws, size_t ws_size, hipStream_t stream) {
    constexpr int kLds = pg8::STAGE_BYTES + 16;
    static int grid_blocks = 0;
    if (grid_blocks == 0) {
        if (n_in != 23 || ws_size < WS_NEED) { fprintf(stderr, "kernel_launch: unexpected n_in %d or workspace %zu < %zu\n", n_in, ws_size, (size_t)WS_NEED); grid_blocks = -1; return; }
        int dev = 0, cus = 0, per_cu = 0;
        hipGetDevice(&dev);
        hipDeviceGetAttribute(&cus, hipDeviceAttributeMultiprocessorCount, dev);
        hipFuncSetAttribute((const void*)fwd_megakernel, hipFuncAttributeMaxDynamicSharedMemorySize, kLds);
        hipOccupancyMaxActiveBlocksPerMultiprocessor(&per_cu, (const void*)fwd_megakernel, NT, kLds);
        if (per_cu < 1) { fprintf(stderr, "kernel_launch: occupancy query says %d blocks/CU\n", per_cu); per_cu = 1; }
        grid_blocks = cus;
        (void)hipGetLastError();
    }
    if (grid_blocks < 0) return;
    if (hipMemsetAsync((char*)d_ws + O_BAR, 0, 16384 + 64 * 256, stream) != hipSuccess) { fprintf(stderr, "kernel_launch: memset of barrier words failed\n"); return; }
    Params p{};
    p.x = (const float*)d_in[0]; p.c = (const float*)d_in[1]; p.ctx = (const float*)d_in[2]; p.c_ctx = (const float*)d_in[3];
    p.mod_w = (const float*)d_in[4]; p.mod_b = (const float*)d_in[5]; p.norm_g = (const float*)d_in[6];
    p.ffn_g = (const float*)d_in[7]; p.ffn_u = (const float*)d_in[8]; p.ffn_d = (const float*)d_in[9];
    p.w_in = (const float*)d_in[10]; p.w_out = (const float*)d_in[11]; p.sink = (const float*)d_in[12];
    p.a_re = (const float*)d_in[13]; p.a_im = (const float*)d_in[14]; p.log_dt = (const float*)d_in[15];
    p.b_re = (const float*)d_in[16]; p.b_im = (const float*)d_in[17]; p.c_re = (const float*)d_in[18]; p.c_im = (const float*)d_in[19];
    p.ssm_d = (const float*)d_in[20]; p.glu_w = (const float*)d_in[21]; p.final_g = (const float*)d_in[22];
    p.out = (float*)d_out; p.ws = (unsigned char*)d_ws;
    void* args[] = {&p};
    hipError_t e = hipLaunchCooperativeKernel((const void*)fwd_megakernel, dim3(grid_blocks), dim3(NT), args, kLds, stream);
    if (e != hipSuccess) fprintf(stderr, "cooperative launch failed: %s (grid %d)\n", hipGetErrorString(e), grid_blocks);
}
```

```cpp
#include <hip/hip_runtime.h>
#include <hip/hip_cooperative_groups.h>
#include <cstdio>
namespace cg = cooperative_groups;

#define LAS __attribute__((address_space(3)))
typedef unsigned short bf16_t;
typedef short bf16x8 __attribute__((ext_vector_type(8)));
typedef float f32x4 __attribute__((ext_vector_type(4)));
typedef float f32x16 __attribute__((ext_vector_type(16)));
typedef unsigned u32x4 __attribute__((ext_vector_type(4)));
typedef unsigned u32x2 __attribute__((ext_vector_type(2)));

constexpr int NT = 512;
constexpr int DM_ = 1024, SEQ_ = 4096, NB_ = 4, CTXL = 256, FF = 2816;
constexpr int NLAT = NB_ * SEQ_;
constexpr int NCTX = NB_ * CTXL;
constexpr int NTOK = NLAT + NCTX;
constexpr int GROWS = 1088;
constexpr int SROWS = 1280;

constexpr size_t MiB = 1u << 20;
constexpr size_t O_WINA = 0;
constexpr size_t O_WINB = O_WINA + 1280ull * 1024 * 2;
constexpr size_t O_WOUT = O_WINB + 768ull * 1024 * 2;
constexpr size_t O_WGU0 = O_WOUT + 1024ull * 1024 * 2;
constexpr size_t O_WD0 = O_WGU0 + 5632ull * 1024 * 2;
constexpr size_t O_WGU1 = O_WD0 + 1024ull * 2816 * 2;
constexpr size_t O_WD1 = O_WGU1 + 5632ull * 1024 * 2;
constexpr size_t O_GLU = O_WD1 + 1024ull * 2816 * 2;
constexpr size_t O_WST = O_GLU + 2048ull * 1024 * 2;
constexpr size_t O_TT = O_WST + 64ull * 256 * 256 * 2;
constexpr size_t O_MODS = O_TT + 64ull * 256 * 512 * 2;
constexpr size_t O_ROPE = O_MODS + 2ull * 5 * 6144 * 4;
constexpr size_t O_DC = O_ROPE + 2ull * 1024 * 4;
constexpr size_t O_HCTX = O_DC + 256ull * 512 * 2;
constexpr size_t O_VTC = O_HCTX + 1024ull * 1024 * 4;
constexpr size_t O_BAR = O_VTC + 4ull * 128 * 256 * 2;
constexpr size_t O_PCNT = O_BAR + 16384;
constexpr size_t O_D256 = O_PCNT + 64ull * 256;
constexpr size_t O_XSS = O_D256 + 512ull * 512 * 2;
constexpr size_t O_RA = 73 * MiB;
static_assert(O_XSS + 16384ull * 4 * 4 <= O_RA, "R_W overflow");
constexpr size_t O_XN = O_RA;
constexpr size_t O_MIX = O_RA + 34 * MiB;
constexpr size_t O_I2 = O_RA + 68 * MiB;
constexpr size_t O_XNP = O_I2;
constexpr size_t O_ZT = O_RA + 100 * MiB;
constexpr size_t O_ZTC = O_RA + 132 * MiB;
constexpr size_t O_Q = O_RA + 134 * MiB;
constexpr size_t O_K = O_RA + 151 * MiB;
constexpr size_t O_VT = O_K + 17408ull * 128 * 2;
constexpr size_t O_ACT = O_RA + 34 * MiB;
constexpr size_t O_A2 = O_RA;
constexpr size_t O_S = O_RA + 69 * MiB;
constexpr size_t O_GY = O_RA + 149 * MiB;
constexpr size_t O_PART = O_RA + 128 * MiB;
constexpr size_t WS_NEED = O_RA + 181 * MiB;

struct Params {
    const float* x; const float* c; const float* ctx; const float* c_ctx; const float* mod_w; const float* mod_b; const float* norm_g;
    const float* ffn_g; const float* ffn_u; const float* ffn_d; const float* w_in; const float* w_out; const float* sink;
    const float* a_re; const float* a_im; const float* log_dt; const float* b_re; const float* b_im; const float* c_re; const float* c_im;
    const float* ssm_d; const float* glu_w; const float* final_g;
    float* out; unsigned char* ws;
};

__device__ __forceinline__ int otid() { int t = threadIdx.x; asm volatile("" : "+v"(t)); return t; }
__device__ __forceinline__ int obid() { int t = blockIdx.x; asm volatile("" : "+s"(t)); return t; }
__device__ __forceinline__ unsigned cvt_pk_bf16(float lo, float hi) { unsigned r; asm volatile("v_cvt_pk_bf16_f32 %0, %1, %2" : "=v"(r) : "v"(lo), "v"(hi)); return r; }
__device__ __forceinline__ bf16_t f2bf(float f) { unsigned u = __float_as_uint(f); u += 0x7FFFu + ((u >> 16) & 1u); return (bf16_t)(u >> 16); }
__device__ __forceinline__ float sigmoidf_(float v) { return __builtin_amdgcn_rcpf(1.0f + __builtin_amdgcn_exp2f(-1.4426950408889634f * v)); }
__device__ __forceinline__ float siluf_(float v) { return v * sigmoidf_(v); }
__device__ __forceinline__ float gelu_tanh(float v) { const float u = 0.7978845608028654f * (v + 0.044715f * v * v * v); return v * sigmoidf_(2.0f * u); }
__device__ __forceinline__ u32x4 pack8(const f32x4 a, const f32x4 b) { u32x4 w; w.x = cvt_pk_bf16(a[0], a[1]); w.y = cvt_pk_bf16(a[2], a[3]); w.z = cvt_pk_bf16(b[0], b[1]); w.w = cvt_pk_bf16(b[2], b[3]); return w; }

namespace pg8 {
constexpr int BM = 256, BK = 64, HALF = 128, HTB = HALF * BK * 2, STAGE_BYTES = 8 * HTB, NXCD = 8, WGM = 8;
__device__ __forceinline__ int lds_byte(int r, int c) { const int st = (r >> 4) * 2 + (c >> 5), rr = r & 15, cc = c & 31, ob = rr * 64 + cc * 2; return st * 1024 + (ob ^ (((ob >> 9) & 1) << 5)); }
__device__ __forceinline__ void stage_rc(int b, int& R, int& C) { const int st = b / 1024, sb = b % 1024, swz = sb ^ (((sb >> 9) & 1) << 5); R = (st >> 1) * 16 + swz / 64; C = (st & 1) * 32 + (swz % 64) / 2; }
__device__ __forceinline__ int perm32(int rho) { const int n = rho >> 4, i = rho & 15; return 8 * (i >> 2) + 4 * n + (i & 3); }

struct Unit { int arow, brow, pm, pn, kofs; size_t aoff, boff; };
struct Gemm { const bf16_t* A; const bf16_t* Bt; int K, lda, ldb; };

struct Sched {
    int nM, nN, nwg, G, c, mode, lda, ldb, base;
    __device__ void init(int nM_, int nN_, int G_, int c_, int mode_, int lda_, int ldb_) { nM = nM_; nN = nN_; nwg = nM_ * nN_; G = G_; c = c_; mode = mode_; lda = lda_; ldb = ldb_; base = 0; }
    __device__ bool next(int i, Unit& u) const {
        const long L = (long)base + (long)i * G + c; if (L >= nwg) return false;
        if (mode == 4) {
            { const int x = (int)L & 7, o = ((int)L & 255) >> 3; u.pm = ((int)L >> 8) * 32 + x * 4 + (o >> 3); u.pn = o & 7; }
            u.arow = u.pm * BM; u.brow = u.pn * BM; u.kofs = 0;
            u.aoff = (size_t)u.arow * lda; u.boff = (size_t)u.brow * ldb; return true;
        }
        if (mode == 0 || mode == 3) {
            int wgid = (int)L; { const int q = nwg / NXCD, r = nwg % NXCD, xcd = wgid % NXCD, off = wgid / NXCD; wgid = (xcd < r ? xcd * (q + 1) : r * (q + 1) + (xcd - r) * q) + off; }
            const int nig = WGM * nN, gid = wgid / nig, fm = gid * WGM, gsz = (nM - fm) < WGM ? (nM - fm) : WGM;
            u.pm = fm + ((wgid % nig) % gsz); u.pn = (wgid % nig) / gsz; u.arow = u.pm * BM; u.brow = u.pn * BM; u.kofs = 0;
        } else if (mode == 1) {
            const int g = (int)L / nM, mi = (int)L % nM; u.pm = mi; u.pn = g; u.arow = g * GROWS + mi * BM; u.brow = g * BM; u.kofs = 0;
        } else {
            const int tile = (int)L % nM, ks = (int)L / nM; u.pm = tile >> 2; u.pn = tile & 3; u.arow = u.pm * BM; u.brow = u.pn * BM; u.kofs = ks * 256;
        }
        u.aoff = (size_t)u.arow * lda + u.kofs;
        u.boff = (mode == 3) ? (size_t)((u.pn >> 4) * 4096 + (u.pn & 15)) * 1024 : (size_t)u.brow * ldb + u.kofs;
        return true;
    }
};

template <class T, class = void> struct epi_after_drain { static constexpr bool value = false; };
template <class T> struct epi_after_drain<T, decltype((void)T::AFTER_DRAIN)> { static constexpr bool value = T::AFTER_DRAIN; };
#ifndef GP_ALIGN
#define GP_ALIGN true
#endif
#ifndef GP_SP2
#define GP_SP2 true
#endif
template <class Epi, bool ALIGN_EPI = GP_ALIGN, bool SP2 = GP_SP2>
__device__ __forceinline__ void gemm_phase(LAS unsigned char* lds, const Gemm g, const Sched& S, const Epi& E) {
    const int tid = otid(), wid = __builtin_amdgcn_readfirstlane(tid >> 6), lane = tid & 63, wr = wid >> 2, wc = wid & 3, fr = lane & 15, fq = lane >> 4;
    const int K = g.K, nt = K / BK;
    unsigned voffA[2], voffB[2];
#pragma unroll
    for (int i = 0; i < 2; ++i) { int R, C; stage_rc(tid * 16 + i * 8192, R, C); const int Rb = (R & ~31) + perm32(R & 31);
        voffA[i] = (unsigned)(R * g.lda + C) * 2u; voffB[i] = (unsigned)(Rb * g.ldb + C) * 2u; }
    const size_t kstep = (size_t)(BK * 2);
    const size_t hstepA = (size_t)HALF * g.lda * 2, hstepB = (size_t)HALF * g.ldb * 2;
    const unsigned ldsw = (unsigned)wid * 1024u;
    const int aoff = lds_byte(wr * 64 + fr, fq * 8), boff = lds_byte(wc * 32 + fr, fq * 8);
#define PG8_SA(b, h) (((b) * 2 + (h)) * HTB)
#define PG8_SB(b, h) ((4 + (b) * 2 + (h)) * HTB)
#define PG8_STAGE(bufoff, gbase, voff) do { _Pragma("unroll") for (int _i = 0; _i < 2; ++_i) \
        __builtin_amdgcn_global_load_lds((const unsigned*)((const char*)(gbase) + (voff)[_i]), (LAS unsigned*)(lds + (bufoff) + ldsw + _i * 8192), 16, 0, 0); } while (0)
#define PG8_LDA(dst, b, h) do { _Pragma("unroll") for (int m = 0; m < 4; ++m) _Pragma("unroll") for (int k = 0; k < 2; ++k) dst[m][k] = *(const LAS bf16x8*)(lds + PG8_SA(b, h) + aoff + m * 2048 + k * 1024); } while (0)
#define PG8_LDB(dst, b, h) do { _Pragma("unroll") for (int n = 0; n < 2; ++n) _Pragma("unroll") for (int k = 0; k < 2; ++k) dst[n][k] = *(const LAS bf16x8*)(lds + PG8_SB(b, h) + boff + n * 2048 + k * 1024); } while (0)
#define PG8_MMA(ai, bj, At, Bt) do { __builtin_amdgcn_s_setprio(1); _Pragma("unroll") for (int m = 0; m < 4; ++m) _Pragma("unroll") for (int n = 0; n < 2; ++n) _Pragma("unroll") for (int k = 0; k < 2; ++k) \
        acc[ai][bj][m][n] = __builtin_amdgcn_mfma_f32_16x16x32_bf16(Bt[n][k], At[m][k], acc[ai][bj][m][n], 0, 0, 0); __builtin_amdgcn_s_setprio(0); } while (0)
#define PG8_WAIT_V(n) asm volatile("s_waitcnt vmcnt(" #n ")" ::: "memory")
#define PG8_WAIT_L(n) asm volatile("s_waitcnt lgkmcnt(" #n ")" ::: "memory")
#define PG8_BAR __builtin_amdgcn_s_barrier()
#define PG8_SCHED __builtin_amdgcn_sched_barrier(0)
    Unit cur, nxt; int ui = 0;
    if (!S.next(0, cur)) return;
    f32x4 acc[2][2][4][2];
#pragma unroll
    for (int a = 0; a < 2; ++a)
#pragma unroll
        for (int b = 0; b < 2; ++b)
#pragma unroll
            for (int m = 0; m < 4; ++m)
#pragma unroll
                for (int n = 0; n < 2; ++n) acc[a][b][m][n] = (f32x4){0.f, 0.f, 0.f, 0.f};
    bf16x8 At[4][2], B0[2][2], B1[2][2];
    const char* cA = (const char*)g.A + cur.aoff * 2; const char* cB = (const char*)g.Bt + cur.boff * 2;
    if constexpr (SP2) {
        PG8_STAGE(PG8_SB(0, 0), cB, voffB); PG8_STAGE(PG8_SB(0, 1), cB + hstepB, voffB); PG8_STAGE(PG8_SA(0, 0), cA, voffA); PG8_STAGE(PG8_SA(0, 1), cA + hstepA, voffA);
        if (wr == 1) PG8_BAR;
        PG8_WAIT_V(2); PG8_BAR;
        PG8_STAGE(PG8_SB(1, 0), cB + kstep, voffB); PG8_STAGE(PG8_SA(1, 0), cA + kstep, voffA); PG8_STAGE(PG8_SB(1, 1), cB + hstepB + kstep, voffB);
        PG8_WAIT_V(6); PG8_BAR;
    } else {
        PG8_STAGE(PG8_SB(0, 0), cB, voffB); PG8_STAGE(PG8_SA(0, 0), cA, voffA); PG8_STAGE(PG8_SB(0, 1), cB + hstepB, voffB); PG8_STAGE(PG8_SA(0, 1), cA + hstepA, voffA);
        if (wr == 1) PG8_BAR;
        PG8_WAIT_V(4); PG8_BAR;
        PG8_STAGE(PG8_SB(1, 0), cB + kstep, voffB); PG8_STAGE(PG8_SA(1, 0), cA + kstep, voffA); PG8_STAGE(PG8_SB(1, 1), cB + hstepB + kstep, voffB);
        PG8_WAIT_V(6); PG8_BAR;
    }
    for (;;) {
        const bool has_next = S.next(ui + 1, nxt);
        const char* nA = has_next ? (const char*)g.A + nxt.aoff * 2 : cA; const char* nB = has_next ? (const char*)g.Bt + nxt.boff * 2 : cB;
        for (int t = 0; t < nt; t += 2) {
            const bool last = (t == nt - 2);
            const char* a1 = cA + (size_t)(t + 1) * kstep;
            const char* a2 = last ? nA : cA + (size_t)(t + 2) * kstep; const char* b2 = last ? nB : cB + (size_t)(t + 2) * kstep;
            const char* a3 = a2 + kstep; const char* b3 = b2 + kstep;
            if constexpr (SP2) {
            PG8_LDB(B0, 0, 0); PG8_LDB(B1, 0, 1); PG8_SCHED; PG8_LDA(At, 0, 0); PG8_STAGE(PG8_SA(1, 1), a1 + hstepA, voffA);
            PG8_WAIT_V(8); PG8_WAIT_L(0); PG8_BAR; PG8_MMA(0, 0, At, B0); PG8_MMA(0, 1, At, B1); PG8_BAR; PG8_SCHED;
            PG8_LDA(At, 0, 1); PG8_STAGE(PG8_SB(0, 0), b2, voffB); PG8_STAGE(PG8_SB(0, 1), b2 + hstepB, voffB); PG8_STAGE(PG8_SA(0, 0), a2, voffA);
            PG8_WAIT_V(8); PG8_WAIT_L(0); PG8_BAR; PG8_MMA(1, 0, At, B0); PG8_MMA(1, 1, At, B1); PG8_BAR; PG8_SCHED;
            PG8_LDB(B0, 1, 0); PG8_LDB(B1, 1, 1); PG8_SCHED; PG8_LDA(At, 1, 0); PG8_STAGE(PG8_SA(0, 1), a2 + hstepA, voffA);
            PG8_WAIT_V(8); PG8_WAIT_L(0); PG8_BAR; PG8_MMA(0, 0, At, B0); PG8_MMA(0, 1, At, B1); PG8_BAR; PG8_SCHED;
            PG8_LDA(At, 1, 1); PG8_STAGE(PG8_SB(1, 0), b3, voffB); PG8_STAGE(PG8_SB(1, 1), b3 + hstepB, voffB); PG8_STAGE(PG8_SA(1, 0), a3, voffA);
            PG8_WAIT_V(8); PG8_WAIT_L(0); PG8_BAR; PG8_MMA(1, 0, At, B0); PG8_MMA(1, 1, At, B1); PG8_BAR; PG8_SCHED;
            } else {
            PG8_LDB(B0, 0, 0); PG8_SCHED; PG8_LDA(At, 0, 0); PG8_STAGE(PG8_SA(1, 1), a1 + hstepA, voffA);
            PG8_WAIT_L(8); PG8_BAR; PG8_WAIT_L(0); PG8_MMA(0, 0, At, B0); PG8_BAR; PG8_SCHED;
            PG8_LDB(B1, 0, 1); PG8_STAGE(PG8_SB(0, 0), b2, voffB);
            PG8_BAR; PG8_WAIT_L(0); PG8_MMA(0, 1, At, B1); PG8_BAR;
            PG8_LDA(At, 0, 1); PG8_STAGE(PG8_SA(0, 0), a2, voffA);
            PG8_BAR; PG8_WAIT_L(0); PG8_MMA(1, 0, At, B0); PG8_BAR; PG8_SCHED;
            PG8_STAGE(PG8_SB(0, 1), b2 + hstepB, voffB);
            PG8_WAIT_V(6); PG8_BAR; PG8_MMA(1, 1, At, B1); PG8_BAR;
            PG8_LDB(B0, 1, 0); PG8_SCHED; PG8_LDA(At, 1, 0); PG8_STAGE(PG8_SA(0, 1), a2 + hstepA, voffA);
            PG8_WAIT_L(8); PG8_BAR; PG8_WAIT_L(0); PG8_MMA(0, 0, At, B0); PG8_BAR; PG8_SCHED;
            PG8_LDB(B1, 1, 1); PG8_STAGE(PG8_SB(1, 0), b3, voffB);
            PG8_BAR; PG8_WAIT_L(0); PG8_MMA(0, 1, At, B1); PG8_BAR;
            PG8_LDA(At, 1, 1); PG8_STAGE(PG8_SA(1, 0), a3, voffA);
            PG8_BAR; PG8_WAIT_L(0); PG8_MMA(1, 0, At, B0); PG8_BAR; PG8_SCHED;
            PG8_STAGE(PG8_SB(1, 1), b3 + hstepB, voffB);
            PG8_WAIT_V(6); PG8_BAR; PG8_MMA(1, 1, At, B1); PG8_BAR;
                    }
        }
        if constexpr (ALIGN_EPI) { if (wr == 0) PG8_BAR; }
        if constexpr (!epi_after_drain<Epi>::value) E(acc, cur, wr, wc, fr, fq);
        if (!has_next) break;
#pragma unroll
        for (int a = 0; a < 2; ++a)
#pragma unroll
            for (int b = 0; b < 2; ++b)
#pragma unroll
                for (int m = 0; m < 4; ++m)
#pragma unroll
                    for (int n = 0; n < 2; ++n) acc[a][b][m][n] = (f32x4){0.f, 0.f, 0.f, 0.f};
        cur = nxt; cA = nA; cB = nB; ++ui;
        if constexpr (ALIGN_EPI) { if (wr == 1) PG8_BAR; }
    }
    PG8_WAIT_V(0);
    if constexpr (!ALIGN_EPI) { if (wr == 0) PG8_BAR; }
    PG8_BAR;
    if constexpr (epi_after_drain<Epi>::value) E.fused(acc, cur, wr, wc, fr, fq, lds, wid, lane);
#undef PG8_SA
#undef PG8_SB
#undef PG8_STAGE
#undef PG8_LDA
#undef PG8_LDB
#undef PG8_MMA
#undef PG8_WAIT_V
#undef PG8_WAIT_L
#undef PG8_BAR
#undef PG8_SCHED
}
}
using pg8::Unit;
typedef f32x4 Acc[2][2][4][2];

struct EpiInA {
    bf16_t *ZT, *ZTc; int tk0, perm;
    __device__ __forceinline__ void operator()(const Acc& acc, const Unit& u, int wr, int wc, int fr, int fq) const {
#pragma unroll
        for (int ai = 0; ai < 2; ++ai)
#pragma unroll
            for (int m = 0; m < 4; ++m) {
                const int r = u.arow + ai * 128 + wr * 64 + m * 16 + fr;
                const int c = r & 511, cs = r >> 9;
#pragma unroll
                for (int bj = 0; bj < 2; ++bj) {
                    const int tk = tk0 + u.brow + bj * 128 + wc * 32 + fq * 8;
                    bf16_t* dst;
                    if (perm) { const int b = tk >> 12, rr = (tk >> 8) & 15, tp = tk & 255; dst = ZT + ((size_t)((b * 512 + c) * 16 + rr) * 512 + cs * 256 + tp); }
                    else { const int b = (tk - NLAT) >> 8, t = tk & 255; dst = ZTc + ((size_t)(b * 512 + c) * 512 + cs * 256 + t); }
                    *(u32x4*)dst = pack8(acc[ai][bj][m][0], acc[ai][bj][m][1]);
                }
            }
    }
};
struct EpiInB {
    bf16_t *Q, *Kb; const float *ropeC, *ropeS; bf16_t *VT, *VTc;
    __device__ __forceinline__ void operator()(const Acc& acc, const Unit& u, int wr, int wc, int fr, int fq) const {
#pragma unroll
        for (int ai = 0; ai < 2; ++ai)
#pragma unroll
            for (int m = 0; m < 4; ++m) {
                const int tok = u.arow + ai * 128 + wr * 64 + m * 16 + fr;
                const bool lat = tok < NLAT; const int pos = tok & 4095, prow = pos >> 6, pcol = pos & 63;
#pragma unroll
                for (int bj = 0; bj < 2; ++bj) {
                    const int col = u.brow + bj * 128 + wc * 32 + fq * 8;
                    f32x4 v0 = acc[ai][bj][m][0], v1 = acc[ai][bj][m][1];
                    if (col >= 640) {
                        const int dv = col - 640, kvh = dv >> 6, d = dv & 63, dt = d >> 5, rl0 = d & 31;
                        int b, t; if (lat) { b = tok >> 12; t = tok & 4095; } else { b = (tok - NLAT) >> 8; t = tok & 255; }
                        const int tile = t >> 5, s = (t >> 4) & 1, k16 = t & 15, hh = (k16 >> 2) & 1, j = ((k16 >> 3) << 2) | (k16 & 3);
                        bf16_t* vb = (lat ? VT + (size_t)((b * 2 + kvh) * 128 + tile) * 2048 : VTc + (size_t)((b * 2 + kvh) * 8 + tile) * 2048) + (dt * 2 + s) * 512 + (hh * 32 + rl0) * 8 + j;
                        const u32x4 w = pack8(v0, v1);
                        vb[0] = (bf16_t)(w.x & 0xFFFFu); vb[8] = (bf16_t)(w.x >> 16); vb[16] = (bf16_t)(w.y & 0xFFFFu); vb[24] = (bf16_t)(w.y >> 16);
                        vb[32] = (bf16_t)(w.z & 0xFFFFu); vb[40] = (bf16_t)(w.z >> 16); vb[48] = (bf16_t)(w.w & 0xFFFFu); vb[56] = (bf16_t)(w.w >> 16);
                        continue;
                    }
                    if (lat) {
                        const int i0 = (col & 63) >> 1, pp = (i0 < 16) ? prow : pcol, f0 = i0 & 15;
                        const f32x4 cs = *(const f32x4*)(ropeC + pp * 16 + f0), sn = *(const f32x4*)(ropeS + pp * 16 + f0);
                        f32x4 w0, w1;
                        w0[0] = v0[0] * cs[0] - v0[1] * sn[0]; w0[1] = v0[0] * sn[0] + v0[1] * cs[0];
                        w0[2] = v0[2] * cs[1] - v0[3] * sn[1]; w0[3] = v0[2] * sn[1] + v0[3] * cs[1];
                        w1[0] = v1[0] * cs[2] - v1[1] * sn[2]; w1[1] = v1[0] * sn[2] + v1[1] * cs[2];
                        w1[2] = v1[2] * cs[3] - v1[3] * sn[3]; w1[3] = v1[2] * sn[3] + v1[3] * cs[3];
                        v0 = w0; v1 = w1;
                    }
                    bf16_t* dst = (col < 512) ? Q + (size_t)tok * 512 + col : Kb + (size_t)tok * 128 + (col - 512);
                    *(u32x4*)dst = pack8(v0, v1);
                }
            }
    }
};
struct EpiDft {
    bf16_t* MIX; int isctx;
    __device__ __forceinline__ void operator()(const Acc& acc, const Unit& u, int wr, int wc, int fr, int fq) const {
#pragma unroll
        for (int ai = 0; ai < 2; ++ai)
#pragma unroll
            for (int m = 0; m < 4; ++m) {
                const int k = u.arow + ai * 128 + wr * 64 + m * 16 + fr;
#pragma unroll
                for (int bj = 0; bj < 2; ++bj) {
                    const int col = u.brow + bj * 128 + wc * 32 + fq * 8; const int b = col >> 9, c = col & 511;
                    const size_t trow = isctx ? (size_t)(NLAT + b * 256 + k) : (size_t)(b * 4096 + k);
                    *(u32x4*)(MIX + trow * 1024 + c) = pack8(acc[ai][bj][m][0], acc[ai][bj][m][1]);
                }
            }
    }
};
struct EpiI2 {
    bf16_t* I2;
    __device__ __forceinline__ void operator()(const Acc& acc, const Unit& u, int wr, int wc, int fr, int fq) const {
#pragma unroll
        for (int ai = 0; ai < 2; ++ai)
#pragma unroll
            for (int m = 0; m < 4; ++m) {
                const int row = u.arow + ai * 128 + wr * 64 + m * 16 + fr;
#pragma unroll
                for (int bj = 0; bj < 2; ++bj) {
                    const int col = u.brow + bj * 128 + wc * 32 + fq * 8;
                    *(u32x4*)(I2 + (size_t)row * 32768 + col) = pack8(acc[ai][bj][m][0], acc[ai][bj][m][1]);
                }
            }
    }
};
struct EpiRes {
    const float *in_lat, *in_ctx; float *out_lat, *out_ctx; const float* gate;
    __device__ __forceinline__ void operator()(const Acc& acc, const Unit& u, int wr, int wc, int fr, int fq) const {
        const int row0 = u.arow + wr * 64 + fr, col0 = u.brow + wc * 32 + fq * 8;
        const bool lat = row0 < NLAT;
        const int b = lat ? (row0 >> 12) : 4;
        const float* ip = lat ? in_lat + (size_t)row0 * 1024 + col0 : in_ctx + (size_t)(row0 - NLAT) * 1024 + col0;
        float* op = lat ? out_lat + (size_t)row0 * 1024 + col0 : out_ctx + (size_t)(row0 - NLAT) * 1024 + col0;
        const float* gp = gate + b * 6144 + col0;
        f32x4 gv[2][2];
#pragma unroll
        for (int bj = 0; bj < 2; ++bj)
#pragma unroll
            for (int n = 0; n < 2; ++n) gv[bj][n] = *(const f32x4*)(gp + bj * 128 + 4 * n);
#pragma unroll
        for (int ai = 0; ai < 2; ++ai)
#pragma unroll
            for (int mh = 0; mh < 2; ++mh) {
                f32x4 hv[2][2][2];
#pragma unroll
                for (int mm = 0; mm < 2; ++mm)
#pragma unroll
                    for (int bj = 0; bj < 2; ++bj)
#pragma unroll
                        for (int n = 0; n < 2; ++n) hv[mm][bj][n] = *(const f32x4*)(ip + (size_t)(ai * 128 + (mh * 2 + mm) * 16) * 1024 + bj * 128 + 4 * n);
#pragma unroll
                for (int mm = 0; mm < 2; ++mm)
#pragma unroll
                    for (int bj = 0; bj < 2; ++bj)
#pragma unroll
                        for (int n = 0; n < 2; ++n) *(f32x4*)(op + (size_t)(ai * 128 + (mh * 2 + mm) * 16) * 1024 + bj * 128 + 4 * n) = hv[mm][bj][n] + gv[bj][n] * acc[ai][bj][mh * 2 + mm][n];
            }
    }
};
struct EpiResFinal {
    static constexpr bool AFTER_DRAIN = true;
    const float* H; float* out; const float* gate; const float* fg; float* xss; unsigned* pcnt; unsigned* tmo;
    __device__ __forceinline__ void fused(Acc& acc, const Unit& u, int wr, int wc, int fr, int fq, LAS unsigned char* lds, int wid, int lane) const {
        LAS float* P = (LAS float*)lds;
        LAS float* S = (LAS float*)(lds + 8192);
        const int row0 = u.arow + wr * 64 + fr, col0 = u.brow + wc * 32 + fq * 8;
        const float* ip = H + (size_t)row0 * 1024 + col0; float* op = out + (size_t)row0 * 1024 + col0;
        const float* gp = gate + (row0 >> 12) * 6144 + col0;
        f32x4 gv[2][2];
#pragma unroll
        for (int bj = 0; bj < 2; ++bj)
#pragma unroll
            for (int n = 0; n < 2; ++n) gv[bj][n] = *(const f32x4*)(gp + bj * 128 + 4 * n);
#pragma unroll
        for (int ai = 0; ai < 2; ++ai)
#pragma unroll
            for (int m = 0; m < 4; ++m) {
                float s = 0.f;
#pragma unroll
                for (int bj = 0; bj < 2; ++bj)
#pragma unroll
                    for (int n = 0; n < 2; ++n) {
                        const f32x4 hv = *(const f32x4*)(ip + (size_t)(ai * 128 + m * 16) * 1024 + bj * 128 + 4 * n);
                        const f32x4 h = hv + gv[bj][n] * acc[ai][bj][m][n]; acc[ai][bj][m][n] = h;
                        s += (h[0] * h[0] + h[1] * h[1]) + (h[2] * h[2] + h[3] * h[3]);
                    }
                s += __shfl_xor(s, 16); s += __shfl_xor(s, 32);
                if (fq == 0) P[(ai * 128 + wr * 64 + m * 16 + fr) * 4 + wc] = s;
            }
        asm volatile("s_waitcnt lgkmcnt(0)" ::: "memory"); __builtin_amdgcn_s_barrier(); asm volatile("" ::: "memory");
        const int row = wid * 32 + (lane & 31);
        if (lane < 32) {
            const float t = (P[row * 4 + 0] + P[row * 4 + 1]) + (P[row * 4 + 2] + P[row * 4 + 3]);
            __hip_atomic_store((unsigned*)xss + ((size_t)(u.arow + row) * 4 + u.pn), __float_as_uint(t), __ATOMIC_RELAXED, __HIP_MEMORY_SCOPE_AGENT);
        }
        asm volatile("s_waitcnt vmcnt(0)" ::: "memory");
        if (lane == 0) __hip_atomic_fetch_add(pcnt + 64 * u.pm, 1u, __ATOMIC_RELAXED, __HIP_MEMORY_SCOPE_AGENT);
        if (wid == 0) {
            unsigned sp = 0;
            while ((unsigned)__builtin_amdgcn_readfirstlane(__hip_atomic_load(pcnt + 64 * u.pm, __ATOMIC_RELAXED, __HIP_MEMORY_SCOPE_AGENT)) < 32u) {
                __builtin_amdgcn_s_sleep(2);
                if ((++sp & 1023u) == 0u) { if (__hip_atomic_load(tmo, __ATOMIC_RELAXED, __HIP_MEMORY_SCOPE_AGENT) != 0u) break; if (sp > (1u << 22)) { if (lane == 0) atomicAdd(tmo, 1u); break; } }
            }
            __builtin_amdgcn_fence(__ATOMIC_ACQUIRE, "agent");
        }
        asm volatile("s_waitcnt vmcnt(0) lgkmcnt(0)" ::: "memory"); __builtin_amdgcn_s_barrier(); asm volatile("" ::: "memory");
        if (lane < 32) {
            const unsigned* slot = (const unsigned*)xss + (size_t)(u.arow + row) * 4; float t = 0.f;
#pragma unroll
            for (int q = 0; q < 4; ++q) t += __uint_as_float(__hip_atomic_load(slot + q, __ATOMIC_RELAXED, __HIP_MEMORY_SCOPE_AGENT));
            S[row] = rsqrtf(t * (1.0f / 1024.0f) + 1e-6f);
        }
        asm volatile("s_waitcnt lgkmcnt(0)" ::: "memory"); __builtin_amdgcn_s_barrier(); asm volatile("" ::: "memory");
        f32x4 fv[2][2];
#pragma unroll
        for (int bj = 0; bj < 2; ++bj)
#pragma unroll
            for (int n = 0; n < 2; ++n) fv[bj][n] = *(const f32x4*)(fg + col0 + bj * 128 + 4 * n);
#pragma unroll
        for (int ai = 0; ai < 2; ++ai)
#pragma unroll
            for (int m = 0; m < 4; ++m) {
                const float rinv = S[ai * 128 + wr * 64 + m * 16 + fr];
#pragma unroll
                for (int bj = 0; bj < 2; ++bj)
#pragma unroll
                    for (int n = 0; n < 2; ++n) *(f32x4*)(op + (size_t)(ai * 128 + m * 16) * 1024 + bj * 128 + 4 * n) = acc[ai][bj][m][n] * rinv * fv[bj][n];
            }
    }
};
struct EpiResNorm {
    static constexpr bool AFTER_DRAIN = true;
    const float* X; float* H; const float* gate; const float* ng; const float* mods_l; bf16_t* XNo; float* xss; unsigned* pcnt; unsigned* tmo;
    __device__ __forceinline__ void fused(Acc& acc, const Unit& u, int wr, int wc, int fr, int fq, LAS unsigned char* lds, int wid, int lane) const {
        LAS float* P = (LAS float*)lds; LAS float* S = (LAS float*)(lds + 8192);
        const int row0 = u.arow + wr * 64 + fr, col0 = u.brow + wc * 32 + fq * 8, b = row0 >> 12;
        const float* ip = X + (size_t)row0 * 1024 + col0; float* op = H + (size_t)row0 * 1024 + col0;
        {
            const float* gp = gate + b * 6144 + col0; f32x4 gv[2][2];
#pragma unroll
            for (int bj = 0; bj < 2; ++bj)
#pragma unroll
                for (int n = 0; n < 2; ++n) gv[bj][n] = *(const f32x4*)(gp + bj * 128 + 4 * n);
#pragma unroll
            for (int ai = 0; ai < 2; ++ai)
#pragma unroll
                for (int m = 0; m < 4; ++m) {
                    float s = 0.f;
#pragma unroll
                    for (int bj = 0; bj < 2; ++bj)
#pragma unroll
                        for (int n = 0; n < 2; ++n) {
                            const f32x4 hv = *(const f32x4*)(ip + (size_t)(ai * 128 + m * 16) * 1024 + bj * 128 + 4 * n);
                            const f32x4 h = hv + gv[bj][n] * acc[ai][bj][m][n]; acc[ai][bj][m][n] = h;
                            *(f32x4*)(op + (size_t)(ai * 128 + m * 16) * 1024 + bj * 128 + 4 * n) = h;
                            s += (h[0] * h[0] + h[1] * h[1]) + (h[2] * h[2] + h[3] * h[3]);
                        }
                    s += __shfl_xor(s, 16); s += __shfl_xor(s, 32);
                    if (fq == 0) P[(ai * 128 + wr * 64 + m * 16 + fr) * 4 + wc] = s;
                }
        }
        asm volatile("s_waitcnt lgkmcnt(0)" ::: "memory"); __builtin_amdgcn_s_barrier(); asm volatile("" ::: "memory");
        const int row = wid * 32 + (lane & 31);
        if (lane < 32) {
            const float t = (P[row * 4 + 0] + P[row * 4 + 1]) + (P[row * 4 + 2] + P[row * 4 + 3]);
            __hip_atomic_store((unsigned*)xss + ((size_t)(u.arow + row) * 4 + u.pn), __float_as_uint(t), __ATOMIC_RELAXED, __HIP_MEMORY_SCOPE_AGENT);
        }
        asm volatile("s_waitcnt vmcnt(0)" ::: "memory");
        if (lane == 0) __hip_atomic_fetch_add(pcnt + 64 * u.pm, 1u, __ATOMIC_RELAXED, __HIP_MEMORY_SCOPE_AGENT);
        if (wid == 0) {
            unsigned sp = 0;
            while ((unsigned)__builtin_amdgcn_readfirstlane(__hip_atomic_load(pcnt + 64 * u.pm, __ATOMIC_RELAXED, __HIP_MEMORY_SCOPE_AGENT)) < 32u) {
                __builtin_amdgcn_s_sleep(2);
                if ((++sp & 1023u) == 0u) { if (__hip_atomic_load(tmo, __ATOMIC_RELAXED, __HIP_MEMORY_SCOPE_AGENT) != 0u) break; if (sp > (1u << 22)) { if (lane == 0) atomicAdd(tmo, 1u); break; } }
            }
            __builtin_amdgcn_fence(__ATOMIC_ACQUIRE, "agent");
        }
        asm volatile("s_waitcnt vmcnt(0) lgkmcnt(0)" ::: "memory"); __builtin_amdgcn_s_barrier(); asm volatile("" ::: "memory");
        if (lane < 32) {
            const unsigned* slot = (const unsigned*)xss + (size_t)(u.arow + row) * 4; float t = 0.f;
#pragma unroll
            for (int q = 0; q < 4; ++q) t += __uint_as_float(__hip_atomic_load(slot + q, __ATOMIC_RELAXED, __HIP_MEMORY_SCOPE_AGENT));
            S[row] = rsqrtf(t * (1.0f / 1024.0f) + 1e-6f);
        }
        asm volatile("s_waitcnt lgkmcnt(0)" ::: "memory"); __builtin_amdgcn_s_barrier(); asm volatile("" ::: "memory");
        bf16_t* xp = XNo + (size_t)row0 * 1024 + col0;
#pragma unroll
        for (int bj = 0; bj < 2; ++bj) {
            f32x4 mv[2], sv[2];
#pragma unroll
            for (int n = 0; n < 2; ++n) { const int c = col0 + bj * 128 + 4 * n; const f32x4 g4 = *(const f32x4*)(ng + c), s4 = *(const f32x4*)(mods_l + (size_t)b * 6144 + 4 * 1024 + c); sv[n] = *(const f32x4*)(mods_l + (size_t)b * 6144 + 3 * 1024 + c);
#pragma unroll
                for (int j = 0; j < 4; ++j) mv[n][j] = g4[j] * (1.0f + s4[j]); }
#pragma unroll
            for (int ai = 0; ai < 2; ++ai)
#pragma unroll
                for (int m = 0; m < 4; ++m) {
                    const float rinv = S[ai * 128 + wr * 64 + m * 16 + fr];
                    const f32x4 y0 = acc[ai][bj][m][0] * rinv * mv[0] + sv[0], y1 = acc[ai][bj][m][1] * rinv * mv[1] + sv[1];
                    *(u32x4*)(xp + (size_t)(ai * 128 + m * 16) * 1024 + bj * 128) = pack8(y0, y1);
                }
        }
    }
};
struct EpiPart {
    bf16_t* slab;
    __device__ __forceinline__ void operator()(const Acc& acc, const Unit& u, int wr, int wc, int fr, int fq) const {
        bf16_t* base = slab + (size_t)(u.kofs >> 8) * 1024 * 1024;
#pragma unroll
        for (int ai = 0; ai < 2; ++ai)
#pragma unroll
            for (int m = 0; m < 4; ++m) {
                const int row = u.arow + ai * 128 + wr * 64 + m * 16 + fr;
                bf16_t* op = base + (size_t)row * 1024;
#pragma unroll
                for (int bj = 0; bj < 2; ++bj) *(u32x4*)(op + u.brow + bj * 128 + wc * 32 + fq * 8) = pack8(acc[ai][bj][m][0], acc[ai][bj][m][1]);
            }
    }
};
struct EpiSwiglu {
    bf16_t* ACT;
    __device__ __forceinline__ void operator()(const Acc& acc, const Unit& u, int wr, int wc, int fr, int fq) const {
#pragma unroll
        for (int ai = 0; ai < 2; ++ai)
#pragma unroll
            for (int m = 0; m < 4; ++m) {
                const int row = u.arow + ai * 128 + wr * 64 + m * 16 + fr;
                const int col = u.pn * 128 + wc * 32 + fq * 8;
                f32x4 o0, o1;
#pragma unroll
                for (int j = 0; j < 4; ++j) { o0[j] = siluf_(acc[ai][0][m][0][j]) * acc[ai][1][m][0][j]; o1[j] = siluf_(acc[ai][0][m][1][j]) * acc[ai][1][m][1][j]; }
                *(u32x4*)(ACT + (size_t)row * FF + col) = pack8(o0, o1);
            }
    }
};
struct EpiGlu {
    float* H; const float* gate;
    __device__ __forceinline__ void operator()(const Acc& acc, const Unit& u, int wr, int wc, int fr, int fq) const {
        const int b = u.arow >> 12; const int col = u.pn * 128 + wc * 32 + fq * 8;
        const float* gp = gate + b * 6144 + col;
        float* hp0 = H + (size_t)(u.arow + wr * 64 + fr) * 1024 + col;
        f32x4 gv[2];
#pragma unroll
        for (int n = 0; n < 2; ++n) gv[n] = *(const f32x4*)(gp + 4 * n);
#pragma unroll
        for (int ai = 0; ai < 2; ++ai) {
            f32x4 hv[4][2];
#pragma unroll
            for (int m = 0; m < 4; ++m)
#pragma unroll
                for (int n = 0; n < 2; ++n) hv[m][n] = *(const f32x4*)(hp0 + (size_t)(ai * 128 + m * 16) * 1024 + 4 * n);
#pragma unroll
            for (int m = 0; m < 4; ++m)
#pragma unroll
                for (int n = 0; n < 2; ++n) {
                    f32x4 o;
#pragma unroll
                    for (int j = 0; j < 4; ++j) o[j] = hv[m][n][j] + gv[n][j] * (acc[ai][0][m][n][j] * sigmoidf_(acc[ai][1][m][n][j]));
                    *(f32x4*)(hp0 + (size_t)(ai * 128 + m * 16) * 1024 + 4 * n) = o;
                }
        }
    }
};
struct EpiGluNorm {
    static constexpr bool AFTER_DRAIN = true;
    float* H; const float* gate; const float* ng; const float* mods_l; bf16_t* XNo; float* xss; unsigned* pcnt; unsigned* tmo;
    __device__ __forceinline__ void fused(Acc& acc, const Unit& u, int wr, int wc, int fr, int fq, LAS unsigned char* lds, int wid, int lane) const {
        LAS float* P = (LAS float*)lds; LAS float* S = (LAS float*)(lds + 8192);
        const int row0 = u.arow + wr * 64 + fr, col = u.pn * 128 + wc * 32 + fq * 8, b = row0 >> 12;
        float* hp = H + (size_t)row0 * 1024 + col;
        {
            const float* gp = gate + b * 6144 + col; f32x4 gv[2];
#pragma unroll
            for (int n = 0; n < 2; ++n) gv[n] = *(const f32x4*)(gp + 4 * n);
#pragma unroll
            for (int ai = 0; ai < 2; ++ai)
#pragma unroll
                for (int m = 0; m < 4; ++m) {
                    float s = 0.f;
#pragma unroll
                    for (int n = 0; n < 2; ++n) {
                        const f32x4 hv = *(const f32x4*)(hp + (size_t)(ai * 128 + m * 16) * 1024 + 4 * n); f32x4 o;
#pragma unroll
                        for (int j = 0; j < 4; ++j) o[j] = hv[j] + gv[n][j] * (acc[ai][0][m][n][j] * sigmoidf_(acc[ai][1][m][n][j]));
                        *(f32x4*)(hp + (size_t)(ai * 128 + m * 16) * 1024 + 4 * n) = o; acc[ai][0][m][n] = o;
                        s += (o[0] * o[0] + o[1] * o[1]) + (o[2] * o[2] + o[3] * o[3]);
                    }
                    s += __shfl_xor(s, 16); s += __shfl_xor(s, 32);
                    if (fq == 0) P[(ai * 128 + wr * 64 + m * 16 + fr) * 4 + wc] = s;
                }
        }
        asm volatile("s_waitcnt lgkmcnt(0)" ::: "memory"); __builtin_amdgcn_s_barrier(); asm volatile("" ::: "memory");
        const int row = wid * 32 + (lane & 31);
        if (lane < 32) {
            const float t = (P[row * 4 + 0] + P[row * 4 + 1]) + (P[row * 4 + 2] + P[row * 4 + 3]);
            __hip_atomic_store((unsigned*)xss + ((size_t)(u.arow + row) * 8 + u.pn), __float_as_uint(t), __ATOMIC_RELAXED, __HIP_MEMORY_SCOPE_AGENT);
        }
        asm volatile("s_waitcnt vmcnt(0)" ::: "memory");
        if (lane == 0) __hip_atomic_fetch_add(pcnt + 64 * u.pm, 1u, __ATOMIC_RELAXED, __HIP_MEMORY_SCOPE_AGENT);
        if (wid == 0) {
            unsigned sp = 0;
            while ((unsigned)__builtin_amdgcn_readfirstlane(__hip_atomic_load(pcnt + 64 * u.pm, __ATOMIC_RELAXED, __HIP_MEMORY_SCOPE_AGENT)) < 64u) {
                __builtin_amdgcn_s_sleep(2);
                if ((++sp & 1023u) == 0u) { if (__hip_atomic_load(tmo, __ATOMIC_RELAXED, __HIP_MEMORY_SCOPE_AGENT) != 0u) break; if (sp > (1u << 22)) { if (lane == 0) atomicAdd(tmo, 1u); break; } }
            }
            __builtin_amdgcn_fence(__ATOMIC_ACQUIRE, "agent");
        }
        asm volatile("s_waitcnt vmcnt(0) lgkmcnt(0)" ::: "memory"); __builtin_amdgcn_s_barrier(); asm volatile("" ::: "memory");
        if (lane < 32) {
            const unsigned* slot = (const unsigned*)xss + (size_t)(u.arow + row) * 8; float t = 0.f;
#pragma unroll
            for (int q = 0; q < 8; ++q) t += __uint_as_float(__hip_atomic_load(slot + q, __ATOMIC_RELAXED, __HIP_MEMORY_SCOPE_AGENT));
            S[row] = rsqrtf(t * (1.0f / 1024.0f) + 1e-6f);
        }
        asm volatile("s_waitcnt lgkmcnt(0)" ::: "memory"); __builtin_amdgcn_s_barrier(); asm volatile("" ::: "memory");
        f32x4 mv[2], sv[2];
#pragma unroll
        for (int n = 0; n < 2; ++n) { const int c = col + 4 * n; const f32x4 g4 = *(const f32x4*)(ng + c), s4 = *(const f32x4*)(mods_l + (size_t)b * 6144 + 4 * 1024 + c); sv[n] = *(const f32x4*)(mods_l + (size_t)b * 6144 + 3 * 1024 + c);
#pragma unroll
            for (int j = 0; j < 4; ++j) mv[n][j] = g4[j] * (1.0f + s4[j]); }
        bf16_t* xp = XNo + (size_t)row0 * 1024 + col;
#pragma unroll
        for (int ai = 0; ai < 2; ++ai)
#pragma unroll
            for (int m = 0; m < 4; ++m) {
                const float rinv = S[ai * 128 + wr * 64 + m * 16 + fr];
                const f32x4 y0 = acc[ai][0][m][0] * rinv * mv[0] + sv[0], y1 = acc[ai][0][m][1] * rinv * mv[1] + sv[1];
                *(u32x4*)(xp + (size_t)(ai * 128 + m * 16) * 1024) = pack8(y0, y1);
            }
    }
};
struct EpiState {
    bf16_t* S;
    __device__ __forceinline__ void operator()(const Acc& acc, const Unit& u, int wr, int wc, int fr, int fq) const {
        bf16_t* base = S + (size_t)u.pn * SROWS * 256;
#pragma unroll
        for (int ai = 0; ai < 2; ++ai)
#pragma unroll
            for (int m = 0; m < 4; ++m) {
                const int lrow = u.pm * 256 + ai * 128 + wr * 64 + m * 16 + fr;
                bf16_t* op = base + (size_t)lrow * 256;
#pragma unroll
                for (int bj = 0; bj < 2; ++bj) *(u32x4*)(op + bj * 128 + wc * 32 + fq * 8) = pack8(acc[ai][bj][m][0], acc[ai][bj][m][1]);
            }
    }
};
struct EpiSout {
    bf16_t* GY;
    __device__ __forceinline__ void operator()(const Acc& acc, const Unit& u, int wr, int wc, int fr, int fq) const {
#pragma unroll
        for (int ai = 0; ai < 2; ++ai)
#pragma unroll
            for (int m = 0; m < 4; ++m) {
                const int lrow = u.pm * 256 + ai * 128 + wr * 64 + m * 16 + fr;
                const int b = lrow >> 8, ch = lrow & 255;
#pragma unroll
                for (int bj = 0; bj < 2; ++bj) {
                    const int n = bj * 128 + wc * 32 + fq * 8; const int t = n >> 4, h0 = n & 15;
                    f32x4 o0, o1;
#pragma unroll
                    for (int j = 0; j < 4; ++j) { o0[j] = gelu_tanh(acc[ai][bj][m][0][j]); o1[j] = gelu_tanh(acc[ai][bj][m][1][j]); }
                    *(u32x4*)(GY + (size_t)(b * 4096 + ch * 16 + t) * 1024 + u.pn * 16 + h0) = pack8(o0, o1);
                }
            }
    }
};

__device__ __forceinline__ void p0_transpose(const float* src, int ld, int K, int c0, bf16_t* dst, float scale, LAS float* tile) {
    const int tid = otid();
    const int lkk = tid >> 7, lcc = tid & 127;
    float r[16];
#pragma unroll
    for (int i = 0; i < 16; ++i) r[i] = __builtin_nontemporal_load(src + (size_t)(lkk + 4 * i) * ld + c0 + lcc);
    for (int k0 = 0; k0 < K; k0 += 64) {
        __syncthreads();
#pragma unroll
        for (int i = 0; i < 16; ++i) tile[(lkk + 4 * i) * 129 + lcc] = r[i];
        if (k0 + 64 < K) {
#pragma unroll
            for (int i = 0; i < 16; ++i) r[i] = __builtin_nontemporal_load(src + (size_t)(k0 + 64 + lkk + 4 * i) * ld + c0 + lcc);
        }
        __syncthreads();
        { const int cc = tid >> 2, kk0 = (tid & 3) * 16; float v[16];
#pragma unroll
          for (int j = 0; j < 16; ++j) v[j] = tile[(kk0 + j) * 129 + cc] * scale;
          u32x4 w0, w1; w0.x = cvt_pk_bf16(v[0], v[1]); w0.y = cvt_pk_bf16(v[2], v[3]); w0.z = cvt_pk_bf16(v[4], v[5]); w0.w = cvt_pk_bf16(v[6], v[7]);
          w1.x = cvt_pk_bf16(v[8], v[9]); w1.y = cvt_pk_bf16(v[10], v[11]); w1.z = cvt_pk_bf16(v[12], v[13]); w1.w = cvt_pk_bf16(v[14], v[15]);
          bf16_t* dp = dst + (size_t)cc * K + k0 + kk0; *(u32x4*)dp = w0; *(u32x4*)(dp + 8) = w1; }
    }
    __syncthreads();
}

__device__ __forceinline__ void p0_s5_item(const Params& p, int g, LAS float* L) {
    const int tid = otid();
    LAS float* pw_re = L;
    LAS float* pw_im = L + 2176;
    LAS float* bb_re = L + 4352;
    LAS float* bb_im = L + 6400;
    LAS float* cc_re = L + 8448;
    LAS float* cc_im = L + 10528;
    LAS float* Kt = L + 12608;
    __syncthreads();
    for (int idx = tid; idx < 2176; idx += NT) {
        const int dir = idx / 1088, rem = idx - dir * 1088, pp = rem / 17, tau = rem - pp * 17;
        const float dt = expf(p.log_dt[dir * 64 + g]);
        const float are = p.a_re[(dir * 64 + g) * 64 + pp], aim = p.a_im[(dir * 64 + g) * 64 + pp];
        const float mag = expf(are * dt * (float)tau); float s, c; sincosf(aim * dt * (float)tau, &s, &c);
        pw_re[idx] = mag * c; pw_im[idx] = mag * s;
    }
    __syncthreads();
    if (tid < 128) {
        const int dir = tid >> 6, pp = tid & 63;
        const float are = p.a_re[(dir * 64 + g) * 64 + pp], aim = p.a_im[(dir * 64 + g) * 64 + pp];
        const float abr = pw_re[(dir * 64 + pp) * 17 + 1], abi = pw_im[(dir * 64 + pp) * 17 + 1];
        const float nr = abr - 1.0f, ni = abi, den = are * are + aim * aim;
        const float fre = (nr * are + ni * aim) / den, fim = (ni * are - nr * aim) / den;
        for (int h = 0; h < 16; ++h) {
            const float br = p.b_re[((size_t)(dir * 64 + g) * 64 + pp) * 16 + h], bi = p.b_im[((size_t)(dir * 64 + g) * 64 + pp) * 16 + h];
            bb_re[(dir * 64 + pp) * 16 + h] = fre * br - fim * bi; bb_im[(dir * 64 + pp) * 16 + h] = fre * bi + fim * br;
        }
    }
    for (int idx = tid; idx < 2048; idx += NT) {
        const int dir = idx >> 10, h = (idx >> 6) & 15, pp = idx & 63;
        cc_re[(dir * 16 + h) * 65 + pp] = p.c_re[((size_t)(dir * 64 + g) * 16 + h) * 64 + pp]; cc_im[(dir * 16 + h) * 65 + pp] = p.c_im[((size_t)(dir * 64 + g) * 16 + h) * 64 + pp];
    }
    __syncthreads();
    {
        const int dir = tid >> 8, tau = (tid >> 4) & 15, h = tid & 15;
        float a[16];
#pragma unroll
        for (int j = 0; j < 16; ++j) a[j] = 0.f;
        for (int pp = 0; pp < 64; ++pp) {
            const float cr = cc_re[(dir * 16 + h) * 65 + pp], ci = cc_im[(dir * 16 + h) * 65 + pp];
            const float pr = pw_re[(dir * 64 + pp) * 17 + tau], pi = pw_im[(dir * 64 + pp) * 17 + tau];
            const float xr = cr * pr - ci * pi, xi = cr * pi + ci * pr;
#pragma unroll
            for (int j = 0; j < 16; ++j) a[j] += xr * bb_re[(dir * 64 + pp) * 16 + j] - xi * bb_im[(dir * 64 + pp) * 16 + j];
        }
#pragma unroll
        for (int j = 0; j < 16; ++j) Kt[tid * 16 + j] = a[j];
    }
    __syncthreads();
    bf16_t* Wst = (bf16_t*)(p.ws + O_WST) + (size_t)g * 256 * 256;
    for (int ch = tid; ch < 8192; ch += NT) {
        const int n = ch >> 5, k0 = (ch & 31) * 8; const int dir = n >> 7, ri = (n >> 6) & 1, pp = n & 63, s = k0 >> 4, h0 = k0 & 15; const int e = dir ? s : 15 - s;
        const float pr = pw_re[(dir * 64 + pp) * 17 + e], pi = pw_im[(dir * 64 + pp) * 17 + e];
        float v[8];
#pragma unroll
        for (int j = 0; j < 8; ++j) { const float br = bb_re[(dir * 64 + pp) * 16 + h0 + j], bi = bb_im[(dir * 64 + pp) * 16 + h0 + j]; v[j] = ri ? (pr * bi + pi * br) : (pr * br - pi * bi); }
        u32x4 w; w.x = cvt_pk_bf16(v[0], v[1]); w.y = cvt_pk_bf16(v[2], v[3]); w.z = cvt_pk_bf16(v[4], v[5]); w.w = cvt_pk_bf16(v[6], v[7]);
        *(u32x4*)(Wst + (size_t)n * 256 + k0) = w;
    }
    bf16_t* Tt = (bf16_t*)(p.ws + O_TT) + (size_t)g * 256 * 512;
    for (int ch = tid; ch < 16384; ch += NT) {
        const int n = ch >> 6, k0 = (ch & 63) * 8; const int t = n >> 4, h = n & 15; float v[8];
        if (k0 < 256) {
            const int s = k0 >> 4, h0 = k0 & 15;
#pragma unroll
            for (int j = 0; j < 8; ++j) {
                float x = 0.f;
                if (s <= t) x += Kt[((0 * 16 + (t - s)) * 16 + h) * 16 + h0 + j];
                if (s >= t) x += Kt[((1 * 16 + (s - t)) * 16 + h) * 16 + h0 + j];
                if (s == t && h == h0 + j) x += p.ssm_d[g * 16 + h];
                v[j] = x;
            }
        } else {
            const int kk = k0 - 256, dir = kk >> 7, ri = (kk >> 6) & 1, p0 = kk & 63; const int e = dir ? 16 - t : t + 1;
#pragma unroll
            for (int j = 0; j < 8; ++j) {
                const int pp = p0 + j;
                const float cr = cc_re[(dir * 16 + h) * 65 + pp], ci = cc_im[(dir * 16 + h) * 65 + pp], pr = pw_re[(dir * 64 + pp) * 17 + e], pi = pw_im[(dir * 64 + pp) * 17 + e];
                v[j] = ri ? -(cr * pi + ci * pr) : (cr * pr - ci * pi);
            }
        }
        u32x4 w; w.x = cvt_pk_bf16(v[0], v[1]); w.y = cvt_pk_bf16(v[2], v[3]); w.z = cvt_pk_bf16(v[4], v[5]); w.w = cvt_pk_bf16(v[6], v[7]);
        *(u32x4*)(Tt + (size_t)n * 512 + k0) = w;
    }
    __syncthreads();
}

__device__ __forceinline__ void p0_adaln_item(const Params& p, int it, LAS float* L) {
    const int tid = otid(); const int l = it / 96, n0 = (it % 96) * 64;
    LAS float* sc = L;
    LAS float* red = L + 5120;
    __syncthreads();
    for (int idx = tid; idx < 5120; idx += NT) { const int r = idx >> 10, k = idx & 1023; const float v = (r < 4) ? p.c[r * 1024 + k] : p.c_ctx[k]; sc[idx] = siluf_(v); }
    __syncthreads();
    const int n = tid & 63, kq = tid >> 6; float a[5] = {0.f, 0.f, 0.f, 0.f, 0.f};
    const float* wp = p.mod_w + (size_t)l * 1024 * 6144 + n0 + n;
    for (int k = kq; k < 1024; k += 128) {
        float w[16];
#pragma unroll
        for (int u = 0; u < 16; ++u) w[u] = __builtin_nontemporal_load(wp + (size_t)(k + 8 * u) * 6144);
#pragma unroll
        for (int u = 0; u < 16; ++u)
#pragma unroll
            for (int r = 0; r < 5; ++r) a[r] += sc[r * 1024 + k + 8 * u] * w[u];
    }
#pragma unroll
    for (int r = 0; r < 5; ++r) red[(kq * 5 + r) * 64 + n] = a[r];
    __syncthreads();
    if (tid < 320) { const int r = tid >> 6, nn = tid & 63; float s = p.mod_b[l * 6144 + n0 + nn];
#pragma unroll
        for (int q = 0; q < 8; ++q) s += red[(q * 5 + r) * 64 + nn];
        ((float*)(p.ws + O_MODS))[(size_t)(l * 5 + r) * 6144 + n0 + nn] = s; }
    __syncthreads();
}

__device__ __forceinline__ void p0_fold_item(const Params& p, int it, LAS float* L) {
    const int tid = otid(); const int grp = it >> 4, kt = it & 15;
    LAS float* w = L;
    LAS float* cT = L + 4160;
    LAS float* sT = L + 4224;
    __syncthreads();
#pragma unroll
    for (int i = 0; i < 8; ++i) { const int idx = tid + i * NT, kk = idx >> 6, j = idx & 63; w[kk * 65 + j] = p.w_in[(size_t)(kt * 64 + kk) * 1280 + grp * 64 + j]; }
    if (tid < 64) { cT[tid] = cospif((float)tid / 32.0f); sT[tid] = sinpif((float)tid / 32.0f); }
    __syncthreads();
    const int kk = tid & 63, q = tid >> 6; bf16_t* WinA = (bf16_t*)(p.ws + O_WINA);
    for (int i = 0; i < 8; ++i) {
        const int n = q + 8 * i; float ac = 0.f, as = 0.f; int ph = 0;
        for (int j = 0; j < 64; ++j) { const float wv = w[kk * 65 + j]; ac += wv * cT[ph]; as += wv * sT[ph]; ph = (ph + n) & 63; }
        WinA[(size_t)(grp * 64 + n) * 1024 + kt * 64 + kk] = f2bf(ac);
        WinA[(size_t)(512 + grp * 64 + n) * 1024 + kt * 64 + kk] = f2bf(as);
    }
    __syncthreads();
}

__device__ __forceinline__ void p0_dft_item(const Params& p, int it, LAS float* L) {
    const int tid = otid();
    __syncthreads();
    for (int i = tid; i < 256; i += NT) L[i] = cospif((float)i / 128.0f);
    __syncthreads();
    if (it == 0) {
        bf16_t* D = (bf16_t*)(p.ws + O_D256);
        for (int idx = tid; idx < 512 * 512; idx += NT) {
            const int row = idx >> 9, col = idx & 511; const int ro = row >> 8, k = row & 255, cs = col >> 8, t = col & 255; const int ph = (k * t) & 255;
            const float C = L[ph], S = L[(ph - 64) & 255];
            const float v = ro == 0 ? (cs == 0 ? C : -S) : (cs == 0 ? -S : -C);
            D[idx] = f2bf(v);
        }
    } else {
        bf16_t* Dc = (bf16_t*)(p.ws + O_DC);
        for (int idx = tid; idx < 256 * 512; idx += NT) {
            const int k = idx >> 9, j = idx & 511, t = j & 255, cs = j >> 8; const int ph = (k * t) & 255;
            Dc[idx] = f2bf((cs ? -L[(ph - 64) & 255] : L[ph]) * (1.0f / 128.0f));
        }
    }
    __syncthreads();
}

constexpr int P0_S5 = 64, P0_ADA = 192, P0_FOLD = 128, P0_TR = 134, P0_DFT = 2, P0_MISC = 1;
constexpr int P0_ITEMS = P0_S5 + P0_ADA + P0_FOLD + P0_TR + P0_DFT + P0_MISC;

__device__ __forceinline__ void p0_transpose_dispatch(const Params& p, int it, LAS float* L) {
    unsigned char* ws = p.ws;
    const float* src; int ld, K, c0; bf16_t* dst; float scale = 1.0f;
    if (it < 16) { const int l = it >> 3; it &= 7; src = p.ffn_d + (size_t)l * FF * 1024; ld = 1024; K = FF; c0 = 128 * it; dst = (bf16_t*)(ws + (l ? O_WD1 : O_WD0)) + (size_t)(128 * it) * FF; }
    else {
        it -= 16;
        if (it < 4) { src = p.w_in; ld = 1280; K = 1024; c0 = 512 + 128 * it; dst = (bf16_t*)(ws + O_WINB) + (size_t)(128 * it) * 1024; scale = 0.125f * 1.4426950408889634f; }
        else if (it < 5) { src = p.w_in; ld = 1280; K = 1024; c0 = 1024; dst = (bf16_t*)(ws + O_WINB) + (size_t)512 * 1024; }
        else if (it < 6) { src = p.w_in; ld = 1280; K = 1024; c0 = 1152; dst = (bf16_t*)(ws + O_WINB) + (size_t)640 * 1024; }
        else if (it < 14) { it -= 6; src = p.w_out; ld = 1024; K = 1024; c0 = 128 * it; dst = (bf16_t*)(ws + O_WOUT) + (size_t)(128 * it) * 1024; }
        else if (it < 14 + 88) {
            it -= 14; const int l = it / 44; it -= l * 44;
            bf16_t* wgu = (bf16_t*)(ws + (l ? O_WGU1 : O_WGU0));
            const int up = it / 22, tile = it % 22;
            src = (up ? p.ffn_u : p.ffn_g) + (size_t)l * 1024 * FF; ld = FF; K = 1024; c0 = 128 * tile; dst = wgu + (size_t)(tile * 256 + up * 128) * 1024;
        } else {
            it -= 102; c0 = 128 * it; const int half = c0 >> 10, j = c0 & 1023;
            src = p.glu_w; ld = 2048; K = 1024; dst = (bf16_t*)(ws + O_GLU) + (size_t)((j >> 7) * 256 + half * 128) * 1024;
        }
    }
    p0_transpose(src, ld, K, c0, dst, scale, L);
}

__device__ __forceinline__ void p0_misc(const Params& p) {
    const int tid = otid();
    float* rc = (float*)(p.ws + O_ROPE); float* rs = rc + 1024;
    for (int i = tid; i < 1024; i += NT) { const int pp = i >> 4, f = i & 15; const float inv = powf(10000.0f, -(float)f / 16.0f); const float ang = (float)pp * inv; float s, c; sincosf(ang, &s, &c); rc[i] = c; rs[i] = s; }
}

__device__ __forceinline__ void p0_dispatch(const Params& p, int it, LAS float* L) {
    int i = it;
    if (i < 64) { p0_s5_item(p, i, L); return; } i -= 64;
    if (i < 16) { p0_transpose_dispatch(p, i, L); return; } i -= 16;
    if (i < 128) { p0_fold_item(p, i, L); return; } i -= 128;
    if (i < 118) { p0_transpose_dispatch(p, 16 + i, L); return; } i -= 118;
    if (i < 192) { p0_adaln_item(p, i, L); return; } i -= 192;
    if (i < 2) { p0_dft_item(p, i, L); return; } i -= 2;
    p0_misc(p);
}
__device__ __forceinline__ void phase_p0(const Params& p, LAS float* L, unsigned* qhead, volatile LAS unsigned* qslot) {
    for (;;) {
        __syncthreads();
        if (threadIdx.x == 0) qslot[0] = __hip_atomic_fetch_add(qhead, 1u, __ATOMIC_RELAXED, __HIP_MEMORY_SCOPE_AGENT);
        __syncthreads();
        const int it = (int)qslot[0];
        if (it >= P0_ITEMS) break;
        p0_dispatch(p, it, L);
    }
}

template <int MODE>
__device__ __forceinline__ void phase_norm(const float* src_lat, const float* src_ctx, int nrows, const float* ng, const float* mods_l, int sh_idx, int sc_idx, bf16_t* dstb, float* dstf,
                                           const bf16_t* part = nullptr, int npart = 0, const float* pgate = nullptr, float* hstore = nullptr, int row_first = 0) {
    const int tid_ = otid(); const int lane = tid_ & 63, wv = obid() * 8 + (tid_ >> 6), nw = gridDim.x * 8;
    for (int row = row_first + wv; row < nrows; row += nw) {
        const float* sp; int mr;
        if (row < NLAT) { sp = src_lat + (size_t)row * 1024; mr = row >> 12; } else { sp = src_ctx + (size_t)(row - NLAT) * 1024; mr = 4; }
        f32x4 v[4]; float ss = 0.f;
#pragma unroll
        for (int i = 0; i < 4; ++i) v[i] = *(const f32x4*)(sp + i * 256 + lane * 4);
        if (npart > 0 && row >= NLAT) {
#pragma unroll
            for (int i = 0; i < 4; ++i) {
                const int col = i * 256 + lane * 4; f32x4 s = {0.f, 0.f, 0.f, 0.f};
#pragma unroll 2
                for (int k = 0; k < npart; ++k) { const u32x2 w = *(const u32x2*)(part + ((size_t)k * 1024 + (row - NLAT)) * 1024 + col);
                    s[0] += __uint_as_float(w.x << 16); s[1] += __uint_as_float(w.x & 0xFFFF0000u); s[2] += __uint_as_float(w.y << 16); s[3] += __uint_as_float(w.y & 0xFFFF0000u); }
                v[i] += *(const f32x4*)(pgate + col) * s;
                if (hstore) *(f32x4*)(hstore + (size_t)(row - NLAT) * 1024 + col) = v[i];
            }
        }
#pragma unroll
        for (int i = 0; i < 4; ++i) ss += v[i][0] * v[i][0] + v[i][1] * v[i][1] + v[i][2] * v[i][2] + v[i][3] * v[i][3];
#pragma unroll
        for (int o = 32; o >= 1; o >>= 1) ss += __shfl_xor(ss, o);
        const float rinv = rsqrtf(ss * (1.0f / 1024.0f) + 1e-6f);
#pragma unroll
        for (int i = 0; i < 4; ++i) {
            const int col = i * 256 + lane * 4; const f32x4 gv = *(const f32x4*)(ng + col); f32x4 y;
            if (MODE == 2) {
#pragma unroll
                for (int j = 0; j < 4; ++j) y[j] = v[i][j] * rinv * gv[j];
                *(f32x4*)(dstf + (size_t)row * 1024 + col) = y;
            } else {
                const f32x4 sh = *(const f32x4*)(mods_l + (size_t)mr * 6144 + sh_idx * 1024 + col), sc = *(const f32x4*)(mods_l + (size_t)mr * 6144 + sc_idx * 1024 + col);
#pragma unroll
                for (int j = 0; j < 4; ++j) y[j] = v[i][j] * rinv * gv[j] * (1.0f + sc[j]) + sh[j];
                u32x2 w; w.x = cvt_pk_bf16(y[0], y[1]); w.y = cvt_pk_bf16(y[2], y[3]);
                if (MODE == 0) *(u32x2*)(dstb + (size_t)row * 1024 + col) = w;
                else {
                    int lrow, s;
                    if (row < NLAT) { const int b = row >> 12, t = row & 4095; lrow = b * 256 + (t >> 4); s = t & 15; } else { const int r2 = row - NLAT, b = r2 >> 8, t = r2 & 255; lrow = 1024 + b * 16 + (t >> 4); s = t & 15; }
                    const int g = col >> 4, h2 = col & 15;
                    *(u32x2*)(dstb + ((size_t)g * GROWS + lrow) * 512 + s * 16 + h2) = w;
                }
            }
        }
    }
}

struct AttnFr { bf16x8 k[4]; bf16x8 v[4]; };
__device__ __forceinline__ void attn_load(AttnFr& f, const bf16_t* kp, const bf16_t* vp) {
#pragma unroll
    for (int kk = 0; kk < 4; ++kk) f.k[kk] = *(const bf16x8*)(kp + 16 * kk);
#pragma unroll
    for (int q = 0; q < 4; ++q) f.v[q] = *(const bf16x8*)(vp + q * 512);
}

__device__ __forceinline__ void attn_item(const Params& p, int item) {
    const int lane = otid() & 63, r = lane & 31, h = lane >> 5;
    const bf16_t* Q = (const bf16_t*)(p.ws + O_Q); const bf16_t* Kb = (const bf16_t*)(p.ws + O_K);
    const bf16_t* VT = (const bf16_t*)(p.ws + O_VT); const bf16_t* VTc = (const bf16_t*)(p.ws + O_VTC);
    bf16_t* MIX = (bf16_t*)(p.ws + O_MIX);
    int b, qt, hq, tok0, q0, ntile; bool isctx;
    if (item < 4096) { isctx = false; b = item >> 10; qt = (item >> 3) & 127; hq = item & 7; q0 = qt * 32; tok0 = b * 4096 + q0; ntile = 17; }
    else { const int it = item - 4096; isctx = true; b = it >> 6; qt = (it >> 3) & 7; hq = it & 7; q0 = qt * 32; tok0 = NLAT + b * 256 + q0; ntile = 8; }
    const int kvh = hq >> 2;
    bf16x8 qf[4];
    { const bf16_t* qp = Q + (size_t)(tok0 + r) * 512 + hq * 64 + h * 8;
#pragma unroll
      for (int kk = 0; kk < 4; ++kk) qf[kk] = *(const bf16x8*)(qp + 16 * kk); }
    float mrun = p.sink[hq] * 1.4426950408889634f, lrun = 1.0f;
    f32x16 o0, o1;
#pragma unroll
    for (int i = 0; i < 16; ++i) { o0[i] = 0.f; o1[i] = 0.f; }
    const int qpos = q0 + r;
    auto tile_ptrs = [&](int ti, const bf16_t*& kp, const bf16_t*& vp) {
        if (ti < 8) { kp = Kb + (size_t)(NLAT + b * 256 + 32 * ti + r) * 128 + kvh * 64 + h * 8; vp = VTc + (size_t)((b * 2 + kvh) * 8 + ti) * 2048 + lane * 8; }
        else { const int kbase = q0 - 128 + 32 * (ti - 8); const int kc = kbase < 0 ? 0 : (kbase > 4064 ? 4064 : kbase);
               kp = Kb + (size_t)(b * 4096 + kc + r) * 128 + kvh * 64 + h * 8; vp = VT + (size_t)((b * 2 + kvh) * 128 + (kc >> 5)) * 2048 + lane * 8; }
    };
    AttnFr cur, nxt;
    { const bf16_t *kp, *vp; tile_ptrs(0, kp, vp); attn_load(cur, kp, vp); }
    for (int ti = 0; ti < ntile; ++ti) {
        if (ti + 1 < ntile) { const bf16_t *kp, *vp; tile_ptrs(ti + 1, kp, vp); attn_load(nxt, kp, vp); }
        f32x16 s;
#pragma unroll
        for (int i = 0; i < 16; ++i) s[i] = 0.f;
#pragma unroll
        for (int kk = 0; kk < 4; ++kk) s = __builtin_amdgcn_mfma_f32_32x32x16_bf16(cur.k[kk], qf[kk], s, 0, 0, 0);
        if (ti >= 8) {
            const int kbase = q0 - 128 + 32 * (ti - 8);
            if (ti == 8 || ti == 16 || kbase < 0 || kbase > 4064) {
#pragma unroll
                for (int i = 0; i < 16; ++i) { const int kpos = kbase + (i & 3) + 8 * (i >> 2) + 4 * h; const int d = kpos - qpos; const bool ok = (kpos >= 0) && (kpos < 4096) && (d <= 128) && (d >= -128); s[i] = ok ? s[i] : -1e30f; }
            }
        }
        float mx = s[0];
#pragma unroll
        for (int i = 1; i < 16; ++i) mx = fmaxf(mx, s[i]);
        mx = fmaxf(mx, __shfl_xor(mx, 32));
        const float mnew = fmaxf(mrun, mx), alpha = __builtin_amdgcn_exp2f(mrun - mnew);
        float ps = 0.f; float pv[16];
#pragma unroll
        for (int i = 0; i < 16; ++i) { pv[i] = __builtin_amdgcn_exp2f(s[i] - mnew); ps += pv[i]; }
        ps += __shfl_xor(ps, 32);
        lrun = lrun * alpha + ps;
        if (__builtin_amdgcn_ballot_w64(mnew != mrun) != 0ull) {
#pragma unroll
            for (int i = 0; i < 16; ++i) { o0[i] *= alpha; o1[i] *= alpha; }
        }
        mrun = mnew;
        bf16x8 pf[2];
#pragma unroll
        for (int sidx = 0; sidx < 2; ++sidx) { u32x4 w; w.x = cvt_pk_bf16(pv[8 * sidx + 0], pv[8 * sidx + 1]); w.y = cvt_pk_bf16(pv[8 * sidx + 2], pv[8 * sidx + 3]); w.z = cvt_pk_bf16(pv[8 * sidx + 4], pv[8 * sidx + 5]); w.w = cvt_pk_bf16(pv[8 * sidx + 6], pv[8 * sidx + 7]); pf[sidx] = __builtin_bit_cast(bf16x8, w); }
#pragma unroll
        for (int sidx = 0; sidx < 2; ++sidx) {
            o0 = __builtin_amdgcn_mfma_f32_32x32x16_bf16(cur.v[sidx], pf[sidx], o0, 0, 0, 0);
            o1 = __builtin_amdgcn_mfma_f32_32x32x16_bf16(cur.v[2 + sidx], pf[sidx], o1, 0, 0, 0);
        }
        cur = nxt;
    }
    const float inv = 1.0f / lrun;
    bf16_t* op = MIX + (size_t)(tok0 + r) * 1024 + 512 + hq * 64;
#pragma unroll
    for (int rg = 0; rg < 4; ++rg) {
        const int d0 = 8 * rg + 4 * h;
        u32x2 w0, w1;
        w0.x = cvt_pk_bf16(o0[4 * rg] * inv, o0[4 * rg + 1] * inv); w0.y = cvt_pk_bf16(o0[4 * rg + 2] * inv, o0[4 * rg + 3] * inv);
        w1.x = cvt_pk_bf16(o1[4 * rg] * inv, o1[4 * rg + 1] * inv); w1.y = cvt_pk_bf16(o1[4 * rg + 2] * inv, o1[4 * rg + 3] * inv);
        *(u32x2*)(op + d0) = w0; *(u32x2*)(op + 32 + d0) = w1;
    }
}


__device__ __forceinline__ void phase_dft_combine(const Params& p, LAS float* L) {
    const int tid = otid(); const int G = gridDim.x, bx = obid();
    const bf16_t* I2 = (const bf16_t*)(p.ws + O_I2); bf16_t* MIX = (bf16_t*)(p.ws + O_MIX);
    constexpr float C16[16] = {1.0f, 0.92387953251f, 0.70710678119f, 0.38268343237f, 0.0f, -0.38268343237f, -0.70710678119f, -0.92387953251f, -1.0f, -0.92387953251f, -0.70710678119f, -0.38268343237f, 0.0f, 0.38268343237f, 0.70710678119f, 0.92387953251f};
    constexpr float S16[16] = {0.0f, 0.38268343237f, 0.70710678119f, 0.92387953251f, 1.0f, 0.92387953251f, 0.70710678119f, 0.38268343237f, 0.0f, -0.38268343237f, -0.70710678119f, -0.92387953251f, -1.0f, -0.92387953251f, -0.70710678119f, -0.38268343237f};
    for (int pair = bx; pair < 1024; pair += G) {
        const int b = pair >> 8, kp = pair & 255;
        __syncthreads();
        if (tid < 16) { float s, c; sincospif((float)(kp * tid) / 2048.0f, &s, &c); L[tid] = c; L[16 + tid] = s; }
        __syncthreads();
        const int c = tid;
        const u32x4* pr = (const u32x4*)(I2 + (size_t)kp * 32768 + (size_t)(b * 512 + c) * 16);
        const u32x4* pi = (const u32x4*)(I2 + (size_t)(256 + kp) * 32768 + (size_t)(b * 512 + c) * 16);
        const u32x4 r0 = pr[0], r1 = pr[1], i0 = pi[0], i1 = pi[1];
        const unsigned rw[8] = {r0.x, r0.y, r0.z, r0.w, r1.x, r1.y, r1.z, r1.w}, iw[8] = {i0.x, i0.y, i0.z, i0.w, i1.x, i1.y, i1.z, i1.w};
        float xr[16], xi[16];
#pragma unroll
        for (int r = 0; r < 16; ++r) {
            const float ire = __uint_as_float((r & 1) ? (rw[r >> 1] & 0xFFFF0000u) : (rw[r >> 1] << 16));
            const float iim = __uint_as_float((r & 1) ? (iw[r >> 1] & 0xFFFF0000u) : (iw[r >> 1] << 16));
            const float ct = L[r], st = L[16 + r];
            xr[r] = ire * ct + iim * st; xi[r] = iim * ct - ire * st;
        }
#pragma unroll
        for (int j = 0; j < 16; ++j) {
            float y = 0.f;
#pragma unroll
            for (int r = 0; r < 16; ++r) y += xr[r] * C16[(j * r) & 15] + xi[r] * S16[(j * r) & 15];
            MIX[(size_t)(b * 4096 + kp + 256 * j) * 1024 + c] = f2bf(y * (1.0f / 512.0f));
        }
    }
}

__device__ __forceinline__ void phase_scan(const Params& p) {
    const int tid_ = otid(); const int lane = tid_ & 63, wave = tid_ >> 6;
    const bf16_t* S = (const bf16_t*)(p.ws + O_S); bf16_t* A2 = (bf16_t*)(p.ws + O_A2);
    const int nitems = 512;
    for (int item = obid() + gridDim.x * wave; item < nitems; item += gridDim.x * 8) {
        const int b = item >> 7, g = (item >> 1) & 63, dir = item & 1, pp = lane;
        const float dt = expf(p.log_dt[dir * 64 + g]);
        const float are = p.a_re[(dir * 64 + g) * 64 + pp], aim = p.a_im[(dir * 64 + g) * 64 + pp];
        const float mag = expf(are * dt * 16.0f); float sn, cs; sincosf(aim * dt * 16.0f, &sn, &cs);
        const float ar = mag * cs, ai = mag * sn;
        float hr = 0.f, hi = 0.f;
        const bf16_t* Sg = S + (size_t)g * SROWS * 256 + dir * 128 + pp;
        bf16_t* Ag = A2 + (size_t)g * GROWS * 512 + 256 + dir * 128 + pp;
        for (int i = 0; i < 16; ++i) {
            const int ch = dir ? 15 - i : i; const size_t lrow = 1024 + b * 16 + ch;
            const float sr = __uint_as_float((unsigned)Sg[lrow * 256] << 16), si = __uint_as_float((unsigned)Sg[lrow * 256 + 64] << 16);
            const float nr = ar * hr - ai * hi + sr, ni = ar * hi + ai * hr + si; hr = nr; hi = ni;
        }
        for (int i0 = 0; i0 < 256; i0 += 8) {
            float sr[8], si[8];
#pragma unroll
            for (int j = 0; j < 8; ++j) { const int ch = dir ? 255 - (i0 + j) : (i0 + j); const size_t lrow = b * 256 + ch; sr[j] = __uint_as_float((unsigned)Sg[lrow * 256] << 16); si[j] = __uint_as_float((unsigned)Sg[lrow * 256 + 64] << 16); }
#pragma unroll
            for (int j = 0; j < 8; ++j) {
                const int ch = dir ? 255 - (i0 + j) : (i0 + j); const size_t lrow = b * 256 + ch;
                Ag[lrow * 512] = f2bf(hr); Ag[lrow * 512 + 64] = f2bf(hi);
                const float nr = ar * hr - ai * hi + sr[j], ni = ar * hi + ai * hr + si[j]; hr = nr; hi = ni;
            }
        }
    }
}


#define XB_TMO      128
#define XB_XCNT(j)  (256  + 64 * (j))
#define XB_XSUB(j)  (1280 + 64 * (j))
#define XB_XGEN(j)  (2304 + 64 * (j))
#define XB_TOP      3328
#define XB_TOPGEN   3392
#define XCD_BAR_WORDS 3456
#define XB_SPIN_CAP (1u << 22)
__device__ __forceinline__ unsigned xb_ld(unsigned* p)              { return __hip_atomic_load(p, __ATOMIC_RELAXED, __HIP_MEMORY_SCOPE_AGENT); }
__device__ __forceinline__ unsigned xb_add(unsigned* p, unsigned v) { return __hip_atomic_fetch_add(p, v, __ATOMIC_RELAXED, __HIP_MEMORY_SCOPE_AGENT); }
__device__ __forceinline__ unsigned xb_xcc_id() { return (unsigned)__builtin_amdgcn_s_getreg((3 << 11) | 20) & 0xFu; }
#define XB_SPIN(cond, bar) do { unsigned _sp = 0; while (cond) { __builtin_amdgcn_s_sleep(1); \
    if ((++_sp & 255u) == 0u) { if (xb_ld(&(bar)[XB_TMO])) break; if (_sp > XB_SPIN_CAP) { atomicAdd(&(bar)[XB_TMO], 1u); break; } } } } while (0)
__device__ __forceinline__ unsigned xcd_barrier_complete(unsigned* bar, unsigned x) {
    const unsigned G = gridDim.x;
    unsigned sum, cnt, mine, sp = 0u;
    for (;;) {
        sum = 0u; cnt = 0u; mine = 0u;
        for (unsigned j = 0; j < 16; ++j) { const unsigned c = xb_ld(&bar[XB_XCNT(j)]); sum += c; cnt += (c > 0u) ? 1u : 0u; mine = (j == x) ? c : mine; }
        if (sum == G) break;
        __builtin_amdgcn_s_sleep(1);
        if ((++sp & 255u) == 0u) { if (xb_ld(&bar[XB_TMO])) break; if (sp > XB_SPIN_CAP) { atomicAdd(&bar[XB_TMO], 1u); break; } }
    }
    const unsigned nloc = mine > 0u ? mine : 1u, nx = cnt > 0u ? cnt : 1u;
    return nloc | (nx << 16);
}
__device__ __forceinline__ void xcd_barrier(unsigned* bar, volatile LAS unsigned* st) {
    asm volatile("s_waitcnt vmcnt(0)" ::: "memory");
    __syncthreads();
    if (threadIdx.x == 0) {
        __builtin_amdgcn_s_waitcnt(0);
        const unsigned x = xb_xcc_id();
        unsigned nloc = st[0], nx = st[1];
        if (nloc == 0u) { const unsigned pk = xcd_barrier_complete(bar, x); nloc = pk & 0xFFFFu; nx = pk >> 16; st[0] = nloc; st[1] = nx; }
        const unsigned old = xb_add(&bar[XB_XSUB(x)], 1u);
        const unsigned gen = old / nloc;
        if (old + 1u == (gen + 1u) * nloc) {
            __builtin_amdgcn_fence(__ATOMIC_RELEASE, "agent");
            asm volatile("s_waitcnt vmcnt(0)" ::: "memory");
            const unsigned og = xb_add(&bar[XB_TOP], 1u);
            const unsigned tg = og / nx;
            if (og + 1u == (tg + 1u) * nx) xb_add(&bar[XB_TOPGEN], 1u);
            else XB_SPIN(xb_ld(&bar[XB_TOPGEN]) == tg, bar);
            __builtin_amdgcn_fence(__ATOMIC_ACQUIRE, "agent");
            xb_add(&bar[XB_XGEN(x)], 1u);
            asm volatile("s_waitcnt vmcnt(0)" ::: "memory");
        } else {
            XB_SPIN(xb_ld(&bar[XB_XGEN(x)]) == gen, bar);
            __builtin_amdgcn_fence(__ATOMIC_ACQUIRE, "agent");
            asm volatile("s_waitcnt vmcnt(0)" ::: "memory");
        }
    }
    __syncthreads();
}

__global__ void __launch_bounds__(NT) fwd_megakernel(Params p) {
    extern __shared__ __attribute__((aligned(16))) unsigned char shm[];
    cg::grid_group grid = cg::this_grid();
    LAS unsigned char* lds = (LAS unsigned char*)shm;
    LAS float* L = (LAS float*)shm;
    unsigned char* ws = p.ws;
    const int G = gridDim.x;
    float* mods = (float*)(ws + O_MODS);
    float* hctx = (float*)(ws + O_HCTX);
    bf16_t* XN = (bf16_t*)(ws + O_XN);
    bf16_t* ACT = (bf16_t*)(ws + O_ACT);
    const float* mods1 = mods + 5 * 6144;
    unsigned* bar = (unsigned*)(ws + O_BAR);
    volatile LAS unsigned* bst = (volatile LAS unsigned*)(lds + pg8::STAGE_BYTES);
    if (threadIdx.x < 4) bst[threadIdx.x] = 0u;
    __syncthreads();
    if (threadIdx.x == 0) (void)xb_add(&bar[XB_XCNT(xb_xcc_id())], 1u);
#define GRID_BAR() xcd_barrier(bar, bst)

    {
    phase_p0(p, L, bar + 0, bst + 2);
    }
    grid.sync();
    {
    phase_norm<0>(p.x, p.ctx, NTOK, p.norm_g + 0, mods, 0, 1, XN, nullptr);
    }
    GRID_BAR();
    {
    const int bx = obid();
    {
        const bf16_t* WinA = (const bf16_t*)(ws + O_WINA);
        bf16_t *ZT = (bf16_t*)(ws + O_ZT), *ZTc = (bf16_t*)(ws + O_ZTC), *VT = (bf16_t*)(ws + O_VT), *VTc = (bf16_t*)(ws + O_VTC);
        { pg8::Gemm g1{WinA, XN, 1024, 1024, 16384}; pg8::Sched s1; s1.init(4, 64, G, bx, 3, 1024, 16384);
          EpiInA e1{ZT, ZTc, 0, 1}; pg8::gemm_phase(lds, g1, s1, e1); }
        { pg8::Gemm gb{XN, (const bf16_t*)(ws + O_WINB), 1024, 1024, 1024}; pg8::Sched sb; sb.init(68, 3, G, bx, 0, 1024, 1024);
          EpiInB eb{(bf16_t*)(ws + O_Q), (bf16_t*)(ws + O_K), (const float*)(ws + O_ROPE), (const float*)(ws + O_ROPE) + 1024, VT, VTc}; pg8::gemm_phase(lds, gb, sb, eb); }
        { pg8::Gemm g3{WinA, XN + (size_t)NLAT * 1024, 1024, 1024, 1024}; pg8::Sched s3; s3.init(4, 4, G, (bx + G - (204 % G)) % G, 0, 1024, 1024);
          EpiInA e3{ZT, ZTc, NLAT, 0}; pg8::gemm_phase(lds, g3, s3, e3); }
    }
    }
    GRID_BAR();
    {
    const int bx = obid();
    {
        { pg8::Gemm gd{(const bf16_t*)(ws + O_D256), (const bf16_t*)(ws + O_ZT), 512, 512, 512}; pg8::Sched sd; sd.init(2, 128, G, bx, 0, 512, 512);
          EpiI2 ed{(bf16_t*)(ws + O_I2)}; pg8::gemm_phase(lds, gd, sd, ed); }
        const int wv = bx * 8 + (otid() >> 6), nw = G * 8;
        for (int item = wv; item < 4352; item += nw) attn_item(p, item);
        __syncthreads();
        { pg8::Gemm gc{(const bf16_t*)(ws + O_DC), (const bf16_t*)(ws + O_ZTC), 512, 512, 512}; pg8::Sched sc; sc.init(1, 8, G, (bx + 8) % G, 0, 512, 512);
          EpiDft ec{(bf16_t*)(ws + O_MIX), 1}; pg8::gemm_phase(lds, gc, sc, ec); }
    }
    }
    GRID_BAR();
    phase_dft_combine(p, L);
    GRID_BAR();
    {
    const int bx = obid();
    {
        const bf16_t* MIX = (const bf16_t*)(ws + O_MIX);
        pg8::Gemm g{MIX, (const bf16_t*)(ws + O_WOUT), 1024, 1024, 1024}; pg8::Sched s; s.init(64, 4, G, bx, 0, 1024, 1024);
        if (G == 256) {
            EpiResNorm e{p.x, p.out, mods + 2 * 1024, p.norm_g + 1024, mods, XN, (float*)(ws + O_XSS), (unsigned*)(ws + O_PCNT) + 32, bar + XB_TMO};
            pg8::gemm_phase<EpiResNorm, true>(lds, g, s, e);
            __syncthreads();
        } else {
            EpiRes e{p.x, p.ctx, p.out, hctx, mods + 2 * 1024};
            pg8::gemm_phase(lds, g, s, e);
        }
        pg8::Gemm gc{MIX + (size_t)NLAT * 1024, (const bf16_t*)(ws + O_WOUT), 256, 1024, 1024}; pg8::Sched sc; sc.init(16, 4, G, bx, 2, 1024, 1024);
        EpiPart ec{(bf16_t*)(ws + O_XNP)};
        pg8::gemm_phase<EpiPart, false>(lds, gc, sc, ec);
    }
    }
    GRID_BAR();
    {
    phase_norm<0>(p.out, p.ctx, NTOK, p.norm_g + 1024, mods, 3, 4, XN, nullptr, (const bf16_t*)(ws + O_XNP), 4, mods + 4 * 6144 + 2 * 1024, hctx, G == 256 ? NLAT : 0);
    }
    GRID_BAR();
    {
    const int bx = obid();
    {
        pg8::Gemm g{XN, (const bf16_t*)(ws + O_WGU0), 1024, 1024, 1024}; pg8::Sched s; s.init(68, 22, G, bx, 0, 1024, 1024);
        EpiSwiglu e{ACT};
        pg8::gemm_phase(lds, g, s, e);
    }
    }
    GRID_BAR();
    {
    const int bx = obid();
    {
        pg8::Gemm g{ACT, (const bf16_t*)(ws + O_WD0), FF, FF, FF}; pg8::Sched s; s.init(64, 4, G, bx, 0, FF, FF);
        EpiRes e{p.out, hctx, p.out, hctx, mods + 5 * 1024};
        pg8::gemm_phase(lds, g, s, e);
        pg8::Gemm gc{ACT + (size_t)NLAT * FF, (const bf16_t*)(ws + O_WD0), 256, FF, FF}; pg8::Sched sc; sc.init(16, 11, G, bx, 2, FF, FF);
        EpiPart ec{(bf16_t*)(ws + O_PART)};
        pg8::gemm_phase<EpiPart, false>(lds, gc, sc, ec);
    }
    }
    GRID_BAR();
    {
    phase_norm<1>(p.out, hctx, NTOK, p.norm_g + 2048, mods1, 0, 1, (bf16_t*)(ws + O_A2), nullptr, (const bf16_t*)(ws + O_PART), 11, mods + 4 * 6144 + 5 * 1024, nullptr);
    }
    GRID_BAR();
    {
    const int bx = obid();
    {
        pg8::Gemm g{(const bf16_t*)(ws + O_A2), (const bf16_t*)(ws + O_WST), 256, 512, 256}; pg8::Sched s; s.init(5, 64, G, bx, 1, 512, 256);
        EpiState e{(bf16_t*)(ws + O_S)};
        pg8::gemm_phase<EpiState, false>(lds, g, s, e);
    }
    }
    GRID_BAR();
    {
    phase_scan(p);
    }
    GRID_BAR();
    {
    const int bx = obid();
    {
        pg8::Gemm g{(const bf16_t*)(ws + O_A2), (const bf16_t*)(ws + O_TT), 512, 512, 512}; pg8::Sched s; s.init(4, 64, G, bx, 1, 512, 512);
        EpiSout e{(bf16_t*)(ws + O_GY)};
        pg8::gemm_phase(lds, g, s, e);
    }
    }
    GRID_BAR();
    {
    const int bx = obid();
    {
        pg8::Gemm g{(const bf16_t*)(ws + O_GY), (const bf16_t*)(ws + O_GLU), 1024, 1024, 1024};
        if (G == 256) {
            EpiGluNorm e{p.out, mods1 + 2 * 1024, p.norm_g + 3072, mods1, XN, (float*)(ws + O_S), (unsigned*)(ws + O_PCNT) + 16, bar + XB_TMO};
            pg8::Sched s; s.init(64, 8, G, bx, 4, 1024, 1024); s.nwg = 256;
            pg8::gemm_phase<EpiGluNorm, true>(lds, g, s, e);
            __syncthreads();
            pg8::Sched s2; s2.init(64, 8, G, bx, 4, 1024, 1024); s2.base = 256;
            pg8::gemm_phase<EpiGluNorm, true>(lds, g, s2, e);
        } else {
            pg8::Sched s; s.init(64, 8, G, bx, 0, 1024, 1024);
            EpiGlu e{p.out, mods1 + 2 * 1024};
            pg8::gemm_phase(lds, g, s, e);
        }
    }
    }
    GRID_BAR();
    if (G != 256) {
    phase_norm<0>(p.out, hctx, NLAT, p.norm_g + 3072, mods1, 3, 4, XN, nullptr);
    GRID_BAR();
    }
    {
    const int bx = obid();
    {
        pg8::Gemm g{XN, (const bf16_t*)(ws + O_WGU1), 1024, 1024, 1024}; pg8::Sched s; s.init(64, 22, G, bx, 0, 1024, 1024);
        EpiSwiglu e{ACT};
        pg8::gemm_phase(lds, g, s, e);
    }
    }
    GRID_BAR();
    {
    const int bx = obid();
    {
        pg8::Gemm g{ACT, (const bf16_t*)(ws + O_WD1), FF, FF, FF}; pg8::Sched s; s.init(64, 4, G, bx, 0, FF, FF);
        if (G == 256) {
            EpiResFinal e{p.out, p.out, mods1 + 5 * 1024, p.final_g, (float*)(ws + O_XSS), (unsigned*)(ws + O_PCNT), bar + XB_TMO};
            pg8::gemm_phase<EpiResFinal, true>(lds, g, s, e);
        } else {
            EpiRes e{p.out, hctx, p.out, hctx, mods1 + 5 * 1024};
            pg8::gemm_phase(lds, g, s, e);
        }
    }
    }
    if (G != 256) {
    GRID_BAR();
    phase_norm<2>(p.out, hctx, NLAT, p.final_g, nullptr, 0, 0, nullptr, p.out);
    }
}

extern "C" void kernel_launch(void* const* d_in, const int* in_sizes, int n_in, void* d_out, int out_size, void* d_ws, size_t ws_size, hipStream_t stream) {
    constexpr int kLds = pg8::STAGE_BYTES + 16;
    static int grid_blocks = 0;
    if (grid_blocks == 0) {
        if (n_in != 23 || ws_size < WS_NEED) { fprintf(stderr, "kernel_launch: unexpected n_in %d or workspace %zu < %zu\n", n_in, ws_size, (size_t)WS_NEED); grid_blocks = -1; return; }
        int dev = 0, cus = 0, per_cu = 0;
        hipGetDevice(&dev);
        hipDeviceGetAttribute(&cus, hipDeviceAttributeMultiprocessorCount, dev);
        hipFuncSetAttribute((const void*)fwd_megakernel, hipFuncAttributeMaxDynamicSharedMemorySize, kLds);
        hipOccupancyMaxActiveBlocksPerMultiprocessor(&per_cu, (const void*)fwd_megakernel, NT, kLds);
        if (per_cu < 1) { fprintf(stderr, "kernel_launch: occupancy query says %d blocks/CU\n", per_cu); per_cu = 1; }
        grid_blocks = cus;
        (void)hipGetLastError();
    }
    if (grid_blocks < 0) return;
    if (hipMemsetAsync((char*)d_ws + O_BAR, 0, 16384 + 64 * 256, stream) != hipSuccess) { fprintf(stderr, "kernel_launch: memset of barrier words failed\n"); return; }
    Params p{};
    p.x = (const float*)d_in[0]; p.c = (const float*)d_in[1]; p.ctx = (const float*)d_in[2]; p.c_ctx = (const float*)d_in[3];
    p.mod_w = (const float*)d_in[4]; p.mod_b = (const float*)d_in[5]; p.norm_g = (const float*)d_in[6];
    p.ffn_g = (const float*)d_in[7]; p.ffn_u = (const float*)d_in[8]; p.ffn_d = (const float*)d_in[9];
    p.w_in = (const float*)d_in[10]; p.w_out = (const float*)d_in[11]; p.sink = (const float*)d_in[12];
    p.a_re = (const float*)d_in[13]; p.a_im = (const float*)d_in[14]; p.log_dt = (const float*)d_in[15];
    p.b_re = (const float*)d_in[16]; p.b_im = (const float*)d_in[17]; p.c_re = (const float*)d_in[18]; p.c_im = (const float*)d_in[19];
    p.ssm_d = (const float*)d_in[20]; p.glu_w = (const float*)d_in[21]; p.final_g = (const float*)d_in[22];
    p.out = (float*)d_out; p.ws = (unsigned char*)d_ws;
    void* args[] = {&p};
    hipError_t e = hipLaunchCooperativeKernel((const void*)fwd_megakernel, dim3(grid_blocks), dim3(NT), args, kLds, stream);
    if (e != hipSuccess) fprintf(stderr, "cooperative launch failed: %s (grid %d)\n", hipGetErrorString(e), grid_blocks);
}
```

```cpp
#include <hip/hip_runtime.h>
#include <hip/hip_cooperative_groups.h>
#include <cstdio>
namespace cg = cooperative_groups;

#define LAS __attribute__((address_space(3)))
typedef unsigned short bf16_t;
typedef short bf16x8 __attribute__((ext_vector_type(8)));
typedef float f32x4 __attribute__((ext_vector_type(4)));
typedef float f32x16 __attribute__((ext_vector_type(16)));
typedef unsigned u32x4 __attribute__((ext_vector_type(4)));
typedef unsigned u32x2 __attribute__((ext_vector_type(2)));

constexpr int NT = 512;
constexpr int DM_ = 1024, SEQ_ = 4096, NB_ = 4, CTXL = 256, FF = 2816;
constexpr int NLAT = NB_ * SEQ_;
constexpr int NCTX = NB_ * CTXL;
constexpr int NTOK = NLAT + NCTX;
constexpr int GROWS = 1088;
constexpr int SROWS = 1280;

constexpr size_t MiB = 1u << 20;
constexpr size_t O_WINA = 0;
constexpr size_t O_WINB = O_WINA + 1280ull * 1024 * 2;
constexpr size_t O_WOUT = O_WINB + 768ull * 1024 * 2;
constexpr size_t O_WGU0 = O_WOUT + 1024ull * 1024 * 2;
constexpr size_t O_WD0 = O_WGU0 + 5632ull * 1024 * 2;
constexpr size_t O_WGU1 = O_WD0 + 1024ull * 2816 * 2;
constexpr size_t O_WD1 = O_WGU1 + 5632ull * 1024 * 2;
constexpr size_t O_GLU = O_WD1 + 1024ull * 2816 * 2;
constexpr size_t O_WST = O_GLU + 2048ull * 1024 * 2;
constexpr size_t O_TT = O_WST + 64ull * 256 * 256 * 2;
constexpr size_t O_MODS = O_TT + 64ull * 256 * 512 * 2;
constexpr size_t O_ROPE = O_MODS + 2ull * 5 * 6144 * 4;
constexpr size_t O_DC = O_ROPE + 2ull * 1024 * 4;
constexpr size_t O_HCTX = O_DC + 256ull * 512 * 2;
constexpr size_t O_VTC = O_HCTX + 1024ull * 1024 * 4;
constexpr size_t O_BAR = O_VTC + 4ull * 128 * 256 * 2;
constexpr size_t O_PCNT = O_BAR + 16384;
constexpr size_t O_D256 = O_PCNT + 64ull * 256;
constexpr size_t O_XSS = O_D256 + 512ull * 512 * 2;
constexpr size_t O_RA = 73 * MiB;
static_assert(O_XSS + 16384ull * 4 * 4 <= O_RA, "R_W overflow");
constexpr size_t O_XN = O_RA;
constexpr size_t O_MIX = O_RA + 34 * MiB;
constexpr size_t O_I2 = O_RA + 68 * MiB;
constexpr size_t O_XNP = O_I2;
constexpr size_t O_ZT = O_RA + 100 * MiB;
constexpr size_t O_ZTC = O_RA + 132 * MiB;
constexpr size_t O_Q = O_RA + 134 * MiB;
constexpr size_t O_K = O_RA + 151 * MiB;
constexpr size_t O_VT = O_K + 17408ull * 128 * 2;
constexpr size_t O_ACT = O_RA + 34 * MiB;
constexpr size_t O_A2 = O_RA;
constexpr size_t O_S = O_RA + 69 * MiB;
constexpr size_t O_GY = O_RA + 149 * MiB;
constexpr size_t O_H1B = O_RA + 128 * MiB;
constexpr size_t O_PART = O_RA + 161 * MiB;
constexpr size_t WS_NEED = O_RA + 183 * MiB;
static_assert(WS_NEED <= 256 * MiB, "workspace budget");

struct Params {
    const float* x; const float* c; const float* ctx; const float* c_ctx; const float* mod_w; const float* mod_b; const float* norm_g;
    const float* ffn_g; const float* ffn_u; const float* ffn_d; const float* w_in; const float* w_out; const float* sink;
    const float* a_re; const float* a_im; const float* log_dt; const float* b_re; const float* b_im; const float* c_re; const float* c_im;
    const float* ssm_d; const float* glu_w; const float* final_g;
    float* out; unsigned char* ws;
};

__device__ __forceinline__ int otid() { int t = threadIdx.x; asm volatile("" : "+v"(t)); return t; }
__device__ __forceinline__ int obid() { int t = blockIdx.x; asm volatile("" : "+s"(t)); return t; }
__device__ __forceinline__ unsigned cvt_pk_bf16(float lo, float hi) { unsigned r; asm volatile("v_cvt_pk_bf16_f32 %0, %1, %2" : "=v"(r) : "v"(lo), "v"(hi)); return r; }
__device__ __forceinline__ bf16_t f2bf(float f) { unsigned u = __float_as_uint(f); u += 0x7FFFu + ((u >> 16) & 1u); return (bf16_t)(u >> 16); }
__device__ __forceinline__ float sigmoidf_(float v) { return __builtin_amdgcn_rcpf(1.0f + __builtin_amdgcn_exp2f(-1.4426950408889634f * v)); }
__device__ __forceinline__ float siluf_(float v) { return v * sigmoidf_(v); }
__device__ __forceinline__ float gelu_tanh(float v) { const float u = 0.7978845608028654f * (v + 0.044715f * v * v * v); return v * sigmoidf_(2.0f * u); }
__device__ __forceinline__ u32x4 pack8(const f32x4 a, const f32x4 b) { u32x4 w; w.x = cvt_pk_bf16(a[0], a[1]); w.y = cvt_pk_bf16(a[2], a[3]); w.z = cvt_pk_bf16(b[0], b[1]); w.w = cvt_pk_bf16(b[2], b[3]); return w; }

namespace pg8 {
constexpr int BM = 256, BK = 64, HALF = 128, HTB = HALF * BK * 2, STAGE_BYTES = 8 * HTB, NXCD = 8, WGM = 8;
__device__ __forceinline__ int lds_byte(int r, int c) { const int st = (r >> 4) * 2 + (c >> 5), rr = r & 15, cc = c & 31, ob = rr * 64 + cc * 2; return st * 1024 + (ob ^ (((ob >> 9) & 1) << 5)); }
__device__ __forceinline__ void stage_rc(int b, int& R, int& C) { const int st = b / 1024, sb = b % 1024, swz = sb ^ (((sb >> 9) & 1) << 5); R = (st >> 1) * 16 + swz / 64; C = (st & 1) * 32 + (swz % 64) / 2; }
__device__ __forceinline__ int perm32(int rho) { const int n = rho >> 4, i = rho & 15; return 8 * (i >> 2) + 4 * n + (i & 3); }

struct Unit { int arow, brow, pm, pn, kofs; size_t aoff, boff; };
struct Gemm { const bf16_t* A; const bf16_t* Bt; int K, lda, ldb; };

struct Sched {
    int nM, nN, nwg, G, c, mode, lda, ldb, base;
    __device__ void init(int nM_, int nN_, int G_, int c_, int mode_, int lda_, int ldb_) { nM = nM_; nN = nN_; nwg = nM_ * nN_; G = G_; c = c_; mode = mode_; lda = lda_; ldb = ldb_; base = 0; }
    __device__ bool next(int i, Unit& u) const {
        const long L = (long)base + (long)i * G + c; if (L >= nwg) return false;
        if (mode == 4) {
            { const int x = (int)L & 7, o = ((int)L & 255) >> 3; u.pm = ((int)L >> 8) * 32 + x * 4 + (o >> 3); u.pn = o & 7; }
            u.arow = u.pm * BM; u.brow = u.pn * BM; u.kofs = 0;
            u.aoff = (size_t)u.arow * lda; u.boff = (size_t)u.brow * ldb; return true;
        }
        if (mode == 0 || mode == 3) {
            int wgid = (int)L; { const int q = nwg / NXCD, r = nwg % NXCD, xcd = wgid % NXCD, off = wgid / NXCD; wgid = (xcd < r ? xcd * (q + 1) : r * (q + 1) + (xcd - r) * q) + off; }
            const int nig = WGM * nN, gid = wgid / nig, fm = gid * WGM, gsz = (nM - fm) < WGM ? (nM - fm) : WGM;
            u.pm = fm + ((wgid % nig) % gsz); u.pn = (wgid % nig) / gsz; u.arow = u.pm * BM; u.brow = u.pn * BM; u.kofs = 0;
        } else if (mode == 1) {
            const int g = (int)L / nM, mi = (int)L % nM; u.pm = mi; u.pn = g; u.arow = g * GROWS + mi * BM; u.brow = g * BM; u.kofs = 0;
        } else {
            const int tile = (int)L % nM, ks = (int)L / nM; u.pm = tile >> 2; u.pn = tile & 3; u.arow = u.pm * BM; u.brow = u.pn * BM; u.kofs = ks * 256;
        }
        u.aoff = (size_t)u.arow * lda + u.kofs;
        u.boff = (mode == 3) ? (size_t)((u.pn >> 4) * 4096 + (u.pn & 15)) * 1024 : (size_t)u.brow * ldb + u.kofs;
        return true;
    }
};

template <class T, class = void> struct epi_after_drain { static constexpr bool value = false; };
template <class T> struct epi_after_drain<T, decltype((void)T::AFTER_DRAIN)> { static constexpr bool value = T::AFTER_DRAIN; };
#ifndef GP_ALIGN
#define GP_ALIGN true
#endif
#ifndef GP_SP2
#define GP_SP2 true
#endif
template <class Epi, bool ALIGN_EPI = GP_ALIGN, bool SP2 = GP_SP2>
__device__ __forceinline__ void gemm_phase(LAS unsigned char* lds, const Gemm g, const Sched& S, const Epi& E) {
    const int tid = otid(), wid = __builtin_amdgcn_readfirstlane(tid >> 6), lane = tid & 63, wr = wid >> 2, wc = wid & 3, fr = lane & 15, fq = lane >> 4;
    const int K = g.K, nt = K / BK;
    unsigned voffA[2], voffB[2];
#pragma unroll
    for (int i = 0; i < 2; ++i) { int R, C; stage_rc(tid * 16 + i * 8192, R, C); const int Rb = (R & ~31) + perm32(R & 31);
        voffA[i] = (unsigned)(R * g.lda + C) * 2u; voffB[i] = (unsigned)(Rb * g.ldb + C) * 2u; }
    const size_t kstep = (size_t)(BK * 2);
    const size_t hstepA = (size_t)HALF * g.lda * 2, hstepB = (size_t)HALF * g.ldb * 2;
    const unsigned ldsw = (unsigned)wid * 1024u;
    const int aoff = lds_byte(wr * 64 + fr, fq * 8), boff = lds_byte(wc * 32 + fr, fq * 8);
#define PG8_SA(b, h) (((b) * 2 + (h)) * HTB)
#define PG8_SB(b, h) ((4 + (b) * 2 + (h)) * HTB)
#define PG8_STAGE(bufoff, gbase, voff) do { _Pragma("unroll") for (int _i = 0; _i < 2; ++_i) \
        __builtin_amdgcn_global_load_lds((const unsigned*)((const char*)(gbase) + (voff)[_i]), (LAS unsigned*)(lds + (bufoff) + ldsw + _i * 8192), 16, 0, 0); } while (0)
#define PG8_LDA(dst, b, h) do { _Pragma("unroll") for (int m = 0; m < 4; ++m) _Pragma("unroll") for (int k = 0; k < 2; ++k) dst[m][k] = *(const LAS bf16x8*)(lds + PG8_SA(b, h) + aoff + m * 2048 + k * 1024); } while (0)
#define PG8_LDB(dst, b, h) do { _Pragma("unroll") for (int n = 0; n < 2; ++n) _Pragma("unroll") for (int k = 0; k < 2; ++k) dst[n][k] = *(const LAS bf16x8*)(lds + PG8_SB(b, h) + boff + n * 2048 + k * 1024); } while (0)
#define PG8_MMA(ai, bj, At, Bt) do { __builtin_amdgcn_s_setprio(1); _Pragma("unroll") for (int m = 0; m < 4; ++m) _Pragma("unroll") for (int n = 0; n < 2; ++n) _Pragma("unroll") for (int k = 0; k < 2; ++k) \
        acc[ai][bj][m][n] = __builtin_amdgcn_mfma_f32_16x16x32_bf16(Bt[n][k], At[m][k], acc[ai][bj][m][n], 0, 0, 0); __builtin_amdgcn_s_setprio(0); } while (0)
#define PG8_WAIT_V(n) asm volatile("s_waitcnt vmcnt(" #n ")" ::: "memory")
#define PG8_WAIT_L(n) asm volatile("s_waitcnt lgkmcnt(" #n ")" ::: "memory")
#define PG8_BAR __builtin_amdgcn_s_barrier()
#define PG8_SCHED __builtin_amdgcn_sched_barrier(0)
    Unit cur, nxt; int ui = 0;
    if (!S.next(0, cur)) return;
    f32x4 acc[2][2][4][2];
#pragma unroll
    for (int a = 0; a < 2; ++a)
#pragma unroll
        for (int b = 0; b < 2; ++b)
#pragma unroll
            for (int m = 0; m < 4; ++m)
#pragma unroll
                for (int n = 0; n < 2; ++n) acc[a][b][m][n] = (f32x4){0.f, 0.f, 0.f, 0.f};
    bf16x8 At[4][2], B0[2][2], B1[2][2];
    const char* cA = (const char*)g.A + cur.aoff * 2; const char* cB = (const char*)g.Bt + cur.boff * 2;
    if constexpr (SP2) {
        PG8_STAGE(PG8_SB(0, 0), cB, voffB); PG8_STAGE(PG8_SB(0, 1), cB + hstepB, voffB); PG8_STAGE(PG8_SA(0, 0), cA, voffA); PG8_STAGE(PG8_SA(0, 1), cA + hstepA, voffA);
        if (wr == 1) PG8_BAR;
        PG8_WAIT_V(2); PG8_BAR;
        PG8_STAGE(PG8_SB(1, 0), cB + kstep, voffB); PG8_STAGE(PG8_SA(1, 0), cA + kstep, voffA); PG8_STAGE(PG8_SB(1, 1), cB + hstepB + kstep, voffB);
        PG8_WAIT_V(6); PG8_BAR;
    } else {
        PG8_STAGE(PG8_SB(0, 0), cB, voffB); PG8_STAGE(PG8_SA(0, 0), cA, voffA); PG8_STAGE(PG8_SB(0, 1), cB + hstepB, voffB); PG8_STAGE(PG8_SA(0, 1), cA + hstepA, voffA);
        if (wr == 1) PG8_BAR;
        PG8_WAIT_V(4); PG8_BAR;
        PG8_STAGE(PG8_SB(1, 0), cB + kstep, voffB); PG8_STAGE(PG8_SA(1, 0), cA + kstep, voffA); PG8_STAGE(PG8_SB(1, 1), cB + hstepB + kstep, voffB);
        PG8_WAIT_V(6); PG8_BAR;
    }
    for (;;) {
        const bool has_next = S.next(ui + 1, nxt);
        const char* nA = has_next ? (const char*)g.A + nxt.aoff * 2 : cA; const char* nB = has_next ? (const char*)g.Bt + nxt.boff * 2 : cB;
        for (int t = 0; t < nt; t += 2) {
            const bool last = (t == nt - 2);
            const char* a1 = cA + (size_t)(t + 1) * kstep;
            const char* a2 = last ? nA : cA + (size_t)(t + 2) * kstep; const char* b2 = last ? nB : cB + (size_t)(t + 2) * kstep;
            const char* a3 = a2 + kstep; const char* b3 = b2 + kstep;
            if constexpr (SP2) {
            PG8_LDB(B0, 0, 0); PG8_LDB(B1, 0, 1); PG8_SCHED; PG8_LDA(At, 0, 0); PG8_STAGE(PG8_SA(1, 1), a1 + hstepA, voffA);
            PG8_WAIT_V(8); PG8_WAIT_L(0); PG8_BAR; PG8_MMA(0, 0, At, B0); PG8_MMA(0, 1, At, B1); PG8_BAR; PG8_SCHED;
            PG8_LDA(At, 0, 1); PG8_STAGE(PG8_SB(0, 0), b2, voffB); PG8_STAGE(PG8_SB(0, 1), b2 + hstepB, voffB); PG8_STAGE(PG8_SA(0, 0), a2, voffA);
            PG8_WAIT_V(8); PG8_WAIT_L(0); PG8_BAR; PG8_MMA(1, 0, At, B0); PG8_MMA(1, 1, At, B1); PG8_BAR; PG8_SCHED;
            PG8_LDB(B0, 1, 0); PG8_LDB(B1, 1, 1); PG8_SCHED; PG8_LDA(At, 1, 0); PG8_STAGE(PG8_SA(0, 1), a2 + hstepA, voffA);
            PG8_WAIT_V(8); PG8_WAIT_L(0); PG8_BAR; PG8_MMA(0, 0, At, B0); PG8_MMA(0, 1, At, B1); PG8_BAR; PG8_SCHED;
            PG8_LDA(At, 1, 1); PG8_STAGE(PG8_SB(1, 0), b3, voffB); PG8_STAGE(PG8_SB(1, 1), b3 + hstepB, voffB); PG8_STAGE(PG8_SA(1, 0), a3, voffA);
            PG8_WAIT_V(8); PG8_WAIT_L(0); PG8_BAR; PG8_MMA(1, 0, At, B0); PG8_MMA(1, 1, At, B1); PG8_BAR; PG8_SCHED;
            } else {
            PG8_LDB(B0, 0, 0); PG8_SCHED; PG8_LDA(At, 0, 0); PG8_STAGE(PG8_SA(1, 1), a1 + hstepA, voffA);
            PG8_WAIT_L(8); PG8_BAR; PG8_WAIT_L(0); PG8_MMA(0, 0, At, B0); PG8_BAR; PG8_SCHED;
            PG8_LDB(B1, 0, 1); PG8_STAGE(PG8_SB(0, 0), b2, voffB);
            PG8_BAR; PG8_WAIT_L(0); PG8_MMA(0, 1, At, B1); PG8_BAR;
            PG8_LDA(At, 0, 1); PG8_STAGE(PG8_SA(0, 0), a2, voffA);
            PG8_BAR; PG8_WAIT_L(0); PG8_MMA(1, 0, At, B0); PG8_BAR; PG8_SCHED;
            PG8_STAGE(PG8_SB(0, 1), b2 + hstepB, voffB);
            PG8_WAIT_V(6); PG8_BAR; PG8_MMA(1, 1, At, B1); PG8_BAR;
            PG8_LDB(B0, 1, 0); PG8_SCHED; PG8_LDA(At, 1, 0); PG8_STAGE(PG8_SA(0, 1), a2 + hstepA, voffA);
            PG8_WAIT_L(8); PG8_BAR; PG8_WAIT_L(0); PG8_MMA(0, 0, At, B0); PG8_BAR; PG8_SCHED;
            PG8_LDB(B1, 1, 1); PG8_STAGE(PG8_SB(1, 0), b3, voffB);
            PG8_BAR; PG8_WAIT_L(0); PG8_MMA(0, 1, At, B1); PG8_BAR;
            PG8_LDA(At, 1, 1); PG8_STAGE(PG8_SA(1, 0), a3, voffA);
            PG8_BAR; PG8_WAIT_L(0); PG8_MMA(1, 0, At, B0); PG8_BAR; PG8_SCHED;
            PG8_STAGE(PG8_SB(1, 1), b3 + hstepB, voffB);
            PG8_WAIT_V(6); PG8_BAR; PG8_MMA(1, 1, At, B1); PG8_BAR;
                    }
        }
        if constexpr (ALIGN_EPI) { if (wr == 0) PG8_BAR; }
        if constexpr (!epi_after_drain<Epi>::value) E(acc, cur, wr, wc, fr, fq);
        if (!has_next) break;
#pragma unroll
        for (int a = 0; a < 2; ++a)
#pragma unroll
            for (int b = 0; b < 2; ++b)
#pragma unroll
                for (int m = 0; m < 4; ++m)
#pragma unroll
                    for (int n = 0; n < 2; ++n) acc[a][b][m][n] = (f32x4){0.f, 0.f, 0.f, 0.f};
        cur = nxt; cA = nA; cB = nB; ++ui;
        if constexpr (ALIGN_EPI) { if (wr == 1) PG8_BAR; }
    }
    PG8_WAIT_V(0);
    if constexpr (!ALIGN_EPI) { if (wr == 0) PG8_BAR; }
    PG8_BAR;
    if constexpr (epi_after_drain<Epi>::value) E.fused(acc, cur, wr, wc, fr, fq, lds, wid, lane);
#undef PG8_SA
#undef PG8_SB
#undef PG8_STAGE
#undef PG8_LDA
#undef PG8_LDB
#undef PG8_MMA
#undef PG8_WAIT_V
#undef PG8_WAIT_L
#undef PG8_BAR
#undef PG8_SCHED
}
}
using pg8::Unit;
typedef f32x4 Acc[2][2][4][2];

struct EpiInA {
    bf16_t *ZT, *ZTc; int tk0, perm;
    __device__ __forceinline__ void operator()(const Acc& acc, const Unit& u, int wr, int wc, int fr, int fq) const {
#pragma unroll
        for (int ai = 0; ai < 2; ++ai)
#pragma unroll
            for (int m = 0; m < 4; ++m) {
                const int r = u.arow + ai * 128 + wr * 64 + m * 16 + fr;
                const int c = r & 511, cs = r >> 9;
#pragma unroll
                for (int bj = 0; bj < 2; ++bj) {
                    const int tk = tk0 + u.brow + bj * 128 + wc * 32 + fq * 8;
                    bf16_t* dst;
                    if (perm) { const int b = tk >> 12, rr = (tk >> 8) & 15, tp = tk & 255; dst = ZT + ((size_t)((b * 512 + c) * 16 + rr) * 512 + cs * 256 + tp); }
                    else { const int b = (tk - NLAT) >> 8, t = tk & 255; dst = ZTc + ((size_t)(b * 512 + c) * 512 + cs * 256 + t); }
                    *(u32x4*)dst = pack8(acc[ai][bj][m][0], acc[ai][bj][m][1]);
                }
            }
    }
};
struct EpiInB {
    bf16_t *Q, *Kb; const float *ropeC, *ropeS; bf16_t *VT, *VTc;
    __device__ __forceinline__ void operator()(const Acc& acc, const Unit& u, int wr, int wc, int fr, int fq) const {
#pragma unroll
        for (int ai = 0; ai < 2; ++ai)
#pragma unroll
            for (int m = 0; m < 4; ++m) {
                const int tok = u.arow + ai * 128 + wr * 64 + m * 16 + fr;
                const bool lat = tok < NLAT; const int pos = tok & 4095, prow = pos >> 6, pcol = pos & 63;
#pragma unroll
                for (int bj = 0; bj < 2; ++bj) {
                    const int col = u.brow + bj * 128 + wc * 32 + fq * 8;
                    f32x4 v0 = acc[ai][bj][m][0], v1 = acc[ai][bj][m][1];
                    if (col >= 640) {
                        const int dv = col - 640, kvh = dv >> 6, d = dv & 63, dt = d >> 5, rl0 = d & 31;
                        int b, t; if (lat) { b = tok >> 12; t = tok & 4095; } else { b = (tok - NLAT) >> 8; t = tok & 255; }
                        const int tile = t >> 5, s = (t >> 4) & 1, k16 = t & 15, hh = (k16 >> 2) & 1, j = ((k16 >> 3) << 2) | (k16 & 3);
                        bf16_t* vb = (lat ? VT + (size_t)((b * 2 + kvh) * 128 + tile) * 2048 : VTc + (size_t)((b * 2 + kvh) * 8 + tile) * 2048) + (dt * 2 + s) * 512 + (hh * 32 + rl0) * 8 + j;
                        const u32x4 w = pack8(v0, v1);
                        vb[0] = (bf16_t)(w.x & 0xFFFFu); vb[8] = (bf16_t)(w.x >> 16); vb[16] = (bf16_t)(w.y & 0xFFFFu); vb[24] = (bf16_t)(w.y >> 16);
                        vb[32] = (bf16_t)(w.z & 0xFFFFu); vb[40] = (bf16_t)(w.z >> 16); vb[48] = (bf16_t)(w.w & 0xFFFFu); vb[56] = (bf16_t)(w.w >> 16);
                        continue;
                    }
                    if (lat) {
                        const int i0 = (col & 63) >> 1, pp = (i0 < 16) ? prow : pcol, f0 = i0 & 15;
                        const f32x4 cs = *(const f32x4*)(ropeC + pp * 16 + f0), sn = *(const f32x4*)(ropeS + pp * 16 + f0);
                        f32x4 w0, w1;
                        w0[0] = v0[0] * cs[0] - v0[1] * sn[0]; w0[1] = v0[0] * sn[0] + v0[1] * cs[0];
                        w0[2] = v0[2] * cs[1] - v0[3] * sn[1]; w0[3] = v0[2] * sn[1] + v0[3] * cs[1];
                        w1[0] = v1[0] * cs[2] - v1[1] * sn[2]; w1[1] = v1[0] * sn[2] + v1[1] * cs[2];
                        w1[2] = v1[2] * cs[3] - v1[3] * sn[3]; w1[3] = v1[2] * sn[3] + v1[3] * cs[3];
                        v0 = w0; v1 = w1;
                    }
                    bf16_t* dst = (col < 512) ? Q + (size_t)tok * 512 + col : Kb + (size_t)tok * 128 + (col - 512);
                    *(u32x4*)dst = pack8(v0, v1);
                }
            }
    }
};
struct EpiDft {
    bf16_t* MIX; int isctx;
    __device__ __forceinline__ void operator()(const Acc& acc, const Unit& u, int wr, int wc, int fr, int fq) const {
#pragma unroll
        for (int ai = 0; ai < 2; ++ai)
#pragma unroll
            for (int m = 0; m < 4; ++m) {
                const int k = u.arow + ai * 128 + wr * 64 + m * 16 + fr;
#pragma unroll
                for (int bj = 0; bj < 2; ++bj) {
                    const int col = u.brow + bj * 128 + wc * 32 + fq * 8; const int b = col >> 9, c = col & 511;
                    const size_t trow = isctx ? (size_t)(NLAT + b * 256 + k) : (size_t)(b * 4096 + k);
                    *(u32x4*)(MIX + trow * 1024 + c) = pack8(acc[ai][bj][m][0], acc[ai][bj][m][1]);
                }
            }
    }
};
struct EpiI2 {
    bf16_t* I2;
    __device__ __forceinline__ void operator()(const Acc& acc, const Unit& u, int wr, int wc, int fr, int fq) const {
#pragma unroll
        for (int ai = 0; ai < 2; ++ai)
#pragma unroll
            for (int m = 0; m < 4; ++m) {
                const int row = u.arow + ai * 128 + wr * 64 + m * 16 + fr;
#pragma unroll
                for (int bj = 0; bj < 2; ++bj) {
                    const int col = u.brow + bj * 128 + wc * 32 + fq * 8;
                    *(u32x4*)(I2 + (size_t)row * 32768 + col) = pack8(acc[ai][bj][m][0], acc[ai][bj][m][1]);
                }
            }
    }
};
struct EpiRes {
    const float *in_lat, *in_ctx; float *out_lat, *out_ctx; const float* gate;
    __device__ __forceinline__ void operator()(const Acc& acc, const Unit& u, int wr, int wc, int fr, int fq) const {
        const int row0 = u.arow + wr * 64 + fr, col0 = u.brow + wc * 32 + fq * 8;
        const bool lat = row0 < NLAT;
        const int b = lat ? (row0 >> 12) : 4;
        const float* ip = lat ? in_lat + (size_t)row0 * 1024 + col0 : in_ctx + (size_t)(row0 - NLAT) * 1024 + col0;
        float* op = lat ? out_lat + (size_t)row0 * 1024 + col0 : out_ctx + (size_t)(row0 - NLAT) * 1024 + col0;
        const float* gp = gate + b * 6144 + col0;
        f32x4 gv[2][2];
#pragma unroll
        for (int bj = 0; bj < 2; ++bj)
#pragma unroll
            for (int n = 0; n < 2; ++n) gv[bj][n] = *(const f32x4*)(gp + bj * 128 + 4 * n);
#pragma unroll
        for (int ai = 0; ai < 2; ++ai)
#pragma unroll
            for (int mh = 0; mh < 2; ++mh) {
                f32x4 hv[2][2][2];
#pragma unroll
                for (int mm = 0; mm < 2; ++mm)
#pragma unroll
                    for (int bj = 0; bj < 2; ++bj)
#pragma unroll
                        for (int n = 0; n < 2; ++n) hv[mm][bj][n] = *(const f32x4*)(ip + (size_t)(ai * 128 + (mh * 2 + mm) * 16) * 1024 + bj * 128 + 4 * n);
#pragma unroll
                for (int mm = 0; mm < 2; ++mm)
#pragma unroll
                    for (int bj = 0; bj < 2; ++bj)
#pragma unroll
                        for (int n = 0; n < 2; ++n) *(f32x4*)(op + (size_t)(ai * 128 + (mh * 2 + mm) * 16) * 1024 + bj * 128 + 4 * n) = hv[mm][bj][n] + gv[bj][n] * acc[ai][bj][mh * 2 + mm][n];
            }
    }
};
struct EpiResFinal {
    static constexpr bool AFTER_DRAIN = true;
    const float* H; float* out; const float* gate; const float* fg; float* xss; unsigned* pcnt; unsigned* tmo;
    __device__ __forceinline__ void fused(Acc& acc, const Unit& u, int wr, int wc, int fr, int fq, LAS unsigned char* lds, int wid, int lane) const {
        LAS float* P = (LAS float*)lds;
        LAS float* S = (LAS float*)(lds + 8192);
        const int row0 = u.arow + wr * 64 + fr, col0 = u.brow + wc * 32 + fq * 8;
        const float* ip = H + (size_t)row0 * 1024 + col0; float* op = out + (size_t)row0 * 1024 + col0;
        const float* gp = gate + (row0 >> 12) * 6144 + col0;
        f32x4 gv[2][2];
#pragma unroll
        for (int bj = 0; bj < 2; ++bj)
#pragma unroll
            for (int n = 0; n < 2; ++n) gv[bj][n] = *(const f32x4*)(gp + bj * 128 + 4 * n);
#pragma unroll
        for (int ai = 0; ai < 2; ++ai)
#pragma unroll
            for (int m = 0; m < 4; ++m) {
                float s = 0.f;
#pragma unroll
                for (int bj = 0; bj < 2; ++bj)
#pragma unroll
                    for (int n = 0; n < 2; ++n) {
                        const f32x4 hv = *(const f32x4*)(ip + (size_t)(ai * 128 + m * 16) * 1024 + bj * 128 + 4 * n);
                        const f32x4 h = hv + gv[bj][n] * acc[ai][bj][m][n]; acc[ai][bj][m][n] = h;
                        s += (h[0] * h[0] + h[1] * h[1]) + (h[2] * h[2] + h[3] * h[3]);
                    }
                s += __shfl_xor(s, 16); s += __shfl_xor(s, 32);
                if (fq == 0) P[(ai * 128 + wr * 64 + m * 16 + fr) * 4 + wc] = s;
            }
        asm volatile("s_waitcnt lgkmcnt(0)" ::: "memory"); __builtin_amdgcn_s_barrier(); asm volatile("" ::: "memory");
        const int row = wid * 32 + (lane & 31);
        if (lane < 32) {
            const float t = (P[row * 4 + 0] + P[row * 4 + 1]) + (P[row * 4 + 2] + P[row * 4 + 3]);
            __hip_atomic_store((unsigned*)xss + ((size_t)(u.arow + row) * 4 + u.pn), __float_as_uint(t), __ATOMIC_RELAXED, __HIP_MEMORY_SCOPE_AGENT);
        }
        asm volatile("s_waitcnt vmcnt(0)" ::: "memory");
        if (lane == 0) __hip_atomic_fetch_add(pcnt + 64 * u.pm, 1u, __ATOMIC_RELAXED, __HIP_MEMORY_SCOPE_AGENT);
        if (wid == 0) {
            unsigned sp = 0;
            while ((unsigned)__builtin_amdgcn_readfirstlane(__hip_atomic_load(pcnt + 64 * u.pm, __ATOMIC_RELAXED, __HIP_MEMORY_SCOPE_AGENT)) < 32u) {
                __builtin_amdgcn_s_sleep(2);
                if ((++sp & 1023u) == 0u) { if (__hip_atomic_load(tmo, __ATOMIC_RELAXED, __HIP_MEMORY_SCOPE_AGENT) != 0u) break; if (sp > (1u << 22)) { if (lane == 0) atomicAdd(tmo, 1u); break; } }
            }
            __builtin_amdgcn_fence(__ATOMIC_ACQUIRE, "agent");
        }
        asm volatile("s_waitcnt vmcnt(0) lgkmcnt(0)" ::: "memory"); __builtin_amdgcn_s_barrier(); asm volatile("" ::: "memory");
        if (lane < 32) {
            const unsigned* slot = (const unsigned*)xss + (size_t)(u.arow + row) * 4; float t = 0.f;
#pragma unroll
            for (int q = 0; q < 4; ++q) t += __uint_as_float(__hip_atomic_load(slot + q, __ATOMIC_RELAXED, __HIP_MEMORY_SCOPE_AGENT));
            S[row] = rsqrtf(t * (1.0f / 1024.0f) + 1e-6f);
        }
        asm volatile("s_waitcnt lgkmcnt(0)" ::: "memory"); __builtin_amdgcn_s_barrier(); asm volatile("" ::: "memory");
        f32x4 fv[2][2];
#pragma unroll
        for (int bj = 0; bj < 2; ++bj)
#pragma unroll
            for (int n = 0; n < 2; ++n) fv[bj][n] = *(const f32x4*)(fg + col0 + bj * 128 + 4 * n);
#pragma unroll
        for (int ai = 0; ai < 2; ++ai)
#pragma unroll
            for (int m = 0; m < 4; ++m) {
                const float rinv = S[ai * 128 + wr * 64 + m * 16 + fr];
#pragma unroll
                for (int bj = 0; bj < 2; ++bj)
#pragma unroll
                    for (int n = 0; n < 2; ++n) *(f32x4*)(op + (size_t)(ai * 128 + m * 16) * 1024 + bj * 128 + 4 * n) = acc[ai][bj][m][n] * rinv * fv[bj][n];
            }
    }
};
struct EpiResNorm {
    static constexpr bool AFTER_DRAIN = true;
    const float* X; bf16_t* Hb; const float* gate; const float* ng; const float* mods_l; bf16_t* XNo; float* xss; unsigned* pcnt; unsigned* tmo;
    __device__ __forceinline__ void fused(Acc& acc, const Unit& u, int wr, int wc, int fr, int fq, LAS unsigned char* lds, int wid, int lane) const {
        LAS float* P = (LAS float*)lds; LAS float* S = (LAS float*)(lds + 8192);
        const int row0 = u.arow + wr * 64 + fr, col0 = u.brow + wc * 32 + fq * 8, b = row0 >> 12;
        const float* ip = X + (size_t)row0 * 1024 + col0; bf16_t* op = Hb + (size_t)row0 * 1024 + col0;
        {
            const float* gp = gate + b * 6144 + col0; f32x4 gv[2][2];
#pragma unroll
            for (int bj = 0; bj < 2; ++bj)
#pragma unroll
                for (int n = 0; n < 2; ++n) gv[bj][n] = *(const f32x4*)(gp + bj * 128 + 4 * n);
#pragma unroll
            for (int ai = 0; ai < 2; ++ai)
#pragma unroll
                for (int m = 0; m < 4; ++m) {
                    float s = 0.f;
#pragma unroll
                    for (int bj = 0; bj < 2; ++bj)
#pragma unroll
                        for (int n = 0; n < 2; ++n) {
                            const f32x4 hv = *(const f32x4*)(ip + (size_t)(ai * 128 + m * 16) * 1024 + bj * 128 + 4 * n);
                            const f32x4 h = hv + gv[bj][n] * acc[ai][bj][m][n]; acc[ai][bj][m][n] = h;
                            s += (h[0] * h[0] + h[1] * h[1]) + (h[2] * h[2] + h[3] * h[3]);
                        }
#pragma unroll
                    for (int bj = 0; bj < 2; ++bj) *(u32x4*)(op + (size_t)(ai * 128 + m * 16) * 1024 + bj * 128) = pack8(acc[ai][bj][m][0], acc[ai][bj][m][1]);
                    s += __shfl_xor(s, 16); s += __shfl_xor(s, 32);
                    if (fq == 0) P[(ai * 128 + wr * 64 + m * 16 + fr) * 4 + wc] = s;
                }
        }
        asm volatile("s_waitcnt lgkmcnt(0)" ::: "memory"); __builtin_amdgcn_s_barrier(); asm volatile("" ::: "memory");
        const int row = wid * 32 + (lane & 31);
        if (lane < 32) {
            const float t = (P[row * 4 + 0] + P[row * 4 + 1]) + (P[row * 4 + 2] + P[row * 4 + 3]);
            __hip_atomic_store((unsigned*)xss + ((size_t)(u.arow + row) * 4 + u.pn), __float_as_uint(t), __ATOMIC_RELAXED, __HIP_MEMORY_SCOPE_AGENT);
        }
        asm volatile("s_waitcnt vmcnt(0)" ::: "memory");
        if (lane == 0) __hip_atomic_fetch_add(pcnt + 64 * u.pm, 1u, __ATOMIC_RELAXED, __HIP_MEMORY_SCOPE_AGENT);
        if (wid == 0) {
            unsigned sp = 0;
            while ((unsigned)__builtin_amdgcn_readfirstlane(__hip_atomic_load(pcnt + 64 * u.pm, __ATOMIC_RELAXED, __HIP_MEMORY_SCOPE_AGENT)) < 32u) {
                __builtin_amdgcn_s_sleep(2);
                if ((++sp & 1023u) == 0u) { if (__hip_atomic_load(tmo, __ATOMIC_RELAXED, __HIP_MEMORY_SCOPE_AGENT) != 0u) break; if (sp > (1u << 22)) { if (lane == 0) atomicAdd(tmo, 1u); break; } }
            }
            __builtin_amdgcn_fence(__ATOMIC_ACQUIRE, "agent");
        }
        asm volatile("s_waitcnt vmcnt(0) lgkmcnt(0)" ::: "memory"); __builtin_amdgcn_s_barrier(); asm volatile("" ::: "memory");
        if (lane < 32) {
            const unsigned* slot = (const unsigned*)xss + (size_t)(u.arow + row) * 4; float t = 0.f;
#pragma unroll
            for (int q = 0; q < 4; ++q) t += __uint_as_float(__hip_atomic_load(slot + q, __ATOMIC_RELAXED, __HIP_MEMORY_SCOPE_AGENT));
            S[row] = rsqrtf(t * (1.0f / 1024.0f) + 1e-6f);
        }
        asm volatile("s_waitcnt lgkmcnt(0)" ::: "memory"); __builtin_amdgcn_s_barrier(); asm volatile("" ::: "memory");
        bf16_t* xp = XNo + (size_t)row0 * 1024 + col0;
#pragma unroll
        for (int bj = 0; bj < 2; ++bj) {
            f32x4 mv[2], sv[2];
#pragma unroll
            for (int n = 0; n < 2; ++n) { const int c = col0 + bj * 128 + 4 * n; const f32x4 g4 = *(const f32x4*)(ng + c), s4 = *(const f32x4*)(mods_l + (size_t)b * 6144 + 4 * 1024 + c); sv[n] = *(const f32x4*)(mods_l + (size_t)b * 6144 + 3 * 1024 + c);
#pragma unroll
                for (int j = 0; j < 4; ++j) mv[n][j] = g4[j] * (1.0f + s4[j]); }
#pragma unroll
            for (int ai = 0; ai < 2; ++ai)
#pragma unroll
                for (int m = 0; m < 4; ++m) {
                    const float rinv = S[ai * 128 + wr * 64 + m * 16 + fr];
                    const f32x4 y0 = acc[ai][bj][m][0] * rinv * mv[0] + sv[0], y1 = acc[ai][bj][m][1] * rinv * mv[1] + sv[1];
                    *(u32x4*)(xp + (size_t)(ai * 128 + m * 16) * 1024 + bj * 128) = pack8(y0, y1);
                }
        }
    }
};
struct EpiResB {
    const bf16_t* Hb; float* out; const float* gate;
    __device__ __forceinline__ void operator()(const Acc& acc, const Unit& u, int wr, int wc, int fr, int fq) const {
        const int row0 = u.arow + wr * 64 + fr, col0 = u.brow + wc * 32 + fq * 8, b = row0 >> 12;
        const bf16_t* ip = Hb + (size_t)row0 * 1024 + col0; float* op = out + (size_t)row0 * 1024 + col0;
        const float* gp = gate + b * 6144 + col0;
        f32x4 gv[2][2];
#pragma unroll
        for (int bj = 0; bj < 2; ++bj)
#pragma unroll
            for (int n = 0; n < 2; ++n) gv[bj][n] = *(const f32x4*)(gp + bj * 128 + 4 * n);
#pragma unroll
        for (int ai = 0; ai < 2; ++ai) {
            u32x4 hw[4][2];
#pragma unroll
            for (int m = 0; m < 4; ++m)
#pragma unroll
                for (int bj = 0; bj < 2; ++bj) hw[m][bj] = *(const u32x4*)(ip + (size_t)(ai * 128 + m * 16) * 1024 + bj * 128);
#pragma unroll
            for (int m = 0; m < 4; ++m)
#pragma unroll
                for (int bj = 0; bj < 2; ++bj) {
                    const u32x4 w = hw[m][bj];
                    const f32x4 h0 = {__uint_as_float(w.x << 16), __uint_as_float(w.x & 0xFFFF0000u), __uint_as_float(w.y << 16), __uint_as_float(w.y & 0xFFFF0000u)};
                    const f32x4 h1 = {__uint_as_float(w.z << 16), __uint_as_float(w.z & 0xFFFF0000u), __uint_as_float(w.w << 16), __uint_as_float(w.w & 0xFFFF0000u)};
                    float* q = op + (size_t)(ai * 128 + m * 16) * 1024 + bj * 128;
                    *(f32x4*)q = h0 + gv[bj][0] * acc[ai][bj][m][0]; *(f32x4*)(q + 4) = h1 + gv[bj][1] * acc[ai][bj][m][1];
                }
        }
    }
};
struct EpiPart {
    bf16_t* slab;
    __device__ __forceinline__ void operator()(const Acc& acc, const Unit& u, int wr, int wc, int fr, int fq) const {
        bf16_t* base = slab + (size_t)(u.kofs >> 8) * 1024 * 1024;
#pragma unroll
        for (int ai = 0; ai < 2; ++ai)
#pragma unroll
            for (int m = 0; m < 4; ++m) {
                const int row = u.arow + ai * 128 + wr * 64 + m * 16 + fr;
                bf16_t* op = base + (size_t)row * 1024;
#pragma unroll
                for (int bj = 0; bj < 2; ++bj) *(u32x4*)(op + u.brow + bj * 128 + wc * 32 + fq * 8) = pack8(acc[ai][bj][m][0], acc[ai][bj][m][1]);
            }
    }
};
struct EpiSwiglu {
    bf16_t* ACT;
    __device__ __forceinline__ void operator()(const Acc& acc, const Unit& u, int wr, int wc, int fr, int fq) const {
#pragma unroll
        for (int ai = 0; ai < 2; ++ai)
#pragma unroll
            for (int m = 0; m < 4; ++m) {
                const int row = u.arow + ai * 128 + wr * 64 + m * 16 + fr;
                const int col = u.pn * 128 + wc * 32 + fq * 8;
                f32x4 o0, o1;
#pragma unroll
                for (int j = 0; j < 4; ++j) { o0[j] = siluf_(acc[ai][0][m][0][j]) * acc[ai][1][m][0][j]; o1[j] = siluf_(acc[ai][0][m][1][j]) * acc[ai][1][m][1][j]; }
                *(u32x4*)(ACT + (size_t)row * FF + col) = pack8(o0, o1);
            }
    }
};
struct EpiGlu {
    float* H; const float* gate;
    __device__ __forceinline__ void operator()(const Acc& acc, const Unit& u, int wr, int wc, int fr, int fq) const {
        const int b = u.arow >> 12; const int col = u.pn * 128 + wc * 32 + fq * 8;
        const float* gp = gate + b * 6144 + col;
        float* hp0 = H + (size_t)(u.arow + wr * 64 + fr) * 1024 + col;
        f32x4 gv[2];
#pragma unroll
        for (int n = 0; n < 2; ++n) gv[n] = *(const f32x4*)(gp + 4 * n);
#pragma unroll
        for (int ai = 0; ai < 2; ++ai) {
            f32x4 hv[4][2];
#pragma unroll
            for (int m = 0; m < 4; ++m)
#pragma unroll
                for (int n = 0; n < 2; ++n) hv[m][n] = *(const f32x4*)(hp0 + (size_t)(ai * 128 + m * 16) * 1024 + 4 * n);
#pragma unroll
            for (int m = 0; m < 4; ++m)
#pragma unroll
                for (int n = 0; n < 2; ++n) {
                    f32x4 o;
#pragma unroll
                    for (int j = 0; j < 4; ++j) o[j] = hv[m][n][j] + gv[n][j] * (acc[ai][0][m][n][j] * sigmoidf_(acc[ai][1][m][n][j]));
                    *(f32x4*)(hp0 + (size_t)(ai * 128 + m * 16) * 1024 + 4 * n) = o;
                }
        }
    }
};
struct EpiGluNorm {
    static constexpr bool AFTER_DRAIN = true;
    float* H; const float* gate; const float* ng; const float* mods_l; bf16_t* XNo; float* xss; unsigned* pcnt; unsigned* tmo;
    __device__ __forceinline__ void fused(Acc& acc, const Unit& u, int wr, int wc, int fr, int fq, LAS unsigned char* lds, int wid, int lane) const {
        LAS float* P = (LAS float*)lds; LAS float* S = (LAS float*)(lds + 8192);
        const int row0 = u.arow + wr * 64 + fr, col = u.pn * 128 + wc * 32 + fq * 8, b = row0 >> 12;
        float* hp = H + (size_t)row0 * 1024 + col;
        {
            const float* gp = gate + b * 6144 + col; f32x4 gv[2];
#pragma unroll
            for (int n = 0; n < 2; ++n) gv[n] = *(const f32x4*)(gp + 4 * n);
#pragma unroll
            for (int ai = 0; ai < 2; ++ai)
#pragma unroll
                for (int m = 0; m < 4; ++m) {
                    float s = 0.f;
#pragma unroll
                    for (int n = 0; n < 2; ++n) {
                        const f32x4 hv = *(const f32x4*)(hp + (size_t)(ai * 128 + m * 16) * 1024 + 4 * n); f32x4 o;
#pragma unroll
                        for (int j = 0; j < 4; ++j) o[j] = hv[j] + gv[n][j] * (acc[ai][0][m][n][j] * sigmoidf_(acc[ai][1][m][n][j]));
                        *(f32x4*)(hp + (size_t)(ai * 128 + m * 16) * 1024 + 4 * n) = o; acc[ai][0][m][n] = o;
                        s += (o[0] * o[0] + o[1] * o[1]) + (o[2] * o[2] + o[3] * o[3]);
                    }
                    s += __shfl_xor(s, 16); s += __shfl_xor(s, 32);
                    if (fq == 0) P[(ai * 128 + wr * 64 + m * 16 + fr) * 4 + wc] = s;
                }
        }
        asm volatile("s_waitcnt lgkmcnt(0)" ::: "memory"); __builtin_amdgcn_s_barrier(); asm volatile("" ::: "memory");
        const int row = wid * 32 + (lane & 31);
        if (lane < 32) {
            const float t = (P[row * 4 + 0] + P[row * 4 + 1]) + (P[row * 4 + 2] + P[row * 4 + 3]);
            __hip_atomic_store((unsigned*)xss + ((size_t)(u.arow + row) * 8 + u.pn), __float_as_uint(t), __ATOMIC_RELAXED, __HIP_MEMORY_SCOPE_AGENT);
        }
        asm volatile("s_waitcnt vmcnt(0)" ::: "memory");
        if (lane == 0) __hip_atomic_fetch_add(pcnt + 64 * u.pm, 1u, __ATOMIC_RELAXED, __HIP_MEMORY_SCOPE_AGENT);
        if (wid == 0) {
            unsigned sp = 0;
            while ((unsigned)__builtin_amdgcn_readfirstlane(__hip_atomic_load(pcnt + 64 * u.pm, __ATOMIC_RELAXED, __HIP_MEMORY_SCOPE_AGENT)) < 64u) {
                __builtin_amdgcn_s_sleep(2);
                if ((++sp & 1023u) == 0u) { if (__hip_atomic_load(tmo, __ATOMIC_RELAXED, __HIP_MEMORY_SCOPE_AGENT) != 0u) break; if (sp > (1u << 22)) { if (lane == 0) atomicAdd(tmo, 1u); break; } }
            }
            __builtin_amdgcn_fence(__ATOMIC_ACQUIRE, "agent");
        }
        asm volatile("s_waitcnt vmcnt(0) lgkmcnt(0)" ::: "memory"); __builtin_amdgcn_s_barrier(); asm volatile("" ::: "memory");
        if (lane < 32) {
            const unsigned* slot = (const unsigned*)xss + (size_t)(u.arow + row) * 8; float t = 0.f;
#pragma unroll
            for (int q = 0; q < 8; ++q) t += __uint_as_float(__hip_atomic_load(slot + q, __ATOMIC_RELAXED, __HIP_MEMORY_SCOPE_AGENT));
            S[row] = rsqrtf(t * (1.0f / 1024.0f) + 1e-6f);
        }
        asm volatile("s_waitcnt lgkmcnt(0)" ::: "memory"); __builtin_amdgcn_s_barrier(); asm volatile("" ::: "memory");
        f32x4 mv[2], sv[2];
#pragma unroll
        for (int n = 0; n < 2; ++n) { const int c = col + 4 * n; const f32x4 g4 = *(const f32x4*)(ng + c), s4 = *(const f32x4*)(mods_l + (size_t)b * 6144 + 4 * 1024 + c); sv[n] = *(const f32x4*)(mods_l + (size_t)b * 6144 + 3 * 1024 + c);
#pragma unroll
            for (int j = 0; j < 4; ++j) mv[n][j] = g4[j] * (1.0f + s4[j]); }
        bf16_t* xp = XNo + (size_t)row0 * 1024 + col;
#pragma unroll
        for (int ai = 0; ai < 2; ++ai)
#pragma unroll
            for (int m = 0; m < 4; ++m) {
                const float rinv = S[ai * 128 + wr * 64 + m * 16 + fr];
                const f32x4 y0 = acc[ai][0][m][0] * rinv * mv[0] + sv[0], y1 = acc[ai][0][m][1] * rinv * mv[1] + sv[1];
                *(u32x4*)(xp + (size_t)(ai * 128 + m * 16) * 1024) = pack8(y0, y1);
            }
    }
};
struct EpiState {
    bf16_t* S;
    __device__ __forceinline__ void operator()(const Acc& acc, const Unit& u, int wr, int wc, int fr, int fq) const {
        bf16_t* base = S + (size_t)u.pn * SROWS * 256;
#pragma unroll
        for (int ai = 0; ai < 2; ++ai)
#pragma unroll
            for (int m = 0; m < 4; ++m) {
                const int lrow = u.pm * 256 + ai * 128 + wr * 64 + m * 16 + fr;
                bf16_t* op = base + (size_t)lrow * 256;
#pragma unroll
                for (int bj = 0; bj < 2; ++bj) *(u32x4*)(op + bj * 128 + wc * 32 + fq * 8) = pack8(acc[ai][bj][m][0], acc[ai][bj][m][1]);
            }
    }
};
struct EpiSout {
    bf16_t* GY;
    __device__ __forceinline__ void operator()(const Acc& acc, const Unit& u, int wr, int wc, int fr, int fq) const {
#pragma unroll
        for (int ai = 0; ai < 2; ++ai)
#pragma unroll
            for (int m = 0; m < 4; ++m) {
                const int lrow = u.pm * 256 + ai * 128 + wr * 64 + m * 16 + fr;
                const int b = lrow >> 8, ch = lrow & 255;
#pragma unroll
                for (int bj = 0; bj < 2; ++bj) {
                    const int n = bj * 128 + wc * 32 + fq * 8; const int t = n >> 4, h0 = n & 15;
                    f32x4 o0, o1;
#pragma unroll
                    for (int j = 0; j < 4; ++j) { o0[j] = gelu_tanh(acc[ai][bj][m][0][j]); o1[j] = gelu_tanh(acc[ai][bj][m][1][j]); }
                    *(u32x4*)(GY + (size_t)(b * 4096 + ch * 16 + t) * 1024 + u.pn * 16 + h0) = pack8(o0, o1);
                }
            }
    }
};

__device__ __forceinline__ void p0_transpose(const float* src, int ld, int K, int c0, bf16_t* dst, float scale, LAS float* tile) {
    const int tid = otid();
    const int lkk = tid >> 7, lcc = tid & 127;
    float r[16];
#pragma unroll
    for (int i = 0; i < 16; ++i) r[i] = __builtin_nontemporal_load(src + (size_t)(lkk + 4 * i) * ld + c0 + lcc);
    for (int k0 = 0; k0 < K; k0 += 64) {
        __syncthreads();
#pragma unroll
        for (int i = 0; i < 16; ++i) tile[(lkk + 4 * i) * 129 + lcc] = r[i];
        if (k0 + 64 < K) {
#pragma unroll
            for (int i = 0; i < 16; ++i) r[i] = __builtin_nontemporal_load(src + (size_t)(k0 + 64 + lkk + 4 * i) * ld + c0 + lcc);
        }
        __syncthreads();
        { const int cc = tid >> 2, kk0 = (tid & 3) * 16; float v[16];
#pragma unroll
          for (int j = 0; j < 16; ++j) v[j] = tile[(kk0 + j) * 129 + cc] * scale;
          u32x4 w0, w1; w0.x = cvt_pk_bf16(v[0], v[1]); w0.y = cvt_pk_bf16(v[2], v[3]); w0.z = cvt_pk_bf16(v[4], v[5]); w0.w = cvt_pk_bf16(v[6], v[7]);
          w1.x = cvt_pk_bf16(v[8], v[9]); w1.y = cvt_pk_bf16(v[10], v[11]); w1.z = cvt_pk_bf16(v[12], v[13]); w1.w = cvt_pk_bf16(v[14], v[15]);
          bf16_t* dp = dst + (size_t)cc * K + k0 + kk0; *(u32x4*)dp = w0; *(u32x4*)(dp + 8) = w1; }
    }
    __syncthreads();
}

__device__ __forceinline__ void p0_s5_item(const Params& p, int g, LAS float* L) {
    const int tid = otid();
    LAS float* pw_re = L;
    LAS float* pw_im = L + 2176;
    LAS float* bb_re = L + 4352;
    LAS float* bb_im = L + 6400;
    LAS float* cc_re = L + 8448;
    LAS float* cc_im = L + 10528;
    LAS float* Kt = L + 12608;
    __syncthreads();
    for (int idx = tid; idx < 2176; idx += NT) {
        const int dir = idx / 1088, rem = idx - dir * 1088, pp = rem / 17, tau = rem - pp * 17;
        const float dt = expf(p.log_dt[dir * 64 + g]);
        const float are = p.a_re[(dir * 64 + g) * 64 + pp], aim = p.a_im[(dir * 64 + g) * 64 + pp];
        const float mag = expf(are * dt * (float)tau); float s, c; sincosf(aim * dt * (float)tau, &s, &c);
        pw_re[idx] = mag * c; pw_im[idx] = mag * s;
    }
    __syncthreads();
    if (tid < 128) {
        const int dir = tid >> 6, pp = tid & 63;
        const float are = p.a_re[(dir * 64 + g) * 64 + pp], aim = p.a_im[(dir * 64 + g) * 64 + pp];
        const float abr = pw_re[(dir * 64 + pp) * 17 + 1], abi = pw_im[(dir * 64 + pp) * 17 + 1];
        const float nr = abr - 1.0f, ni = abi, den = are * are + aim * aim;
        const float fre = (nr * are + ni * aim) / den, fim = (ni * are - nr * aim) / den;
        for (int h = 0; h < 16; ++h) {
            const float br = p.b_re[((size_t)(dir * 64 + g) * 64 + pp) * 16 + h], bi = p.b_im[((size_t)(dir * 64 + g) * 64 + pp) * 16 + h];
            bb_re[(dir * 64 + pp) * 16 + h] = fre * br - fim * bi; bb_im[(dir * 64 + pp) * 16 + h] = fre * bi + fim * br;
        }
    }
    for (int idx = tid; idx < 2048; idx += NT) {
        const int dir = idx >> 10, h = (idx >> 6) & 15, pp = idx & 63;
        cc_re[(dir * 16 + h) * 65 + pp] = p.c_re[((size_t)(dir * 64 + g) * 16 + h) * 64 + pp]; cc_im[(dir * 16 + h) * 65 + pp] = p.c_im[((size_t)(dir * 64 + g) * 16 + h) * 64 + pp];
    }
    __syncthreads();
    {
        const int dir = tid >> 8, tau = (tid >> 4) & 15, h = tid & 15;
        float a[16];
#pragma unroll
        for (int j = 0; j < 16; ++j) a[j] = 0.f;
        for (int pp = 0; pp < 64; ++pp) {
            const float cr = cc_re[(dir * 16 + h) * 65 + pp], ci = cc_im[(dir * 16 + h) * 65 + pp];
            const float pr = pw_re[(dir * 64 + pp) * 17 + tau], pi = pw_im[(dir * 64 + pp) * 17 + tau];
            const float xr = cr * pr - ci * pi, xi = cr * pi + ci * pr;
#pragma unroll
            for (int j = 0; j < 16; ++j) a[j] += xr * bb_re[(dir * 64 + pp) * 16 + j] - xi * bb_im[(dir * 64 + pp) * 16 + j];
        }
#pragma unroll
        for (int j = 0; j < 16; ++j) Kt[tid * 16 + j] = a[j];
    }
    __syncthreads();
    bf16_t* Wst = (bf16_t*)(p.ws + O_WST) + (size_t)g * 256 * 256;
    for (int ch = tid; ch < 8192; ch += NT) {
        const int n = ch >> 5, k0 = (ch & 31) * 8; const int dir = n >> 7, ri = (n >> 6) & 1, pp = n & 63, s = k0 >> 4, h0 = k0 & 15; const int e = dir ? s : 15 - s;
        const float pr = pw_re[(dir * 64 + pp) * 17 + e], pi = pw_im[(dir * 64 + pp) * 17 + e];
        float v[8];
#pragma unroll
        for (int j = 0; j < 8; ++j) { const float br = bb_re[(dir * 64 + pp) * 16 + h0 + j], bi = bb_im[(dir * 64 + pp) * 16 + h0 + j]; v[j] = ri ? (pr * bi + pi * br) : (pr * br - pi * bi); }
        u32x4 w; w.x = cvt_pk_bf16(v[0], v[1]); w.y = cvt_pk_bf16(v[2], v[3]); w.z = cvt_pk_bf16(v[4], v[5]); w.w = cvt_pk_bf16(v[6], v[7]);
        *(u32x4*)(Wst + (size_t)n * 256 + k0) = w;
    }
    bf16_t* Tt = (bf16_t*)(p.ws + O_TT) + (size_t)g * 256 * 512;
    for (int ch = tid; ch < 16384; ch += NT) {
        const int n = ch >> 6, k0 = (ch & 63) * 8; const int t = n >> 4, h = n & 15; float v[8];
        if (k0 < 256) {
            const int s = k0 >> 4, h0 = k0 & 15;
#pragma unroll
            for (int j = 0; j < 8; ++j) {
                float x = 0.f;
                if (s <= t) x += Kt[((0 * 16 + (t - s)) * 16 + h) * 16 + h0 + j];
                if (s >= t) x += Kt[((1 * 16 + (s - t)) * 16 + h) * 16 + h0 + j];
                if (s == t && h == h0 + j) x += p.ssm_d[g * 16 + h];
                v[j] = x;
            }
        } else {
            const int kk = k0 - 256, dir = kk >> 7, ri = (kk >> 6) & 1, p0 = kk & 63; const int e = dir ? 16 - t : t + 1;
#pragma unroll
            for (int j = 0; j < 8; ++j) {
                const int pp = p0 + j;
                const float cr = cc_re[(dir * 16 + h) * 65 + pp], ci = cc_im[(dir * 16 + h) * 65 + pp], pr = pw_re[(dir * 64 + pp) * 17 + e], pi = pw_im[(dir * 64 + pp) * 17 + e];
                v[j] = ri ? -(cr * pi + ci * pr) : (cr * pr - ci * pi);
            }
        }
        u32x4 w; w.x = cvt_pk_bf16(v[0], v[1]); w.y = cvt_pk_bf16(v[2], v[3]); w.z = cvt_pk_bf16(v[4], v[5]); w.w = cvt_pk_bf16(v[6], v[7]);
        *(u32x4*)(Tt + (size_t)n * 512 + k0) = w;
    }
    __syncthreads();
}

__device__ __forceinline__ void p0_adaln_item(const Params& p, int it, LAS float* L) {
    const int tid = otid(); const int l = it / 96, n0 = (it % 96) * 64;
    LAS float* sc = L;
    LAS float* red = L + 5120;
    __syncthreads();
    for (int idx = tid; idx < 5120; idx += NT) { const int r = idx >> 10, k = idx & 1023; const float v = (r < 4) ? p.c[r * 1024 + k] : p.c_ctx[k]; sc[idx] = siluf_(v); }
    __syncthreads();
    const int n = tid & 63, kq = tid >> 6; float a[5] = {0.f, 0.f, 0.f, 0.f, 0.f};
    const float* wp = p.mod_w + (size_t)l * 1024 * 6144 + n0 + n;
    for (int k = kq; k < 1024; k += 128) {
        float w[16];
#pragma unroll
        for (int u = 0; u < 16; ++u) w[u] = __builtin_nontemporal_load(wp + (size_t)(k + 8 * u) * 6144);
#pragma unroll
        for (int u = 0; u < 16; ++u)
#pragma unroll
            for (int r = 0; r < 5; ++r) a[r] += sc[r * 1024 + k + 8 * u] * w[u];
    }
#pragma unroll
    for (int r = 0; r < 5; ++r) red[(kq * 5 + r) * 64 + n] = a[r];
    __syncthreads();
    if (tid < 320) { const int r = tid >> 6, nn = tid & 63; float s = p.mod_b[l * 6144 + n0 + nn];
#pragma unroll
        for (int q = 0; q < 8; ++q) s += red[(q * 5 + r) * 64 + nn];
        ((float*)(p.ws + O_MODS))[(size_t)(l * 5 + r) * 6144 + n0 + nn] = s; }
    __syncthreads();
}

__device__ __forceinline__ void p0_fold_item(const Params& p, int it, LAS float* L) {
    const int tid = otid(); const int grp = it >> 4, kt = it & 15;
    LAS float* w = L;
    LAS float* cT = L + 4160;
    LAS float* sT = L + 4224;
    __syncthreads();
#pragma unroll
    for (int i = 0; i < 8; ++i) { const int idx = tid + i * NT, kk = idx >> 6, j = idx & 63; w[kk * 65 + j] = p.w_in[(size_t)(kt * 64 + kk) * 1280 + grp * 64 + j]; }
    if (tid < 64) { cT[tid] = cospif((float)tid / 32.0f); sT[tid] = sinpif((float)tid / 32.0f); }
    __syncthreads();
    const int kk = tid & 63, q = tid >> 6; bf16_t* WinA = (bf16_t*)(p.ws + O_WINA);
    for (int i = 0; i < 8; ++i) {
        const int n = q + 8 * i; float ac = 0.f, as = 0.f; int ph = 0;
        for (int j = 0; j < 64; ++j) { const float wv = w[kk * 65 + j]; ac += wv * cT[ph]; as += wv * sT[ph]; ph = (ph + n) & 63; }
        WinA[(size_t)(grp * 64 + n) * 1024 + kt * 64 + kk] = f2bf(ac);
        WinA[(size_t)(512 + grp * 64 + n) * 1024 + kt * 64 + kk] = f2bf(as);
    }
    __syncthreads();
}

__device__ __forceinline__ void p0_dft_item(const Params& p, int it, LAS float* L) {
    const int tid = otid();
    __syncthreads();
    for (int i = tid; i < 256; i += NT) L[i] = cospif((float)i / 128.0f);
    __syncthreads();
    if (it == 0) {
        bf16_t* D = (bf16_t*)(p.ws + O_D256);
        for (int idx = tid; idx < 512 * 512; idx += NT) {
            const int row = idx >> 9, col = idx & 511; const int ro = row >> 8, k = row & 255, cs = col >> 8, t = col & 255; const int ph = (k * t) & 255;
            const float C = L[ph], S = L[(ph - 64) & 255];
            const float v = ro == 0 ? (cs == 0 ? C : -S) : (cs == 0 ? -S : -C);
            D[idx] = f2bf(v);
        }
    } else {
        bf16_t* Dc = (bf16_t*)(p.ws + O_DC);
        for (int idx = tid; idx < 256 * 512; idx += NT) {
            const int k = idx >> 9, j = idx & 511, t = j & 255, cs = j >> 8; const int ph = (k * t) & 255;
            Dc[idx] = f2bf((cs ? -L[(ph - 64) & 255] : L[ph]) * (1.0f / 128.0f));
        }
    }
    __syncthreads();
}

constexpr int P0_S5 = 64, P0_ADA = 192, P0_FOLD = 128, P0_TR = 134, P0_DFT = 2, P0_MISC = 1;
constexpr int P0_ITEMS = P0_S5 + P0_ADA + P0_FOLD + P0_TR + P0_DFT + P0_MISC;

__device__ __forceinline__ void p0_transpose_dispatch(const Params& p, int it, LAS float* L) {
    unsigned char* ws = p.ws;
    const float* src; int ld, K, c0; bf16_t* dst; float scale = 1.0f;
    if (it < 16) { const int l = it >> 3; it &= 7; src = p.ffn_d + (size_t)l * FF * 1024; ld = 1024; K = FF; c0 = 128 * it; dst = (bf16_t*)(ws + (l ? O_WD1 : O_WD0)) + (size_t)(128 * it) * FF; }
    else {
        it -= 16;
        if (it < 4) { src = p.w_in; ld = 1280; K = 1024; c0 = 512 + 128 * it; dst = (bf16_t*)(ws + O_WINB) + (size_t)(128 * it) * 1024; scale = 0.125f * 1.4426950408889634f; }
        else if (it < 5) { src = p.w_in; ld = 1280; K = 1024; c0 = 1024; dst = (bf16_t*)(ws + O_WINB) + (size_t)512 * 1024; }
        else if (it < 6) { src = p.w_in; ld = 1280; K = 1024; c0 = 1152; dst = (bf16_t*)(ws + O_WINB) + (size_t)640 * 1024; }
        else if (it < 14) { it -= 6; src = p.w_out; ld = 1024; K = 1024; c0 = 128 * it; dst = (bf16_t*)(ws + O_WOUT) + (size_t)(128 * it) * 1024; }
        else if (it < 14 + 88) {
            it -= 14; const int l = it / 44; it -= l * 44;
            bf16_t* wgu = (bf16_t*)(ws + (l ? O_WGU1 : O_WGU0));
            const int up = it / 22, tile = it % 22;
            src = (up ? p.ffn_u : p.ffn_g) + (size_t)l * 1024 * FF; ld = FF; K = 1024; c0 = 128 * tile; dst = wgu + (size_t)(tile * 256 + up * 128) * 1024;
        } else {
            it -= 102; c0 = 128 * it; const int half = c0 >> 10, j = c0 & 1023;
            src = p.glu_w; ld = 2048; K = 1024; dst = (bf16_t*)(ws + O_GLU) + (size_t)((j >> 7) * 256 + half * 128) * 1024;
        }
    }
    p0_transpose(src, ld, K, c0, dst, scale, L);
}

__device__ __forceinline__ void p0_misc(const Params& p) {
    const int tid = otid();
    float* rc = (float*)(p.ws + O_ROPE); float* rs = rc + 1024;
    for (int i = tid; i < 1024; i += NT) { const int pp = i >> 4, f = i & 15; const float inv = powf(10000.0f, -(float)f / 16.0f); const float ang = (float)pp * inv; float s, c; sincosf(ang, &s, &c); rc[i] = c; rs[i] = s; }
}

__device__ __forceinline__ void p0_dispatch(const Params& p, int it, LAS float* L) {
    int i = it;
    if (i < 64) { p0_s5_item(p, i, L); return; } i -= 64;
    if (i < 16) { p0_transpose_dispatch(p, i, L); return; } i -= 16;
    if (i < 128) { p0_fold_item(p, i, L); return; } i -= 128;
    if (i < 118) { p0_transpose_dispatch(p, 16 + i, L); return; } i -= 118;
    if (i < 192) { p0_adaln_item(p, i, L); return; } i -= 192;
    if (i < 2) { p0_dft_item(p, i, L); return; } i -= 2;
    p0_misc(p);
}
__device__ __forceinline__ void phase_p0(const Params& p, LAS float* L, unsigned* qhead, volatile LAS unsigned* qslot) {
    for (;;) {
        __syncthreads();
        if (threadIdx.x == 0) qslot[0] = __hip_atomic_fetch_add(qhead, 1u, __ATOMIC_RELAXED, __HIP_MEMORY_SCOPE_AGENT);
        __syncthreads();
        const int it = (int)qslot[0];
        if (it >= P0_ITEMS) break;
        p0_dispatch(p, it, L);
    }
}

template <int MODE>
__device__ __forceinline__ void phase_norm(const float* src_lat, const float* src_ctx, int nrows, const float* ng, const float* mods_l, int sh_idx, int sc_idx, bf16_t* dstb, float* dstf,
                                           const bf16_t* part = nullptr, int npart = 0, const float* pgate = nullptr, float* hstore = nullptr, int row_first = 0) {
    const int tid_ = otid(); const int lane = tid_ & 63, wv = obid() * 8 + (tid_ >> 6), nw = gridDim.x * 8;
    for (int row = row_first + wv; row < nrows; row += nw) {
        const float* sp; int mr;
        if (row < NLAT) { sp = src_lat + (size_t)row * 1024; mr = row >> 12; } else { sp = src_ctx + (size_t)(row - NLAT) * 1024; mr = 4; }
        f32x4 v[4]; float ss = 0.f;
#pragma unroll
        for (int i = 0; i < 4; ++i) v[i] = *(const f32x4*)(sp + i * 256 + lane * 4);
        if (npart > 0 && row >= NLAT) {
#pragma unroll
            for (int i = 0; i < 4; ++i) {
                const int col = i * 256 + lane * 4; f32x4 s = {0.f, 0.f, 0.f, 0.f};
#pragma unroll 2
                for (int k = 0; k < npart; ++k) { const u32x2 w = *(const u32x2*)(part + ((size_t)k * 1024 + (row - NLAT)) * 1024 + col);
                    s[0] += __uint_as_float(w.x << 16); s[1] += __uint_as_float(w.x & 0xFFFF0000u); s[2] += __uint_as_float(w.y << 16); s[3] += __uint_as_float(w.y & 0xFFFF0000u); }
                v[i] += *(const f32x4*)(pgate + col) * s;
                if (hstore) *(f32x4*)(hstore + (size_t)(row - NLAT) * 1024 + col) = v[i];
            }
        }
#pragma unroll
        for (int i = 0; i < 4; ++i) ss += v[i][0] * v[i][0] + v[i][1] * v[i][1] + v[i][2] * v[i][2] + v[i][3] * v[i][3];
#pragma unroll
        for (int o = 32; o >= 1; o >>= 1) ss += __shfl_xor(ss, o);
        const float rinv = rsqrtf(ss * (1.0f / 1024.0f) + 1e-6f);
#pragma unroll
        for (int i = 0; i < 4; ++i) {
            const int col = i * 256 + lane * 4; const f32x4 gv = *(const f32x4*)(ng + col); f32x4 y;
            if (MODE == 2) {
#pragma unroll
                for (int j = 0; j < 4; ++j) y[j] = v[i][j] * rinv * gv[j];
                *(f32x4*)(dstf + (size_t)row * 1024 + col) = y;
            } else {
                const f32x4 sh = *(const f32x4*)(mods_l + (size_t)mr * 6144 + sh_idx * 1024 + col), sc = *(const f32x4*)(mods_l + (size_t)mr * 6144 + sc_idx * 1024 + col);
#pragma unroll
                for (int j = 0; j < 4; ++j) y[j] = v[i][j] * rinv * gv[j] * (1.0f + sc[j]) + sh[j];
                u32x2 w; w.x = cvt_pk_bf16(y[0], y[1]); w.y = cvt_pk_bf16(y[2], y[3]);
                if (MODE == 0) *(u32x2*)(dstb + (size_t)row * 1024 + col) = w;
                else {
                    int lrow, s;
                    if (row < NLAT) { const int b = row >> 12, t = row & 4095; lrow = b * 256 + (t >> 4); s = t & 15; } else { const int r2 = row - NLAT, b = r2 >> 8, t = r2 & 255; lrow = 1024 + b * 16 + (t >> 4); s = t & 15; }
                    const int g = col >> 4, h2 = col & 15;
                    *(u32x2*)(dstb + ((size_t)g * GROWS + lrow) * 512 + s * 16 + h2) = w;
                }
            }
        }
    }
}

struct AttnFr { bf16x8 k[4]; bf16x8 v[4]; };
__device__ __forceinline__ void attn_load(AttnFr& f, const bf16_t* kp, const bf16_t* vp) {
#pragma unroll
    for (int kk = 0; kk < 4; ++kk) f.k[kk] = *(const bf16x8*)(kp + 16 * kk);
#pragma unroll
    for (int q = 0; q < 4; ++q) f.v[q] = *(const bf16x8*)(vp + q * 512);
}

__device__ __forceinline__ void attn_item(const Params& p, int item) {
    const int lane = otid() & 63, r = lane & 31, h = lane >> 5;
    const bf16_t* Q = (const bf16_t*)(p.ws + O_Q); const bf16_t* Kb = (const bf16_t*)(p.ws + O_K);
    const bf16_t* VT = (const bf16_t*)(p.ws + O_VT); const bf16_t* VTc = (const bf16_t*)(p.ws + O_VTC);
    bf16_t* MIX = (bf16_t*)(p.ws + O_MIX);
    int b, qt, hq, tok0, q0, ntile; bool isctx;
    if (item < 4096) { isctx = false; b = item >> 10; qt = (item >> 3) & 127; hq = item & 7; q0 = qt * 32; tok0 = b * 4096 + q0; ntile = 17; }
    else { const int it = item - 4096; isctx = true; b = it >> 6; qt = (it >> 3) & 7; hq = it & 7; q0 = qt * 32; tok0 = NLAT + b * 256 + q0; ntile = 8; }
    const int kvh = hq >> 2;
    bf16x8 qf[4];
    { const bf16_t* qp = Q + (size_t)(tok0 + r) * 512 + hq * 64 + h * 8;
#pragma unroll
      for (int kk = 0; kk < 4; ++kk) qf[kk] = *(const bf16x8*)(qp + 16 * kk); }
    float mrun = p.sink[hq] * 1.4426950408889634f, lrun = 1.0f;
    f32x16 o0, o1;
#pragma unroll
    for (int i = 0; i < 16; ++i) { o0[i] = 0.f; o1[i] = 0.f; }
    const int qpos = q0 + r;
    auto tile_ptrs = [&](int ti, const bf16_t*& kp, const bf16_t*& vp) {
        if (ti < 8) { kp = Kb + (size_t)(NLAT + b * 256 + 32 * ti + r) * 128 + kvh * 64 + h * 8; vp = VTc + (size_t)((b * 2 + kvh) * 8 + ti) * 2048 + lane * 8; }
        else { const int kbase = q0 - 128 + 32 * (ti - 8); const int kc = kbase < 0 ? 0 : (kbase > 4064 ? 4064 : kbase);
               kp = Kb + (size_t)(b * 4096 + kc + r) * 128 + kvh * 64 + h * 8; vp = VT + (size_t)((b * 2 + kvh) * 128 + (kc >> 5)) * 2048 + lane * 8; }
    };
    AttnFr cur, nxt;
    { const bf16_t *kp, *vp; tile_ptrs(0, kp, vp); attn_load(cur, kp, vp); }
    for (int ti = 0; ti < ntile; ++ti) {
        if (ti + 1 < ntile) { const bf16_t *kp, *vp; tile_ptrs(ti + 1, kp, vp); attn_load(nxt, kp, vp); }
        f32x16 s;
#pragma unroll
        for (int i = 0; i < 16; ++i) s[i] = 0.f;
#pragma unroll
        for (int kk = 0; kk < 4; ++kk) s = __builtin_amdgcn_mfma_f32_32x32x16_bf16(cur.k[kk], qf[kk], s, 0, 0, 0);
        if (ti >= 8) {
            const int kbase = q0 - 128 + 32 * (ti - 8);
            if (ti == 8 || ti == 16 || kbase < 0 || kbase > 4064) {
#pragma unroll
                for (int i = 0; i < 16; ++i) { const int kpos = kbase + (i & 3) + 8 * (i >> 2) + 4 * h; const int d = kpos - qpos; const bool ok = (kpos >= 0) && (kpos < 4096) && (d <= 128) && (d >= -128); s[i] = ok ? s[i] : -1e30f; }
            }
        }
        float mx = s[0];
#pragma unroll
        for (int i = 1; i < 16; ++i) mx = fmaxf(mx, s[i]);
        mx = fmaxf(mx, __shfl_xor(mx, 32));
        const float mnew = fmaxf(mrun, mx), alpha = __builtin_amdgcn_exp2f(mrun - mnew);
        float ps = 0.f; float pv[16];
#pragma unroll
        for (int i = 0; i < 16; ++i) { pv[i] = __builtin_amdgcn_exp2f(s[i] - mnew); ps += pv[i]; }
        ps += __shfl_xor(ps, 32);
        lrun = lrun * alpha + ps;
        if (__builtin_amdgcn_ballot_w64(mnew != mrun) != 0ull) {
#pragma unroll
            for (int i = 0; i < 16; ++i) { o0[i] *= alpha; o1[i] *= alpha; }
        }
        mrun = mnew;
        bf16x8 pf[2];
#pragma unroll
        for (int sidx = 0; sidx < 2; ++sidx) { u32x4 w; w.x = cvt_pk_bf16(pv[8 * sidx + 0], pv[8 * sidx + 1]); w.y = cvt_pk_bf16(pv[8 * sidx + 2], pv[8 * sidx + 3]); w.z = cvt_pk_bf16(pv[8 * sidx + 4], pv[8 * sidx + 5]); w.w = cvt_pk_bf16(pv[8 * sidx + 6], pv[8 * sidx + 7]); pf[sidx] = __builtin_bit_cast(bf16x8, w); }
#pragma unroll
        for (int sidx = 0; sidx < 2; ++sidx) {
            o0 = __builtin_amdgcn_mfma_f32_32x32x16_bf16(cur.v[sidx], pf[sidx], o0, 0, 0, 0);
            o1 = __builtin_amdgcn_mfma_f32_32x32x16_bf16(cur.v[2 + sidx], pf[sidx], o1, 0, 0, 0);
        }
        cur = nxt;
    }
    const float inv = 1.0f / lrun;
    bf16_t* op = MIX + (size_t)(tok0 + r) * 1024 + 512 + hq * 64;
#pragma unroll
    for (int rg = 0; rg < 4; ++rg) {
        const int d0 = 8 * rg + 4 * h;
        u32x2 w0, w1;
        w0.x = cvt_pk_bf16(o0[4 * rg] * inv, o0[4 * rg + 1] * inv); w0.y = cvt_pk_bf16(o0[4 * rg + 2] * inv, o0[4 * rg + 3] * inv);
        w1.x = cvt_pk_bf16(o1[4 * rg] * inv, o1[4 * rg + 1] * inv); w1.y = cvt_pk_bf16(o1[4 * rg + 2] * inv, o1[4 * rg + 3] * inv);
        *(u32x2*)(op + d0) = w0; *(u32x2*)(op + 32 + d0) = w1;
    }
}


__device__ __forceinline__ void phase_dft_combine(const Params& p, LAS float* L) {
    const int tid = otid(); const int G = gridDim.x, bx = obid();
    const bf16_t* I2 = (const bf16_t*)(p.ws + O_I2); bf16_t* MIX = (bf16_t*)(p.ws + O_MIX);
    constexpr float C16[16] = {1.0f, 0.92387953251f, 0.70710678119f, 0.38268343237f, 0.0f, -0.38268343237f, -0.70710678119f, -0.92387953251f, -1.0f, -0.92387953251f, -0.70710678119f, -0.38268343237f, 0.0f, 0.38268343237f, 0.70710678119f, 0.92387953251f};
    constexpr float S16[16] = {0.0f, 0.38268343237f, 0.70710678119f, 0.92387953251f, 1.0f, 0.92387953251f, 0.70710678119f, 0.38268343237f, 0.0f, -0.38268343237f, -0.70710678119f, -0.92387953251f, -1.0f, -0.92387953251f, -0.70710678119f, -0.38268343237f};
    for (int pair = bx; pair < 1024; pair += G) {
        const int b = pair >> 8, kp = pair & 255;
        __syncthreads();
        if (tid < 16) { float s, c; sincospif((float)(kp * tid) / 2048.0f, &s, &c); L[tid] = c; L[16 + tid] = s; }
        __syncthreads();
        const int c = tid;
        const u32x4* pr = (const u32x4*)(I2 + (size_t)kp * 32768 + (size_t)(b * 512 + c) * 16);
        const u32x4* pi = (const u32x4*)(I2 + (size_t)(256 + kp) * 32768 + (size_t)(b * 512 + c) * 16);
        const u32x4 r0 = pr[0], r1 = pr[1], i0 = pi[0], i1 = pi[1];
        const unsigned rw[8] = {r0.x, r0.y, r0.z, r0.w, r1.x, r1.y, r1.z, r1.w}, iw[8] = {i0.x, i0.y, i0.z, i0.w, i1.x, i1.y, i1.z, i1.w};
        float xr[16], xi[16];
#pragma unroll
        for (int r = 0; r < 16; ++r) {
            const float ire = __uint_as_float((r & 1) ? (rw[r >> 1] & 0xFFFF0000u) : (rw[r >> 1] << 16));
            const float iim = __uint_as_float((r & 1) ? (iw[r >> 1] & 0xFFFF0000u) : (iw[r >> 1] << 16));
            const float ct = L[r], st = L[16 + r];
            xr[r] = ire * ct + iim * st; xi[r] = iim * ct - ire * st;
        }
#pragma unroll
        for (int j = 0; j < 16; ++j) {
            float y = 0.f;
#pragma unroll
            for (int r = 0; r < 16; ++r) y += xr[r] * C16[(j * r) & 15] + xi[r] * S16[(j * r) & 15];
            MIX[(size_t)(b * 4096 + kp + 256 * j) * 1024 + c] = f2bf(y * (1.0f / 512.0f));
        }
    }
}

__device__ __forceinline__ void phase_scan(const Params& p) {
    const int tid_ = otid(); const int lane = tid_ & 63, wave = tid_ >> 6;
    const bf16_t* S = (const bf16_t*)(p.ws + O_S); bf16_t* A2 = (bf16_t*)(p.ws + O_A2);
    const int nitems = 512;
    for (int item = obid() + gridDim.x * wave; item < nitems; item += gridDim.x * 8) {
        const int b = item >> 7, g = (item >> 1) & 63, dir = item & 1, pp = lane;
        const float dt = expf(p.log_dt[dir * 64 + g]);
        const float are = p.a_re[(dir * 64 + g) * 64 + pp], aim = p.a_im[(dir * 64 + g) * 64 + pp];
        const float mag = expf(are * dt * 16.0f); float sn, cs; sincosf(aim * dt * 16.0f, &sn, &cs);
        const float ar = mag * cs, ai = mag * sn;
        float hr = 0.f, hi = 0.f;
        const bf16_t* Sg = S + (size_t)g * SROWS * 256 + dir * 128 + pp;
        bf16_t* Ag = A2 + (size_t)g * GROWS * 512 + 256 + dir * 128 + pp;
        for (int i = 0; i < 16; ++i) {
            const int ch = dir ? 15 - i : i; const size_t lrow = 1024 + b * 16 + ch;
            const float sr = __uint_as_float((unsigned)Sg[lrow * 256] << 16), si = __uint_as_float((unsigned)Sg[lrow * 256 + 64] << 16);
            const float nr = ar * hr - ai * hi + sr, ni = ar * hi + ai * hr + si; hr = nr; hi = ni;
        }
        for (int i0 = 0; i0 < 256; i0 += 8) {
            float sr[8], si[8];
#pragma unroll
            for (int j = 0; j < 8; ++j) { const int ch = dir ? 255 - (i0 + j) : (i0 + j); const size_t lrow = b * 256 + ch; sr[j] = __uint_as_float((unsigned)Sg[lrow * 256] << 16); si[j] = __uint_as_float((unsigned)Sg[lrow * 256 + 64] << 16); }
#pragma unroll
            for (int j = 0; j < 8; ++j) {
                const int ch = dir ? 255 - (i0 + j) : (i0 + j); const size_t lrow = b * 256 + ch;
                Ag[lrow * 512] = f2bf(hr); Ag[lrow * 512 + 64] = f2bf(hi);
                const float nr = ar * hr - ai * hi + sr[j], ni = ar * hi + ai * hr + si[j]; hr = nr; hi = ni;
            }
        }
    }
}


#define XB_TMO      128
#define XB_XCNT(j)  (256  + 64 * (j))
#define XB_XSUB(j)  (1280 + 64 * (j))
#define XB_XGEN(j)  (2304 + 64 * (j))
#define XB_TOP      3328
#define XB_TOPGEN   3392
#define XCD_BAR_WORDS 3456
#define XB_SPIN_CAP (1u << 22)
__device__ __forceinline__ unsigned xb_ld(unsigned* p)              { return __hip_atomic_load(p, __ATOMIC_RELAXED, __HIP_MEMORY_SCOPE_AGENT); }
__device__ __forceinline__ unsigned xb_add(unsigned* p, unsigned v) { return __hip_atomic_fetch_add(p, v, __ATOMIC_RELAXED, __HIP_MEMORY_SCOPE_AGENT); }
__device__ __forceinline__ unsigned xb_xcc_id() { return (unsigned)__builtin_amdgcn_s_getreg((3 << 11) | 20) & 0xFu; }
#define XB_SPIN(cond, bar) do { unsigned _sp = 0; while (cond) { __builtin_amdgcn_s_sleep(1); \
    if ((++_sp & 255u) == 0u) { if (xb_ld(&(bar)[XB_TMO])) break; if (_sp > XB_SPIN_CAP) { atomicAdd(&(bar)[XB_TMO], 1u); break; } } } } while (0)
__device__ __forceinline__ unsigned xcd_barrier_complete(unsigned* bar, unsigned x) {
    const unsigned G = gridDim.x;
    unsigned sum, cnt, mine, sp = 0u;
    for (;;) {
        sum = 0u; cnt = 0u; mine = 0u;
        for (unsigned j = 0; j < 16; ++j) { const unsigned c = xb_ld(&bar[XB_XCNT(j)]); sum += c; cnt += (c > 0u) ? 1u : 0u; mine = (j == x) ? c : mine; }
        if (sum == G) break;
        __builtin_amdgcn_s_sleep(1);
        if ((++sp & 255u) == 0u) { if (xb_ld(&bar[XB_TMO])) break; if (sp > XB_SPIN_CAP) { atomicAdd(&bar[XB_TMO], 1u); break; } }
    }
    const unsigned nloc = mine > 0u ? mine : 1u, nx = cnt > 0u ? cnt : 1u;
    return nloc | (nx << 16);
}
__device__ __forceinline__ void xcd_barrier(unsigned* bar, volatile LAS unsigned* st) {
    asm volatile("s_waitcnt vmcnt(0)" ::: "memory");
    __syncthreads();
    if (threadIdx.x == 0) {
        __builtin_amdgcn_s_waitcnt(0);
        const unsigned x = xb_xcc_id();
        unsigned nloc = st[0], nx = st[1];
        if (nloc == 0u) { const unsigned pk = xcd_barrier_complete(bar, x); nloc = pk & 0xFFFFu; nx = pk >> 16; st[0] = nloc; st[1] = nx; }
        const unsigned old = xb_add(&bar[XB_XSUB(x)], 1u);
        const unsigned gen = old / nloc;
        if (old + 1u == (gen + 1u) * nloc) {
            __builtin_amdgcn_fence(__ATOMIC_RELEASE, "agent");
            asm volatile("s_waitcnt vmcnt(0)" ::: "memory");
            const unsigned og = xb_add(&bar[XB_TOP], 1u);
            const unsigned tg = og / nx;
            if (og + 1u == (tg + 1u) * nx) xb_add(&bar[XB_TOPGEN], 1u);
            else XB_SPIN(xb_ld(&bar[XB_TOPGEN]) == tg, bar);
            __builtin_amdgcn_fence(__ATOMIC_ACQUIRE, "agent");
            xb_add(&bar[XB_XGEN(x)], 1u);
            asm volatile("s_waitcnt vmcnt(0)" ::: "memory");
        } else {
            XB_SPIN(xb_ld(&bar[XB_XGEN(x)]) == gen, bar);
            __builtin_amdgcn_fence(__ATOMIC_ACQUIRE, "agent");
            asm volatile("s_waitcnt vmcnt(0)" ::: "memory");
        }
    }
    __syncthreads();
}

__global__ void __launch_bounds__(NT) fwd_megakernel(Params p) {
    extern __shared__ __attribute__((aligned(16))) unsigned char shm[];
    cg::grid_group grid = cg::this_grid();
    LAS unsigned char* lds = (LAS unsigned char*)shm;
    LAS float* L = (LAS float*)shm;
    unsigned char* ws = p.ws;
    const int G = gridDim.x;
    float* mods = (float*)(ws + O_MODS);
    float* hctx = (float*)(ws + O_HCTX);
    bf16_t* XN = (bf16_t*)(ws + O_XN);
    bf16_t* ACT = (bf16_t*)(ws + O_ACT);
    const float* mods1 = mods + 5 * 6144;
    unsigned* bar = (unsigned*)(ws + O_BAR);
    volatile LAS unsigned* bst = (volatile LAS unsigned*)(lds + pg8::STAGE_BYTES);
    if (threadIdx.x < 4) bst[threadIdx.x] = 0u;
    __syncthreads();
    if (threadIdx.x == 0) (void)xb_add(&bar[XB_XCNT(xb_xcc_id())], 1u);
#define GRID_BAR() xcd_barrier(bar, bst)

    {
    phase_p0(p, L, bar + 0, bst + 2);
    }
    grid.sync();
    {
    phase_norm<0>(p.x, p.ctx, NTOK, p.norm_g + 0, mods, 0, 1, XN, nullptr);
    }
    GRID_BAR();
    {
    const int bx = obid();
    {
        const bf16_t* WinA = (const bf16_t*)(ws + O_WINA);
        bf16_t *ZT = (bf16_t*)(ws + O_ZT), *ZTc = (bf16_t*)(ws + O_ZTC), *VT = (bf16_t*)(ws + O_VT), *VTc = (bf16_t*)(ws + O_VTC);
        { pg8::Gemm g1{WinA, XN, 1024, 1024, 16384}; pg8::Sched s1; s1.init(4, 64, G, bx, 3, 1024, 16384);
          EpiInA e1{ZT, ZTc, 0, 1}; pg8::gemm_phase(lds, g1, s1, e1); }
        { pg8::Gemm gb{XN, (const bf16_t*)(ws + O_WINB), 1024, 1024, 1024}; pg8::Sched sb; sb.init(68, 3, G, bx, 0, 1024, 1024);
          EpiInB eb{(bf16_t*)(ws + O_Q), (bf16_t*)(ws + O_K), (const float*)(ws + O_ROPE), (const float*)(ws + O_ROPE) + 1024, VT, VTc}; pg8::gemm_phase(lds, gb, sb, eb); }
        { pg8::Gemm g3{WinA, XN + (size_t)NLAT * 1024, 1024, 1024, 1024}; pg8::Sched s3; s3.init(4, 4, G, (bx + G - (204 % G)) % G, 0, 1024, 1024);
          EpiInA e3{ZT, ZTc, NLAT, 0}; pg8::gemm_phase(lds, g3, s3, e3); }
    }
    }
    GRID_BAR();
    {
    const int bx = obid();
    {
        { pg8::Gemm gd{(const bf16_t*)(ws + O_D256), (const bf16_t*)(ws + O_ZT), 512, 512, 512}; pg8::Sched sd; sd.init(2, 128, G, bx, 0, 512, 512);
          EpiI2 ed{(bf16_t*)(ws + O_I2)}; pg8::gemm_phase(lds, gd, sd, ed); }
        const int wv = bx * 8 + (otid() >> 6), nw = G * 8;
        for (int item = wv; item < 4352; item += nw) attn_item(p, item);
        __syncthreads();
        { pg8::Gemm gc{(const bf16_t*)(ws + O_DC), (const bf16_t*)(ws + O_ZTC), 512, 512, 512}; pg8::Sched sc; sc.init(1, 8, G, (bx + 8) % G, 0, 512, 512);
          EpiDft ec{(bf16_t*)(ws + O_MIX), 1}; pg8::gemm_phase(lds, gc, sc, ec); }
    }
    }
    GRID_BAR();
    phase_dft_combine(p, L);
    GRID_BAR();
    {
    const int bx = obid();
    {
        const bf16_t* MIX = (const bf16_t*)(ws + O_MIX);
        pg8::Gemm g{MIX, (const bf16_t*)(ws + O_WOUT), 1024, 1024, 1024}; pg8::Sched s; s.init(64, 4, G, bx, 0, 1024, 1024);
        if (G == 256) {
            EpiResNorm e{p.x, (bf16_t*)(ws + O_H1B), mods + 2 * 1024, p.norm_g + 1024, mods, XN, (float*)(ws + O_XSS), (unsigned*)(ws + O_PCNT) + 32, bar + XB_TMO};
            pg8::gemm_phase<EpiResNorm, true>(lds, g, s, e);
            __syncthreads();
        } else {
            EpiRes e{p.x, p.ctx, p.out, hctx, mods + 2 * 1024};
            pg8::gemm_phase(lds, g, s, e);
        }
        pg8::Gemm gc{MIX + (size_t)NLAT * 1024, (const bf16_t*)(ws + O_WOUT), 256, 1024, 1024}; pg8::Sched sc; sc.init(16, 4, G, bx, 2, 1024, 1024);
        EpiPart ec{(bf16_t*)(ws + O_XNP)};
        pg8::gemm_phase<EpiPart, false>(lds, gc, sc, ec);
    }
    }
    GRID_BAR();
    {
    phase_norm<0>(p.out, p.ctx, NTOK, p.norm_g + 1024, mods, 3, 4, XN, nullptr, (const bf16_t*)(ws + O_XNP), 4, mods + 4 * 6144 + 2 * 1024, hctx, G == 256 ? NLAT : 0);
    }
    GRID_BAR();
    {
    const int bx = obid();
    {
        pg8::Gemm g{XN, (const bf16_t*)(ws + O_WGU0), 1024, 1024, 1024}; pg8::Sched s; s.init(68, 22, G, bx, 0, 1024, 1024);
        EpiSwiglu e{ACT};
        pg8::gemm_phase(lds, g, s, e);
    }
    }
    GRID_BAR();
    {
    const int bx = obid();
    {
        pg8::Gemm g{ACT, (const bf16_t*)(ws + O_WD0), FF, FF, FF}; pg8::Sched s; s.init(64, 4, G, bx, 0, FF, FF);
        if (G == 256) { EpiResB e{(const bf16_t*)(ws + O_H1B), p.out, mods + 5 * 1024}; pg8::gemm_phase(lds, g, s, e); }
        else { EpiRes e{p.out, hctx, p.out, hctx, mods + 5 * 1024}; pg8::gemm_phase(lds, g, s, e); }
        pg8::Gemm gc{ACT + (size_t)NLAT * FF, (const bf16_t*)(ws + O_WD0), 256, FF, FF}; pg8::Sched sc; sc.init(16, 11, G, bx, 2, FF, FF);
        EpiPart ec{(bf16_t*)(ws + O_PART)};
        pg8::gemm_phase<EpiPart, false>(lds, gc, sc, ec);
    }
    }
    GRID_BAR();
    {
    phase_norm<1>(p.out, hctx, NTOK, p.norm_g + 2048, mods1, 0, 1, (bf16_t*)(ws + O_A2), nullptr, (const bf16_t*)(ws + O_PART), 11, mods + 4 * 6144 + 5 * 1024, nullptr);
    }
    GRID_BAR();
    {
    const int bx = obid();
    {
        pg8::Gemm g{(const bf16_t*)(ws + O_A2), (const bf16_t*)(ws + O_WST), 256, 512, 256}; pg8::Sched s; s.init(5, 64, G, bx, 1, 512, 256);
        EpiState e{(bf16_t*)(ws + O_S)};
        pg8::gemm_phase<EpiState, false>(lds, g, s, e);
    }
    }
    GRID_BAR();
    {
    phase_scan(p);
    }
    GRID_BAR();
    {
    const int bx = obid();
    {
        pg8::Gemm g{(const bf16_t*)(ws + O_A2), (const bf16_t*)(ws + O_TT), 512, 512, 512}; pg8::Sched s; s.init(4, 64, G, bx, 1, 512, 512);
        EpiSout e{(bf16_t*)(ws + O_GY)};
        pg8::gemm_phase(lds, g, s, e);
    }
    }
    GRID_BAR();
    {
    const int bx = obid();
    {
        pg8::Gemm g{(const bf16_t*)(ws + O_GY), (const bf16_t*)(ws + O_GLU), 1024, 1024, 1024};
        if (G == 256) {
            EpiGluNorm e{p.out, mods1 + 2 * 1024, p.norm_g + 3072, mods1, XN, (float*)(ws + O_S), (unsigned*)(ws + O_PCNT) + 16, bar + XB_TMO};
            pg8::Sched s; s.init(64, 8, G, bx, 4, 1024, 1024); s.nwg = 256;
            pg8::gemm_phase<EpiGluNorm, true>(lds, g, s, e);
            __syncthreads();
            pg8::Sched s2; s2.init(64, 8, G, bx, 4, 1024, 1024); s2.base = 256;
            pg8::gemm_phase<EpiGluNorm, true>(lds, g, s2, e);
        } else {
            pg8::Sched s; s.init(64, 8, G, bx, 0, 1024, 1024);
            EpiGlu e{p.out, mods1 + 2 * 1024};
            pg8::gemm_phase(lds, g, s, e);
        }
    }
    }
    GRID_BAR();
    if (G != 256) {
    phase_norm<0>(p.out, hctx, NLAT, p.norm_g + 3072, mods1, 3, 4, XN, nullptr);
    GRID_BAR();
    }
    {
    const int bx = obid();
    {
        pg8::Gemm g{XN, (const bf16_t*)(ws + O_WGU1), 1024, 1024, 1024}; pg8::Sched s; s.init(64, 22, G, bx, 0, 1024, 1024);
        EpiSwiglu e{ACT};
        pg8::gemm_phase(lds, g, s, e);
    }
    }
    GRID_BAR();
    {
    const int bx = obid();
    {
        pg8::Gemm g{ACT, (const bf16_t*)(ws + O_WD1), FF, FF, FF}; pg8::Sched s; s.init(64, 4, G, bx, 0, FF, FF);
        if (G == 256) {
            EpiResFinal e{p.out, p.out, mods1 + 5 * 1024, p.final_g, (float*)(ws + O_XSS), (unsigned*)(ws + O_PCNT), bar + XB_TMO};
            pg8::gemm_phase<EpiResFinal, true>(lds, g, s, e);
        } else {
            EpiRes e{p.out, hctx, p.out, hctx, mods1 + 5 * 1024};
            pg8::gemm_phase(lds, g, s, e);
        }
    }
    }
    if (G != 256) {
    GRID_BAR();
    phase_norm<2>(p.out, hctx, NLAT, p.final_g, nullptr, 0, 0, nullptr, p.out);
    }
}

extern "C" void kernel_launch(void* const* d_in, const int* in_sizes, int n_in, void* d_out, int out_size, void* d_ws, size_t ws_size, hipStream_t stream) {
    constexpr int kLds = pg8::STAGE_BYTES + 16;
    static int grid_blocks = 0;
    if (grid_blocks == 0) {
        if (n_in != 23 || ws_size < WS_NEED) { fprintf(stderr, "kernel_launch: unexpected n_in %d or workspace %zu < %zu\n", n_in, ws_size, (size_t)WS_NEED); grid_blocks = -1; return; }
        int dev = 0, cus = 0, per_cu = 0;
        hipGetDevice(&dev);
        hipDeviceGetAttribute(&cus, hipDeviceAttributeMultiprocessorCount, dev);
        hipFuncSetAttribute((const void*)fwd_megakernel, hipFuncAttributeMaxDynamicSharedMemorySize, kLds);
        hipOccupancyMaxActiveBlocksPerMultiprocessor(&per_cu, (const void*)fwd_megakernel, NT, kLds);
        if (per_cu < 1) { fprintf(stderr, "kernel_launch: occupancy query says %d blocks/CU\n", per_cu); per_cu = 1; }
        grid_blocks = cus;
        (void)hipGetLastError();
    }
    if (grid_blocks < 0) return;
    if (hipMemsetAsync((char*)d_ws + O_BAR, 0, 16384 + 64 * 256, stream) != hipSuccess) { fprintf(stderr, "kernel_launch: memset of barrier words failed\n"); return; }
    Params p{};
    p.x = (const float*)d_in[0]; p.c = (const float*)d_in[1]; p.ctx = (const float*)d_in[2]; p.c_ctx = (const float*)d_in[3];
    p.mod_w = (const float*)d_in[4]; p.mod_b = (const float*)d_in[5]; p.norm_g = (const float*)d_in[6];
    p.ffn_g = (const float*)d_in[7]; p.ffn_u = (const float*)d_in[8]; p.ffn_d = (const float*)d_in[9];
    p.w_in = (const float*)d_in[10]; p.w_out = (const float*)d_in[11]; p.sink = (const float*)d_in[12];
    p.a_re = (const float*)d_in[13]; p.a_im = (const float*)d_in[14]; p.log_dt = (const float*)d_in[15];
    p.b_re = (const float*)d_in[16]; p.b_im = (const float*)d_in[17]; p.c_re = (const float*)d_in[18]; p.c_im = (const float*)d_in[19];
    p.ssm_d = (const float*)d_in[20]; p.glu_w = (const float*)d_in[21]; p.final_g = (const float*)d_in[22];
    p.out = (float*)d_out; p.ws = (unsigned char*)d_ws;
    void* args[] = {&p};
    hipError_t e = hipLaunchCooperativeKernel((const void*)fwd_megakernel, dim3(grid_blocks), dim3(NT), args, kLds, stream);
    if (e != hipSuccess) fprintf(stderr, "cooperative launch failed: %s (grid %d)\n", hipGetErrorString(e), grid_blocks);
}
```

```cpp
#include <hip/hip_runtime.h>
#include <hip/hip_cooperative_groups.h>
#include <cstdio>
namespace cg = cooperative_groups;

#define LAS __attribute__((address_space(3)))
typedef unsigned short bf16_t;
typedef short bf16x8 __attribute__((ext_vector_type(8)));
typedef float f32x4 __attribute__((ext_vector_type(4)));
typedef float f32x16 __attribute__((ext_vector_type(16)));
typedef unsigned u32x4 __attribute__((ext_vector_type(4)));
typedef unsigned u32x2 __attribute__((ext_vector_type(2)));

constexpr int NT = 512;
constexpr int DM_ = 1024, SEQ_ = 4096, NB_ = 4, CTXL = 256, FF = 2816;
constexpr int NLAT = NB_ * SEQ_;
constexpr int NCTX = NB_ * CTXL;
constexpr int NTOK = NLAT + NCTX;
constexpr int GROWS = 1088;
constexpr int SROWS = 1280;

constexpr size_t MiB = 1u << 20;
constexpr size_t O_WINA = 0;
constexpr size_t O_WINB = O_WINA + 1280ull * 1024 * 2;
constexpr size_t O_WOUT = O_WINB + 768ull * 1024 * 2;
constexpr size_t O_WGU0 = O_WOUT + 1024ull * 1024 * 2;
constexpr size_t O_WD0 = O_WGU0 + 5632ull * 1024 * 2;
constexpr size_t O_WGU1 = O_WD0 + 1024ull * 2816 * 2;
constexpr size_t O_WD1 = O_WGU1 + 5632ull * 1024 * 2;
constexpr size_t O_GLU = O_WD1 + 1024ull * 2816 * 2;
constexpr size_t O_WST = O_GLU + 2048ull * 1024 * 2;
constexpr size_t O_TT = O_WST + 64ull * 256 * 256 * 2;
constexpr size_t O_MODS = O_TT + 64ull * 256 * 512 * 2;
constexpr size_t O_ROPE = O_MODS + 2ull * 5 * 6144 * 4;
constexpr size_t O_DC = O_ROPE + 2ull * 1024 * 4;
constexpr size_t O_HCTX = O_DC + 256ull * 512 * 2;
constexpr size_t O_VTC = O_HCTX + 1024ull * 1024 * 4;
constexpr size_t O_BAR = O_VTC + 4ull * 128 * 256 * 2;
constexpr size_t O_PCNT = O_BAR + 16384;
constexpr size_t O_D256 = O_PCNT + 64ull * 256;
constexpr size_t O_XSS = O_D256 + 512ull * 512 * 2;
constexpr size_t O_RA = 73 * MiB;
static_assert(O_XSS + 16384ull * 4 * 4 <= O_RA, "R_W overflow");
constexpr size_t O_XN = O_RA;
constexpr size_t O_MIX = O_RA + 34 * MiB;
constexpr size_t O_I2 = O_RA + 68 * MiB;
constexpr size_t O_XNP = O_I2;
constexpr size_t O_ZT = O_RA + 100 * MiB;
constexpr size_t O_ZTC = O_RA + 132 * MiB;
constexpr size_t O_Q = O_RA + 134 * MiB;
constexpr size_t O_K = O_RA + 151 * MiB;
constexpr size_t O_VT = O_K + 17408ull * 128 * 2;
constexpr size_t O_ACT = O_RA + 34 * MiB;
constexpr size_t O_A2 = O_RA;
constexpr size_t O_S = O_RA + 69 * MiB;
constexpr size_t O_GY = O_RA + 69 * MiB;
constexpr size_t O_XSS8 = O_RA + 102 * MiB;
constexpr size_t O_H1B = O_RA + 128 * MiB;
constexpr size_t O_PART = O_RA + 161 * MiB;
constexpr size_t WS_NEED = O_RA + 183 * MiB;
static_assert(WS_NEED <= 256 * MiB, "workspace budget");

struct Params {
    const float* x; const float* c; const float* ctx; const float* c_ctx; const float* mod_w; const float* mod_b; const float* norm_g;
    const float* ffn_g; const float* ffn_u; const float* ffn_d; const float* w_in; const float* w_out; const float* sink;
    const float* a_re; const float* a_im; const float* log_dt; const float* b_re; const float* b_im; const float* c_re; const float* c_im;
    const float* ssm_d; const float* glu_w; const float* final_g;
    float* out; unsigned char* ws;
};

__device__ __forceinline__ int otid() { int t = threadIdx.x; asm volatile("" : "+v"(t)); return t; }
__device__ __forceinline__ int obid() { int t = blockIdx.x; asm volatile("" : "+s"(t)); return t; }
__device__ __forceinline__ unsigned cvt_pk_bf16(float lo, float hi) { unsigned r; asm volatile("v_cvt_pk_bf16_f32 %0, %1, %2" : "=v"(r) : "v"(lo), "v"(hi)); return r; }
__device__ __forceinline__ bf16_t f2bf(float f) { unsigned u = __float_as_uint(f); u += 0x7FFFu + ((u >> 16) & 1u); return (bf16_t)(u >> 16); }
__device__ __forceinline__ float sigmoidf_(float v) { return __builtin_amdgcn_rcpf(1.0f + __builtin_amdgcn_exp2f(-1.4426950408889634f * v)); }
__device__ __forceinline__ float siluf_(float v) { return v * sigmoidf_(v); }
__device__ __forceinline__ float gelu_tanh(float v) { const float u = 0.7978845608028654f * (v + 0.044715f * v * v * v); return v * sigmoidf_(2.0f * u); }
__device__ __forceinline__ u32x4 pack8(const f32x4 a, const f32x4 b) { u32x4 w; w.x = cvt_pk_bf16(a[0], a[1]); w.y = cvt_pk_bf16(a[2], a[3]); w.z = cvt_pk_bf16(b[0], b[1]); w.w = cvt_pk_bf16(b[2], b[3]); return w; }

namespace pg8 {
constexpr int BM = 256, BK = 64, HALF = 128, HTB = HALF * BK * 2, STAGE_BYTES = 8 * HTB, NXCD = 8, WGM = 8;
__device__ __forceinline__ int lds_byte(int r, int c) { const int st = (r >> 4) * 2 + (c >> 5), rr = r & 15, cc = c & 31, ob = rr * 64 + cc * 2; return st * 1024 + (ob ^ (((ob >> 9) & 1) << 5)); }
__device__ __forceinline__ void stage_rc(int b, int& R, int& C) { const int st = b / 1024, sb = b % 1024, swz = sb ^ (((sb >> 9) & 1) << 5); R = (st >> 1) * 16 + swz / 64; C = (st & 1) * 32 + (swz % 64) / 2; }
__device__ __forceinline__ int perm32(int rho) { const int n = rho >> 4, i = rho & 15; return 8 * (i >> 2) + 4 * n + (i & 3); }

struct Unit { int arow, brow, pm, pn, kofs; size_t aoff, boff; };
struct Gemm { const bf16_t* A; const bf16_t* Bt; int K, lda, ldb; };

struct Sched {
    int nM, nN, nwg, G, c, mode, lda, ldb, base;
    __device__ void init(int nM_, int nN_, int G_, int c_, int mode_, int lda_, int ldb_) { nM = nM_; nN = nN_; nwg = nM_ * nN_; G = G_; c = c_; mode = mode_; lda = lda_; ldb = ldb_; base = 0; }
    __device__ bool next(int i, Unit& u) const {
        const long L = (long)base + (long)i * G + c; if (L >= nwg) return false;
        if (mode == 4) {
            { const int x = (int)L & 7, o = ((int)L & 255) >> 3; u.pm = ((int)L >> 8) * 32 + x * 4 + (o >> 3); u.pn = o & 7; }
            u.arow = u.pm * BM; u.brow = u.pn * BM; u.kofs = 0;
            u.aoff = (size_t)u.arow * lda; u.boff = (size_t)u.brow * ldb; return true;
        }
        if (mode == 0 || mode == 3) {
            int wgid = (int)L; { const int q = nwg / NXCD, r = nwg % NXCD, xcd = wgid % NXCD, off = wgid / NXCD; wgid = (xcd < r ? xcd * (q + 1) : r * (q + 1) + (xcd - r) * q) + off; }
            const int nig = WGM * nN, gid = wgid / nig, fm = gid * WGM, gsz = (nM - fm) < WGM ? (nM - fm) : WGM;
            u.pm = fm + ((wgid % nig) % gsz); u.pn = (wgid % nig) / gsz; u.arow = u.pm * BM; u.brow = u.pn * BM; u.kofs = 0;
        } else if (mode == 1) {
            const int g = (int)L / nM, mi = (int)L % nM; u.pm = mi; u.pn = g; u.arow = g * GROWS + mi * BM; u.brow = g * BM; u.kofs = 0;
        } else {
            const int tile = (int)L % nM, ks = (int)L / nM; u.pm = tile >> 2; u.pn = tile & 3; u.arow = u.pm * BM; u.brow = u.pn * BM; u.kofs = ks * 256;
        }
        u.aoff = (size_t)u.arow * lda + u.kofs;
        u.boff = (mode == 3) ? (size_t)((u.pn >> 4) * 4096 + (u.pn & 15)) * 1024 : (size_t)u.brow * ldb + u.kofs;
        return true;
    }
};

template <class T, class = void> struct epi_after_drain { static constexpr bool value = false; };
template <class T> struct epi_after_drain<T, decltype((void)T::AFTER_DRAIN)> { static constexpr bool value = T::AFTER_DRAIN; };
#ifndef GP_ALIGN
#define GP_ALIGN true
#endif
#ifndef GP_SP2
#define GP_SP2 true
#endif
template <class Epi, bool ALIGN_EPI = GP_ALIGN, bool SP2 = GP_SP2>
__device__ __forceinline__ void gemm_phase(LAS unsigned char* lds, const Gemm g, const Sched& S, const Epi& E) {
    const int tid = otid(), wid = __builtin_amdgcn_readfirstlane(tid >> 6), lane = tid & 63, wr = wid >> 2, wc = wid & 3, fr = lane & 15, fq = lane >> 4;
    const int K = g.K, nt = K / BK;
    unsigned voffA[2], voffB[2];
#pragma unroll
    for (int i = 0; i < 2; ++i) { int R, C; stage_rc(tid * 16 + i * 8192, R, C); const int Rb = (R & ~31) + perm32(R & 31);
        voffA[i] = (unsigned)(R * g.lda + C) * 2u; voffB[i] = (unsigned)(Rb * g.ldb + C) * 2u; }
    const size_t kstep = (size_t)(BK * 2);
    const size_t hstepA = (size_t)HALF * g.lda * 2, hstepB = (size_t)HALF * g.ldb * 2;
    const unsigned ldsw = (unsigned)wid * 1024u;
    const int aoff = lds_byte(wr * 64 + fr, fq * 8), boff = lds_byte(wc * 32 + fr, fq * 8);
#define PG8_SA(b, h) (((b) * 2 + (h)) * HTB)
#define PG8_SB(b, h) ((4 + (b) * 2 + (h)) * HTB)
#define PG8_STAGE(bufoff, gbase, voff) do { _Pragma("unroll") for (int _i = 0; _i < 2; ++_i) \
        __builtin_amdgcn_global_load_lds((const unsigned*)((const char*)(gbase) + (voff)[_i]), (LAS unsigned*)(lds + (bufoff) + ldsw + _i * 8192), 16, 0, 0); } while (0)
#define PG8_LDA(dst, b, h) do { _Pragma("unroll") for (int m = 0; m < 4; ++m) _Pragma("unroll") for (int k = 0; k < 2; ++k) dst[m][k] = *(const LAS bf16x8*)(lds + PG8_SA(b, h) + aoff + m * 2048 + k * 1024); } while (0)
#define PG8_LDB(dst, b, h) do { _Pragma("unroll") for (int n = 0; n < 2; ++n) _Pragma("unroll") for (int k = 0; k < 2; ++k) dst[n][k] = *(const LAS bf16x8*)(lds + PG8_SB(b, h) + boff + n * 2048 + k * 1024); } while (0)
#define PG8_MMA(ai, bj, At, Bt) do { __builtin_amdgcn_s_setprio(1); _Pragma("unroll") for (int m = 0; m < 4; ++m) _Pragma("unroll") for (int n = 0; n < 2; ++n) _Pragma("unroll") for (int k = 0; k < 2; ++k) \
        acc[ai][bj][m][n] = __builtin_amdgcn_mfma_f32_16x16x32_bf16(Bt[n][k], At[m][k], acc[ai][bj][m][n], 0, 0, 0); __builtin_amdgcn_s_setprio(0); } while (0)
#define PG8_WAIT_V(n) asm volatile("s_waitcnt vmcnt(" #n ")" ::: "memory")
#define PG8_WAIT_L(n) asm volatile("s_waitcnt lgkmcnt(" #n ")" ::: "memory")
#define PG8_BAR __builtin_amdgcn_s_barrier()
#define PG8_SCHED __builtin_amdgcn_sched_barrier(0)
    Unit cur, nxt; int ui = 0;
    if (!S.next(0, cur)) return;
    f32x4 acc[2][2][4][2];
#pragma unroll
    for (int a = 0; a < 2; ++a)
#pragma unroll
        for (int b = 0; b < 2; ++b)
#pragma unroll
            for (int m = 0; m < 4; ++m)
#pragma unroll
                for (int n = 0; n < 2; ++n) acc[a][b][m][n] = (f32x4){0.f, 0.f, 0.f, 0.f};
    bf16x8 At[4][2], B0[2][2], B1[2][2];
    const char* cA = (const char*)g.A + cur.aoff * 2; const char* cB = (const char*)g.Bt + cur.boff * 2;
    if constexpr (SP2) {
        PG8_STAGE(PG8_SB(0, 0), cB, voffB); PG8_STAGE(PG8_SB(0, 1), cB + hstepB, voffB); PG8_STAGE(PG8_SA(0, 0), cA, voffA); PG8_STAGE(PG8_SA(0, 1), cA + hstepA, voffA);
        if (wr == 1) PG8_BAR;
        PG8_WAIT_V(2); PG8_BAR;
        PG8_STAGE(PG8_SB(1, 0), cB + kstep, voffB); PG8_STAGE(PG8_SA(1, 0), cA + kstep, voffA); PG8_STAGE(PG8_SB(1, 1), cB + hstepB + kstep, voffB);
        PG8_WAIT_V(6); PG8_BAR;
    } else {
        PG8_STAGE(PG8_SB(0, 0), cB, voffB); PG8_STAGE(PG8_SA(0, 0), cA, voffA); PG8_STAGE(PG8_SB(0, 1), cB + hstepB, voffB); PG8_STAGE(PG8_SA(0, 1), cA + hstepA, voffA);
        if (wr == 1) PG8_BAR;
        PG8_WAIT_V(4); PG8_BAR;
        PG8_STAGE(PG8_SB(1, 0), cB + kstep, voffB); PG8_STAGE(PG8_SA(1, 0), cA + kstep, voffA); PG8_STAGE(PG8_SB(1, 1), cB + hstepB + kstep, voffB);
        PG8_WAIT_V(6); PG8_BAR;
    }
    for (;;) {
        const bool has_next = S.next(ui + 1, nxt);
        const char* nA = has_next ? (const char*)g.A + nxt.aoff * 2 : cA; const char* nB = has_next ? (const char*)g.Bt + nxt.boff * 2 : cB;
        for (int t = 0; t < nt; t += 2) {
            const bool last = (t == nt - 2);
            const char* a1 = cA + (size_t)(t + 1) * kstep;
            const char* a2 = last ? nA : cA + (size_t)(t + 2) * kstep; const char* b2 = last ? nB : cB + (size_t)(t + 2) * kstep;
            const char* a3 = a2 + kstep; const char* b3 = b2 + kstep;
            if constexpr (SP2) {
            PG8_LDB(B0, 0, 0); PG8_LDB(B1, 0, 1); PG8_SCHED; PG8_LDA(At, 0, 0); PG8_STAGE(PG8_SA(1, 1), a1 + hstepA, voffA);
            PG8_WAIT_V(8); PG8_WAIT_L(0); PG8_BAR; PG8_MMA(0, 0, At, B0); PG8_MMA(0, 1, At, B1); PG8_BAR; PG8_SCHED;
            PG8_LDA(At, 0, 1); PG8_STAGE(PG8_SB(0, 0), b2, voffB); PG8_STAGE(PG8_SB(0, 1), b2 + hstepB, voffB); PG8_STAGE(PG8_SA(0, 0), a2, voffA);
            PG8_WAIT_V(8); PG8_WAIT_L(0); PG8_BAR; PG8_MMA(1, 0, At, B0); PG8_MMA(1, 1, At, B1); PG8_BAR; PG8_SCHED;
            PG8_LDB(B0, 1, 0); PG8_LDB(B1, 1, 1); PG8_SCHED; PG8_LDA(At, 1, 0); PG8_STAGE(PG8_SA(0, 1), a2 + hstepA, voffA);
            PG8_WAIT_V(8); PG8_WAIT_L(0); PG8_BAR; PG8_MMA(0, 0, At, B0); PG8_MMA(0, 1, At, B1); PG8_BAR; PG8_SCHED;
            PG8_LDA(At, 1, 1); PG8_STAGE(PG8_SB(1, 0), b3, voffB); PG8_STAGE(PG8_SB(1, 1), b3 + hstepB, voffB); PG8_STAGE(PG8_SA(1, 0), a3, voffA);
            PG8_WAIT_V(8); PG8_WAIT_L(0); PG8_BAR; PG8_MMA(1, 0, At, B0); PG8_MMA(1, 1, At, B1); PG8_BAR; PG8_SCHED;
            } else {
            PG8_LDB(B0, 0, 0); PG8_SCHED; PG8_LDA(At, 0, 0); PG8_STAGE(PG8_SA(1, 1), a1 + hstepA, voffA);
            PG8_WAIT_L(8); PG8_BAR; PG8_WAIT_L(0); PG8_MMA(0, 0, At, B0); PG8_BAR; PG8_SCHED;
            PG8_LDB(B1, 0, 1); PG8_STAGE(PG8_SB(0, 0), b2, voffB);
            PG8_BAR; PG8_WAIT_L(0); PG8_MMA(0, 1, At, B1); PG8_BAR;
            PG8_LDA(At, 0, 1); PG8_STAGE(PG8_SA(0, 0), a2, voffA);
            PG8_BAR; PG8_WAIT_L(0); PG8_MMA(1, 0, At, B0); PG8_BAR; PG8_SCHED;
            PG8_STAGE(PG8_SB(0, 1), b2 + hstepB, voffB);
            PG8_WAIT_V(6); PG8_BAR; PG8_MMA(1, 1, At, B1); PG8_BAR;
            PG8_LDB(B0, 1, 0); PG8_SCHED; PG8_LDA(At, 1, 0); PG8_STAGE(PG8_SA(0, 1), a2 + hstepA, voffA);
            PG8_WAIT_L(8); PG8_BAR; PG8_WAIT_L(0); PG8_MMA(0, 0, At, B0); PG8_BAR; PG8_SCHED;
            PG8_LDB(B1, 1, 1); PG8_STAGE(PG8_SB(1, 0), b3, voffB);
            PG8_BAR; PG8_WAIT_L(0); PG8_MMA(0, 1, At, B1); PG8_BAR;
            PG8_LDA(At, 1, 1); PG8_STAGE(PG8_SA(1, 0), a3, voffA);
            PG8_BAR; PG8_WAIT_L(0); PG8_MMA(1, 0, At, B0); PG8_BAR; PG8_SCHED;
            PG8_STAGE(PG8_SB(1, 1), b3 + hstepB, voffB);
            PG8_WAIT_V(6); PG8_BAR; PG8_MMA(1, 1, At, B1); PG8_BAR;
                    }
        }
        if constexpr (ALIGN_EPI) { if (wr == 0) PG8_BAR; }
        if constexpr (!epi_after_drain<Epi>::value) E(acc, cur, wr, wc, fr, fq);
        if (!has_next) break;
#pragma unroll
        for (int a = 0; a < 2; ++a)
#pragma unroll
            for (int b = 0; b < 2; ++b)
#pragma unroll
                for (int m = 0; m < 4; ++m)
#pragma unroll
                    for (int n = 0; n < 2; ++n) acc[a][b][m][n] = (f32x4){0.f, 0.f, 0.f, 0.f};
        cur = nxt; cA = nA; cB = nB; ++ui;
        if constexpr (ALIGN_EPI) { if (wr == 1) PG8_BAR; }
    }
    PG8_WAIT_V(0);
    if constexpr (!ALIGN_EPI) { if (wr == 0) PG8_BAR; }
    PG8_BAR;
    if constexpr (epi_after_drain<Epi>::value) E.fused(acc, cur, wr, wc, fr, fq, lds, wid, lane);
#undef PG8_SA
#undef PG8_SB
#undef PG8_STAGE
#undef PG8_LDA
#undef PG8_LDB
#undef PG8_MMA
#undef PG8_WAIT_V
#undef PG8_WAIT_L
#undef PG8_BAR
#undef PG8_SCHED
}
}
using pg8::Unit;
typedef f32x4 Acc[2][2][4][2];

struct EpiInA {
    bf16_t *ZT, *ZTc; int tk0, perm;
    __device__ __forceinline__ void operator()(const Acc& acc, const Unit& u, int wr, int wc, int fr, int fq) const {
#pragma unroll
        for (int ai = 0; ai < 2; ++ai)
#pragma unroll
            for (int m = 0; m < 4; ++m) {
                const int r = u.arow + ai * 128 + wr * 64 + m * 16 + fr;
                const int c = r & 511, cs = r >> 9;
#pragma unroll
                for (int bj = 0; bj < 2; ++bj) {
                    const int tk = tk0 + u.brow + bj * 128 + wc * 32 + fq * 8;
                    bf16_t* dst;
                    if (perm) { const int b = tk >> 12, rr = (tk >> 8) & 15, tp = tk & 255; dst = ZT + ((size_t)((b * 512 + c) * 16 + rr) * 512 + cs * 256 + tp); }
                    else { const int b = (tk - NLAT) >> 8, t = tk & 255; dst = ZTc + ((size_t)(b * 512 + c) * 512 + cs * 256 + t); }
                    *(u32x4*)dst = pack8(acc[ai][bj][m][0], acc[ai][bj][m][1]);
                }
            }
    }
};
struct EpiInB {
    bf16_t *Q, *Kb; const float *ropeC, *ropeS; bf16_t *VT, *VTc;
    __device__ __forceinline__ void operator()(const Acc& acc, const Unit& u, int wr, int wc, int fr, int fq) const {
#pragma unroll
        for (int ai = 0; ai < 2; ++ai)
#pragma unroll
            for (int m = 0; m < 4; ++m) {
                const int tok = u.arow + ai * 128 + wr * 64 + m * 16 + fr;
                const bool lat = tok < NLAT; const int pos = tok & 4095, prow = pos >> 6, pcol = pos & 63;
#pragma unroll
                for (int bj = 0; bj < 2; ++bj) {
                    const int col = u.brow + bj * 128 + wc * 32 + fq * 8;
                    f32x4 v0 = acc[ai][bj][m][0], v1 = acc[ai][bj][m][1];
                    if (col >= 640) {
                        const int dv = col - 640, kvh = dv >> 6, d = dv & 63, dt = d >> 5, rl0 = d & 31;
                        int b, t; if (lat) { b = tok >> 12; t = tok & 4095; } else { b = (tok - NLAT) >> 8; t = tok & 255; }
                        const int tile = t >> 5, s = (t >> 4) & 1, k16 = t & 15, hh = (k16 >> 2) & 1, j = ((k16 >> 3) << 2) | (k16 & 3);
                        bf16_t* vb = (lat ? VT + (size_t)((b * 2 + kvh) * 128 + tile) * 2048 : VTc + (size_t)((b * 2 + kvh) * 8 + tile) * 2048) + (dt * 2 + s) * 512 + (hh * 32 + rl0) * 8 + j;
                        const u32x4 w = pack8(v0, v1);
                        vb[0] = (bf16_t)(w.x & 0xFFFFu); vb[8] = (bf16_t)(w.x >> 16); vb[16] = (bf16_t)(w.y & 0xFFFFu); vb[24] = (bf16_t)(w.y >> 16);
                        vb[32] = (bf16_t)(w.z & 0xFFFFu); vb[40] = (bf16_t)(w.z >> 16); vb[48] = (bf16_t)(w.w & 0xFFFFu); vb[56] = (bf16_t)(w.w >> 16);
                        continue;
                    }
                    if (lat) {
                        const int i0 = (col & 63) >> 1, pp = (i0 < 16) ? prow : pcol, f0 = i0 & 15;
                        const f32x4 cs = *(const f32x4*)(ropeC + pp * 16 + f0), sn = *(const f32x4*)(ropeS + pp * 16 + f0);
                        f32x4 w0, w1;
                        w0[0] = v0[0] * cs[0] - v0[1] * sn[0]; w0[1] = v0[0] * sn[0] + v0[1] * cs[0];
                        w0[2] = v0[2] * cs[1] - v0[3] * sn[1]; w0[3] = v0[2] * sn[1] + v0[3] * cs[1];
                        w1[0] = v1[0] * cs[2] - v1[1] * sn[2]; w1[1] = v1[0] * sn[2] + v1[1] * cs[2];
                        w1[2] = v1[2] * cs[3] - v1[3] * sn[3]; w1[3] = v1[2] * sn[3] + v1[3] * cs[3];
                        v0 = w0; v1 = w1;
                    }
                    bf16_t* dst = (col < 512) ? Q + (size_t)tok * 512 + col : Kb + (size_t)tok * 128 + (col - 512);
                    *(u32x4*)dst = pack8(v0, v1);
                }
            }
    }
};
struct EpiDft {
    bf16_t* MIX; int isctx;
    __device__ __forceinline__ void operator()(const Acc& acc, const Unit& u, int wr, int wc, int fr, int fq) const {
#pragma unroll
        for (int ai = 0; ai < 2; ++ai)
#pragma unroll
            for (int m = 0; m < 4; ++m) {
                const int k = u.arow + ai * 128 + wr * 64 + m * 16 + fr;
#pragma unroll
                for (int bj = 0; bj < 2; ++bj) {
                    const int col = u.brow + bj * 128 + wc * 32 + fq * 8; const int b = col >> 9, c = col & 511;
                    const size_t trow = isctx ? (size_t)(NLAT + b * 256 + k) : (size_t)(b * 4096 + k);
                    *(u32x4*)(MIX + trow * 1024 + c) = pack8(acc[ai][bj][m][0], acc[ai][bj][m][1]);
                }
            }
    }
};
struct EpiI2 {
    bf16_t* I2;
    __device__ __forceinline__ void operator()(const Acc& acc, const Unit& u, int wr, int wc, int fr, int fq) const {
#pragma unroll
        for (int ai = 0; ai < 2; ++ai)
#pragma unroll
            for (int m = 0; m < 4; ++m) {
                const int row = u.arow + ai * 128 + wr * 64 + m * 16 + fr;
#pragma unroll
                for (int bj = 0; bj < 2; ++bj) {
                    const int col = u.brow + bj * 128 + wc * 32 + fq * 8;
                    *(u32x4*)(I2 + (size_t)row * 32768 + col) = pack8(acc[ai][bj][m][0], acc[ai][bj][m][1]);
                }
            }
    }
};
struct EpiRes {
    const float *in_lat, *in_ctx; float *out_lat, *out_ctx; const float* gate;
    __device__ __forceinline__ void operator()(const Acc& acc, const Unit& u, int wr, int wc, int fr, int fq) const {
        const int row0 = u.arow + wr * 64 + fr, col0 = u.brow + wc * 32 + fq * 8;
        const bool lat = row0 < NLAT;
        const int b = lat ? (row0 >> 12) : 4;
        const float* ip = lat ? in_lat + (size_t)row0 * 1024 + col0 : in_ctx + (size_t)(row0 - NLAT) * 1024 + col0;
        float* op = lat ? out_lat + (size_t)row0 * 1024 + col0 : out_ctx + (size_t)(row0 - NLAT) * 1024 + col0;
        const float* gp = gate + b * 6144 + col0;
        f32x4 gv[2][2];
#pragma unroll
        for (int bj = 0; bj < 2; ++bj)
#pragma unroll
            for (int n = 0; n < 2; ++n) gv[bj][n] = *(const f32x4*)(gp + bj * 128 + 4 * n);
#pragma unroll
        for (int ai = 0; ai < 2; ++ai)
#pragma unroll
            for (int mh = 0; mh < 2; ++mh) {
                f32x4 hv[2][2][2];
#pragma unroll
                for (int mm = 0; mm < 2; ++mm)
#pragma unroll
                    for (int bj = 0; bj < 2; ++bj)
#pragma unroll
                        for (int n = 0; n < 2; ++n) hv[mm][bj][n] = *(const f32x4*)(ip + (size_t)(ai * 128 + (mh * 2 + mm) * 16) * 1024 + bj * 128 + 4 * n);
#pragma unroll
                for (int mm = 0; mm < 2; ++mm)
#pragma unroll
                    for (int bj = 0; bj < 2; ++bj)
#pragma unroll
                        for (int n = 0; n < 2; ++n) *(f32x4*)(op + (size_t)(ai * 128 + (mh * 2 + mm) * 16) * 1024 + bj * 128 + 4 * n) = hv[mm][bj][n] + gv[bj][n] * acc[ai][bj][mh * 2 + mm][n];
            }
    }
};
struct EpiResFinal {
    static constexpr bool AFTER_DRAIN = true;
    const float* H; float* out; const float* gate; const float* fg; float* xss; unsigned* pcnt; unsigned* tmo;
    __device__ __forceinline__ void fused(Acc& acc, const Unit& u, int wr, int wc, int fr, int fq, LAS unsigned char* lds, int wid, int lane) const {
        LAS float* P = (LAS float*)lds;
        LAS float* S = (LAS float*)(lds + 8192);
        const int row0 = u.arow + wr * 64 + fr, col0 = u.brow + wc * 32 + fq * 8;
        const float* ip = H + (size_t)row0 * 1024 + col0; float* op = out + (size_t)row0 * 1024 + col0;
        const float* gp = gate + (row0 >> 12) * 6144 + col0;
        f32x4 gv[2][2];
#pragma unroll
        for (int bj = 0; bj < 2; ++bj)
#pragma unroll
            for (int n = 0; n < 2; ++n) gv[bj][n] = *(const f32x4*)(gp + bj * 128 + 4 * n);
#pragma unroll
        for (int ai = 0; ai < 2; ++ai)
#pragma unroll
            for (int m = 0; m < 4; ++m) {
                float s = 0.f;
#pragma unroll
                for (int bj = 0; bj < 2; ++bj)
#pragma unroll
                    for (int n = 0; n < 2; ++n) {
                        const f32x4 hv = *(const f32x4*)(ip + (size_t)(ai * 128 + m * 16) * 1024 + bj * 128 + 4 * n);
                        const f32x4 h = hv + gv[bj][n] * acc[ai][bj][m][n]; acc[ai][bj][m][n] = h;
                        s += (h[0] * h[0] + h[1] * h[1]) + (h[2] * h[2] + h[3] * h[3]);
                    }
                s += __shfl_xor(s, 16); s += __shfl_xor(s, 32);
                if (fq == 0) P[(ai * 128 + wr * 64 + m * 16 + fr) * 4 + wc] = s;
            }
        asm volatile("s_waitcnt lgkmcnt(0)" ::: "memory"); __builtin_amdgcn_s_barrier(); asm volatile("" ::: "memory");
        const int row = wid * 32 + (lane & 31);
        if (lane < 32) {
            const float t = (P[row * 4 + 0] + P[row * 4 + 1]) + (P[row * 4 + 2] + P[row * 4 + 3]);
            __hip_atomic_store((unsigned*)xss + ((size_t)(u.arow + row) * 4 + u.pn), __float_as_uint(t), __ATOMIC_RELAXED, __HIP_MEMORY_SCOPE_AGENT);
        }
        asm volatile("s_waitcnt vmcnt(0)" ::: "memory");
        if (lane == 0) __hip_atomic_fetch_add(pcnt + 64 * u.pm, 1u, __ATOMIC_RELAXED, __HIP_MEMORY_SCOPE_AGENT);
        if (wid == 0) {
            unsigned sp = 0;
            while ((unsigned)__builtin_amdgcn_readfirstlane(__hip_atomic_load(pcnt + 64 * u.pm, __ATOMIC_RELAXED, __HIP_MEMORY_SCOPE_AGENT)) < 32u) {
                __builtin_amdgcn_s_sleep(2);
                if ((++sp & 1023u) == 0u) { if (__hip_atomic_load(tmo, __ATOMIC_RELAXED, __HIP_MEMORY_SCOPE_AGENT) != 0u) break; if (sp > (1u << 22)) { if (lane == 0) atomicAdd(tmo, 1u); break; } }
            }
            __builtin_amdgcn_fence(__ATOMIC_ACQUIRE, "agent");
        }
        asm volatile("s_waitcnt vmcnt(0) lgkmcnt(0)" ::: "memory"); __builtin_amdgcn_s_barrier(); asm volatile("" ::: "memory");
        if (lane < 32) {
            const unsigned* slot = (const unsigned*)xss + (size_t)(u.arow + row) * 4; float t = 0.f;
#pragma unroll
            for (int q = 0; q < 4; ++q) t += __uint_as_float(__hip_atomic_load(slot + q, __ATOMIC_RELAXED, __HIP_MEMORY_SCOPE_AGENT));
            S[row] = rsqrtf(t * (1.0f / 1024.0f) + 1e-6f);
        }
        asm volatile("s_waitcnt lgkmcnt(0)" ::: "memory"); __builtin_amdgcn_s_barrier(); asm volatile("" ::: "memory");
        f32x4 fv[2][2];
#pragma unroll
        for (int bj = 0; bj < 2; ++bj)
#pragma unroll
            for (int n = 0; n < 2; ++n) fv[bj][n] = *(const f32x4*)(fg + col0 + bj * 128 + 4 * n);
#pragma unroll
        for (int ai = 0; ai < 2; ++ai)
#pragma unroll
            for (int m = 0; m < 4; ++m) {
                const float rinv = S[ai * 128 + wr * 64 + m * 16 + fr];
#pragma unroll
                for (int bj = 0; bj < 2; ++bj)
#pragma unroll
                    for (int n = 0; n < 2; ++n) *(f32x4*)(op + (size_t)(ai * 128 + m * 16) * 1024 + bj * 128 + 4 * n) = acc[ai][bj][m][n] * rinv * fv[bj][n];
            }
    }
};
struct EpiResNorm {
    static constexpr bool AFTER_DRAIN = true;
    const float* X; bf16_t* Hb; const float* gate; const float* ng; const float* mods_l; bf16_t* XNo; float* xss; unsigned* pcnt; unsigned* tmo;
    __device__ __forceinline__ void fused(Acc& acc, const Unit& u, int wr, int wc, int fr, int fq, LAS unsigned char* lds, int wid, int lane) const {
        LAS float* P = (LAS float*)lds; LAS float* S = (LAS float*)(lds + 8192);
        const int row0 = u.arow + wr * 64 + fr, col0 = u.brow + wc * 32 + fq * 8, b = row0 >> 12;
        const float* ip = X + (size_t)row0 * 1024 + col0; bf16_t* op = Hb + (size_t)row0 * 1024 + col0;
        {
            const float* gp = gate + b * 6144 + col0; f32x4 gv[2][2];
#pragma unroll
            for (int bj = 0; bj < 2; ++bj)
#pragma unroll
                for (int n = 0; n < 2; ++n) gv[bj][n] = *(const f32x4*)(gp + bj * 128 + 4 * n);
#pragma unroll
            for (int ai = 0; ai < 2; ++ai)
#pragma unroll
                for (int m = 0; m < 4; ++m) {
                    float s = 0.f;
#pragma unroll
                    for (int bj = 0; bj < 2; ++bj)
#pragma unroll
                        for (int n = 0; n < 2; ++n) {
                            const f32x4 hv = *(const f32x4*)(ip + (size_t)(ai * 128 + m * 16) * 1024 + bj * 128 + 4 * n);
                            const f32x4 h = hv + gv[bj][n] * acc[ai][bj][m][n]; acc[ai][bj][m][n] = h;
                            s += (h[0] * h[0] + h[1] * h[1]) + (h[2] * h[2] + h[3] * h[3]);
                        }
#pragma unroll
                    for (int bj = 0; bj < 2; ++bj) *(u32x4*)(op + (size_t)(ai * 128 + m * 16) * 1024 + bj * 128) = pack8(acc[ai][bj][m][0], acc[ai][bj][m][1]);
                    s += __shfl_xor(s, 16); s += __shfl_xor(s, 32);
                    if (fq == 0) P[(ai * 128 + wr * 64 + m * 16 + fr) * 4 + wc] = s;
                }
        }
        asm volatile("s_waitcnt lgkmcnt(0)" ::: "memory"); __builtin_amdgcn_s_barrier(); asm volatile("" ::: "memory");
        const int row = wid * 32 + (lane & 31);
        if (lane < 32) {
            const float t = (P[row * 4 + 0] + P[row * 4 + 1]) + (P[row * 4 + 2] + P[row * 4 + 3]);
            __hip_atomic_store((unsigned*)xss + ((size_t)(u.arow + row) * 4 + u.pn), __float_as_uint(t), __ATOMIC_RELAXED, __HIP_MEMORY_SCOPE_AGENT);
        }
        asm volatile("s_waitcnt vmcnt(0)" ::: "memory");
        if (lane == 0) __hip_atomic_fetch_add(pcnt + 64 * u.pm, 1u, __ATOMIC_RELAXED, __HIP_MEMORY_SCOPE_AGENT);
        if (wid == 0) {
            unsigned sp = 0;
            while ((unsigned)__builtin_amdgcn_readfirstlane(__hip_atomic_load(pcnt + 64 * u.pm, __ATOMIC_RELAXED, __HIP_MEMORY_SCOPE_AGENT)) < 32u) {
                __builtin_amdgcn_s_sleep(2);
                if ((++sp & 1023u) == 0u) { if (__hip_atomic_load(tmo, __ATOMIC_RELAXED, __HIP_MEMORY_SCOPE_AGENT) != 0u) break; if (sp > (1u << 22)) { if (lane == 0) atomicAdd(tmo, 1u); break; } }
            }
            __builtin_amdgcn_fence(__ATOMIC_ACQUIRE, "agent");
        }
        asm volatile("s_waitcnt vmcnt(0) lgkmcnt(0)" ::: "memory"); __builtin_amdgcn_s_barrier(); asm volatile("" ::: "memory");
        if (lane < 32) {
            const unsigned* slot = (const unsigned*)xss + (size_t)(u.arow + row) * 4; float t = 0.f;
#pragma unroll
            for (int q = 0; q < 4; ++q) t += __uint_as_float(__hip_atomic_load(slot + q, __ATOMIC_RELAXED, __HIP_MEMORY_SCOPE_AGENT));
            S[row] = rsqrtf(t * (1.0f / 1024.0f) + 1e-6f);
        }
        asm volatile("s_waitcnt lgkmcnt(0)" ::: "memory"); __builtin_amdgcn_s_barrier(); asm volatile("" ::: "memory");
        bf16_t* xp = XNo + (size_t)row0 * 1024 + col0;
#pragma unroll
        for (int bj = 0; bj < 2; ++bj) {
            f32x4 mv[2], sv[2];
#pragma unroll
            for (int n = 0; n < 2; ++n) { const int c = col0 + bj * 128 + 4 * n; const f32x4 g4 = *(const f32x4*)(ng + c), s4 = *(const f32x4*)(mods_l + (size_t)b * 6144 + 4 * 1024 + c); sv[n] = *(const f32x4*)(mods_l + (size_t)b * 6144 + 3 * 1024 + c);
#pragma unroll
                for (int j = 0; j < 4; ++j) mv[n][j] = g4[j] * (1.0f + s4[j]); }
#pragma unroll
            for (int ai = 0; ai < 2; ++ai)
#pragma unroll
                for (int m = 0; m < 4; ++m) {
                    const float rinv = S[ai * 128 + wr * 64 + m * 16 + fr];
                    const f32x4 y0 = acc[ai][bj][m][0] * rinv * mv[0] + sv[0], y1 = acc[ai][bj][m][1] * rinv * mv[1] + sv[1];
                    *(u32x4*)(xp + (size_t)(ai * 128 + m * 16) * 1024 + bj * 128) = pack8(y0, y1);
                }
        }
    }
};
struct EpiResB {
    const bf16_t* Hb; float* out; const float* gate;
    __device__ __forceinline__ void operator()(const Acc& acc, const Unit& u, int wr, int wc, int fr, int fq) const {
        const int row0 = u.arow + wr * 64 + fr, col0 = u.brow + wc * 32 + fq * 8, b = row0 >> 12;
        const bf16_t* ip = Hb + (size_t)row0 * 1024 + col0; float* op = out + (size_t)row0 * 1024 + col0;
        const float* gp = gate + b * 6144 + col0;
        f32x4 gv[2][2];
#pragma unroll
        for (int bj = 0; bj < 2; ++bj)
#pragma unroll
            for (int n = 0; n < 2; ++n) gv[bj][n] = *(const f32x4*)(gp + bj * 128 + 4 * n);
#pragma unroll
        for (int ai = 0; ai < 2; ++ai) {
            u32x4 hw[4][2];
#pragma unroll
            for (int m = 0; m < 4; ++m)
#pragma unroll
                for (int bj = 0; bj < 2; ++bj) hw[m][bj] = *(const u32x4*)(ip + (size_t)(ai * 128 + m * 16) * 1024 + bj * 128);
#pragma unroll
            for (int m = 0; m < 4; ++m)
#pragma unroll
                for (int bj = 0; bj < 2; ++bj) {
                    const u32x4 w = hw[m][bj];
                    const f32x4 h0 = {__uint_as_float(w.x << 16), __uint_as_float(w.x & 0xFFFF0000u), __uint_as_float(w.y << 16), __uint_as_float(w.y & 0xFFFF0000u)};
                    const f32x4 h1 = {__uint_as_float(w.z << 16), __uint_as_float(w.z & 0xFFFF0000u), __uint_as_float(w.w << 16), __uint_as_float(w.w & 0xFFFF0000u)};
                    const f32x4 o0 = h0 + gv[bj][0] * acc[ai][bj][m][0], o1 = h1 + gv[bj][1] * acc[ai][bj][m][1];
                    if (out) { float* q = op + (size_t)(ai * 128 + m * 16) * 1024 + bj * 128; *(f32x4*)q = o0; *(f32x4*)(q + 4) = o1; }
                    else *(u32x4*)(const_cast<bf16_t*>(ip) + (size_t)(ai * 128 + m * 16) * 1024 + bj * 128) = pack8(o0, o1);
                }
        }
    }
};
struct EpiPart {
    bf16_t* slab;
    __device__ __forceinline__ void operator()(const Acc& acc, const Unit& u, int wr, int wc, int fr, int fq) const {
        bf16_t* base = slab + (size_t)(u.kofs >> 8) * 1024 * 1024;
#pragma unroll
        for (int ai = 0; ai < 2; ++ai)
#pragma unroll
            for (int m = 0; m < 4; ++m) {
                const int row = u.arow + ai * 128 + wr * 64 + m * 16 + fr;
                bf16_t* op = base + (size_t)row * 1024;
#pragma unroll
                for (int bj = 0; bj < 2; ++bj) *(u32x4*)(op + u.brow + bj * 128 + wc * 32 + fq * 8) = pack8(acc[ai][bj][m][0], acc[ai][bj][m][1]);
            }
    }
};
struct EpiSwiglu {
    bf16_t* ACT;
    __device__ __forceinline__ void operator()(const Acc& acc, const Unit& u, int wr, int wc, int fr, int fq) const {
#pragma unroll
        for (int ai = 0; ai < 2; ++ai)
#pragma unroll
            for (int m = 0; m < 4; ++m) {
                const int row = u.arow + ai * 128 + wr * 64 + m * 16 + fr;
                const int col = u.pn * 128 + wc * 32 + fq * 8;
                f32x4 o0, o1;
#pragma unroll
                for (int j = 0; j < 4; ++j) { o0[j] = siluf_(acc[ai][0][m][0][j]) * acc[ai][1][m][0][j]; o1[j] = siluf_(acc[ai][0][m][1][j]) * acc[ai][1][m][1][j]; }
                *(u32x4*)(ACT + (size_t)row * FF + col) = pack8(o0, o1);
            }
    }
};
struct EpiGlu {
    float* H; const float* gate;
    __device__ __forceinline__ void operator()(const Acc& acc, const Unit& u, int wr, int wc, int fr, int fq) const {
        const int b = u.arow >> 12; const int col = u.pn * 128 + wc * 32 + fq * 8;
        const float* gp = gate + b * 6144 + col;
        float* hp0 = H + (size_t)(u.arow + wr * 64 + fr) * 1024 + col;
        f32x4 gv[2];
#pragma unroll
        for (int n = 0; n < 2; ++n) gv[n] = *(const f32x4*)(gp + 4 * n);
#pragma unroll
        for (int ai = 0; ai < 2; ++ai) {
            f32x4 hv[4][2];
#pragma unroll
            for (int m = 0; m < 4; ++m)
#pragma unroll
                for (int n = 0; n < 2; ++n) hv[m][n] = *(const f32x4*)(hp0 + (size_t)(ai * 128 + m * 16) * 1024 + 4 * n);
#pragma unroll
            for (int m = 0; m < 4; ++m)
#pragma unroll
                for (int n = 0; n < 2; ++n) {
                    f32x4 o;
#pragma unroll
                    for (int j = 0; j < 4; ++j) o[j] = hv[m][n][j] + gv[n][j] * (acc[ai][0][m][n][j] * sigmoidf_(acc[ai][1][m][n][j]));
                    *(f32x4*)(hp0 + (size_t)(ai * 128 + m * 16) * 1024 + 4 * n) = o;
                }
        }
    }
};
struct EpiGluNorm {
    static constexpr bool AFTER_DRAIN = true;
    float* H; const float* gate; const float* ng; const float* mods_l; bf16_t* XNo; float* xss; unsigned* pcnt; unsigned* tmo; const bf16_t* Hb;
    __device__ __forceinline__ void fused(Acc& acc, const Unit& u, int wr, int wc, int fr, int fq, LAS unsigned char* lds, int wid, int lane) const {
        LAS float* P = (LAS float*)lds; LAS float* S = (LAS float*)(lds + 8192);
        const int row0 = u.arow + wr * 64 + fr, col = u.pn * 128 + wc * 32 + fq * 8, b = row0 >> 12;
        float* hp = H + (size_t)row0 * 1024 + col; const bf16_t* hb = Hb + (size_t)row0 * 1024 + col;
        {
            const float* gp = gate + b * 6144 + col; f32x4 gv[2];
#pragma unroll
            for (int n = 0; n < 2; ++n) gv[n] = *(const f32x4*)(gp + 4 * n);
#pragma unroll
            for (int ai = 0; ai < 2; ++ai)
#pragma unroll
                for (int m = 0; m < 4; ++m) {
                    float s = 0.f;
                    const u32x4 hw = *(const u32x4*)(hb + (size_t)(ai * 128 + m * 16) * 1024);
                    const f32x4 hv2[2] = {{__uint_as_float(hw.x << 16), __uint_as_float(hw.x & 0xFFFF0000u), __uint_as_float(hw.y << 16), __uint_as_float(hw.y & 0xFFFF0000u)},
                                          {__uint_as_float(hw.z << 16), __uint_as_float(hw.z & 0xFFFF0000u), __uint_as_float(hw.w << 16), __uint_as_float(hw.w & 0xFFFF0000u)}};
#pragma unroll
                    for (int n = 0; n < 2; ++n) {
                        const f32x4 hv = hv2[n]; f32x4 o;
#pragma unroll
                        for (int j = 0; j < 4; ++j) o[j] = hv[j] + gv[n][j] * (acc[ai][0][m][n][j] * sigmoidf_(acc[ai][1][m][n][j]));
                        *(f32x4*)(hp + (size_t)(ai * 128 + m * 16) * 1024 + 4 * n) = o; acc[ai][0][m][n] = o;
                        s += (o[0] * o[0] + o[1] * o[1]) + (o[2] * o[2] + o[3] * o[3]);
                    }
                    s += __shfl_xor(s, 16); s += __shfl_xor(s, 32);
                    if (fq == 0) P[(ai * 128 + wr * 64 + m * 16 + fr) * 4 + wc] = s;
                }
        }
        asm volatile("s_waitcnt lgkmcnt(0)" ::: "memory"); __builtin_amdgcn_s_barrier(); asm volatile("" ::: "memory");
        const int row = wid * 32 + (lane & 31);
        if (lane < 32) {
            const float t = (P[row * 4 + 0] + P[row * 4 + 1]) + (P[row * 4 + 2] + P[row * 4 + 3]);
            __hip_atomic_store((unsigned*)xss + ((size_t)(u.arow + row) * 8 + u.pn), __float_as_uint(t), __ATOMIC_RELAXED, __HIP_MEMORY_SCOPE_AGENT);
        }
        asm volatile("s_waitcnt vmcnt(0)" ::: "memory");
        if (lane == 0) __hip_atomic_fetch_add(pcnt + 64 * u.pm, 1u, __ATOMIC_RELAXED, __HIP_MEMORY_SCOPE_AGENT);
        if (wid == 0) {
            unsigned sp = 0;
            while ((unsigned)__builtin_amdgcn_readfirstlane(__hip_atomic_load(pcnt + 64 * u.pm, __ATOMIC_RELAXED, __HIP_MEMORY_SCOPE_AGENT)) < 64u) {
                __builtin_amdgcn_s_sleep(2);
                if ((++sp & 1023u) == 0u) { if (__hip_atomic_load(tmo, __ATOMIC_RELAXED, __HIP_MEMORY_SCOPE_AGENT) != 0u) break; if (sp > (1u << 22)) { if (lane == 0) atomicAdd(tmo, 1u); break; } }
            }
            __builtin_amdgcn_fence(__ATOMIC_ACQUIRE, "agent");
        }
        asm volatile("s_waitcnt vmcnt(0) lgkmcnt(0)" ::: "memory"); __builtin_amdgcn_s_barrier(); asm volatile("" ::: "memory");
        if (lane < 32) {
            const unsigned* slot = (const unsigned*)xss + (size_t)(u.arow + row) * 8; float t = 0.f;
#pragma unroll
            for (int q = 0; q < 8; ++q) t += __uint_as_float(__hip_atomic_load(slot + q, __ATOMIC_RELAXED, __HIP_MEMORY_SCOPE_AGENT));
            S[row] = rsqrtf(t * (1.0f / 1024.0f) + 1e-6f);
        }
        asm volatile("s_waitcnt lgkmcnt(0)" ::: "memory"); __builtin_amdgcn_s_barrier(); asm volatile("" ::: "memory");
        f32x4 mv[2], sv[2];
#pragma unroll
        for (int n = 0; n < 2; ++n) { const int c = col + 4 * n; const f32x4 g4 = *(const f32x4*)(ng + c), s4 = *(const f32x4*)(mods_l + (size_t)b * 6144 + 4 * 1024 + c); sv[n] = *(const f32x4*)(mods_l + (size_t)b * 6144 + 3 * 1024 + c);
#pragma unroll
            for (int j = 0; j < 4; ++j) mv[n][j] = g4[j] * (1.0f + s4[j]); }
        bf16_t* xp = XNo + (size_t)row0 * 1024 + col;
#pragma unroll
        for (int ai = 0; ai < 2; ++ai)
#pragma unroll
            for (int m = 0; m < 4; ++m) {
                const float rinv = S[ai * 128 + wr * 64 + m * 16 + fr];
                const f32x4 y0 = acc[ai][0][m][0] * rinv * mv[0] + sv[0], y1 = acc[ai][0][m][1] * rinv * mv[1] + sv[1];
                *(u32x4*)(xp + (size_t)(ai * 128 + m * 16) * 1024) = pack8(y0, y1);
            }
    }
};
struct EpiState {
    bf16_t* S;
    __device__ __forceinline__ void operator()(const Acc& acc, const Unit& u, int wr, int wc, int fr, int fq) const {
        bf16_t* base = S + (size_t)u.pn * SROWS * 256;
#pragma unroll
        for (int ai = 0; ai < 2; ++ai)
#pragma unroll
            for (int m = 0; m < 4; ++m) {
                const int lrow = u.pm * 256 + ai * 128 + wr * 64 + m * 16 + fr;
                bf16_t* op = base + (size_t)lrow * 256;
#pragma unroll
                for (int bj = 0; bj < 2; ++bj) *(u32x4*)(op + bj * 128 + wc * 32 + fq * 8) = pack8(acc[ai][bj][m][0], acc[ai][bj][m][1]);
            }
    }
};
struct EpiSout {
    bf16_t* GY;
    __device__ __forceinline__ void operator()(const Acc& acc, const Unit& u, int wr, int wc, int fr, int fq) const {
#pragma unroll
        for (int ai = 0; ai < 2; ++ai)
#pragma unroll
            for (int m = 0; m < 4; ++m) {
                const int lrow = u.pm * 256 + ai * 128 + wr * 64 + m * 16 + fr;
                const int b = lrow >> 8, ch = lrow & 255;
#pragma unroll
                for (int bj = 0; bj < 2; ++bj) {
                    const int n = bj * 128 + wc * 32 + fq * 8; const int t = n >> 4, h0 = n & 15;
                    f32x4 o0, o1;
#pragma unroll
                    for (int j = 0; j < 4; ++j) { o0[j] = gelu_tanh(acc[ai][bj][m][0][j]); o1[j] = gelu_tanh(acc[ai][bj][m][1][j]); }
                    *(u32x4*)(GY + (size_t)(b * 4096 + ch * 16 + t) * 1024 + u.pn * 16 + h0) = pack8(o0, o1);
                }
            }
    }
};

__device__ __forceinline__ void p0_transpose(const float* src, int ld, int K, int c0, bf16_t* dst, float scale, LAS float* tile) {
    const int tid = otid();
    const int lkk = tid >> 7, lcc = tid & 127;
    float r[16];
#pragma unroll
    for (int i = 0; i < 16; ++i) r[i] = __builtin_nontemporal_load(src + (size_t)(lkk + 4 * i) * ld + c0 + lcc);
    for (int k0 = 0; k0 < K; k0 += 64) {
        __syncthreads();
#pragma unroll
        for (int i = 0; i < 16; ++i) tile[(lkk + 4 * i) * 129 + lcc] = r[i];
        if (k0 + 64 < K) {
#pragma unroll
            for (int i = 0; i < 16; ++i) r[i] = __builtin_nontemporal_load(src + (size_t)(k0 + 64 + lkk + 4 * i) * ld + c0 + lcc);
        }
        __syncthreads();
        { const int cc = tid >> 2, kk0 = (tid & 3) * 16; float v[16];
#pragma unroll
          for (int j = 0; j < 16; ++j) v[j] = tile[(kk0 + j) * 129 + cc] * scale;
          u32x4 w0, w1; w0.x = cvt_pk_bf16(v[0], v[1]); w0.y = cvt_pk_bf16(v[2], v[3]); w0.z = cvt_pk_bf16(v[4], v[5]); w0.w = cvt_pk_bf16(v[6], v[7]);
          w1.x = cvt_pk_bf16(v[8], v[9]); w1.y = cvt_pk_bf16(v[10], v[11]); w1.z = cvt_pk_bf16(v[12], v[13]); w1.w = cvt_pk_bf16(v[14], v[15]);
          bf16_t* dp = dst + (size_t)cc * K + k0 + kk0; *(u32x4*)dp = w0; *(u32x4*)(dp + 8) = w1; }
    }
    __syncthreads();
}

__device__ __forceinline__ void p0_s5_item(const Params& p, int g, LAS float* L) {
    const int tid = otid();
    LAS float* pw_re = L;
    LAS float* pw_im = L + 2176;
    LAS float* bb_re = L + 4352;
    LAS float* bb_im = L + 6400;
    LAS float* cc_re = L + 8448;
    LAS float* cc_im = L + 10528;
    LAS float* Kt = L + 12608;
    __syncthreads();
    for (int idx = tid; idx < 2176; idx += NT) {
        const int dir = idx / 1088, rem = idx - dir * 1088, pp = rem / 17, tau = rem - pp * 17;
        const float dt = expf(p.log_dt[dir * 64 + g]);
        const float are = p.a_re[(dir * 64 + g) * 64 + pp], aim = p.a_im[(dir * 64 + g) * 64 + pp];
        const float mag = expf(are * dt * (float)tau); float s, c; sincosf(aim * dt * (float)tau, &s, &c);
        pw_re[idx] = mag * c; pw_im[idx] = mag * s;
    }
    __syncthreads();
    if (tid < 128) {
        const int dir = tid >> 6, pp = tid & 63;
        const float are = p.a_re[(dir * 64 + g) * 64 + pp], aim = p.a_im[(dir * 64 + g) * 64 + pp];
        const float abr = pw_re[(dir * 64 + pp) * 17 + 1], abi = pw_im[(dir * 64 + pp) * 17 + 1];
        const float nr = abr - 1.0f, ni = abi, den = are * are + aim * aim;
        const float fre = (nr * are + ni * aim) / den, fim = (ni * are - nr * aim) / den;
        for (int h = 0; h < 16; ++h) {
            const float br = p.b_re[((size_t)(dir * 64 + g) * 64 + pp) * 16 + h], bi = p.b_im[((size_t)(dir * 64 + g) * 64 + pp) * 16 + h];
            bb_re[(dir * 64 + pp) * 16 + h] = fre * br - fim * bi; bb_im[(dir * 64 + pp) * 16 + h] = fre * bi + fim * br;
        }
    }
    for (int idx = tid; idx < 2048; idx += NT) {
        const int dir = idx >> 10, h = (idx >> 6) & 15, pp = idx & 63;
        cc_re[(dir * 16 + h) * 65 + pp] = p.c_re[((size_t)(dir * 64 + g) * 16 + h) * 64 + pp]; cc_im[(dir * 16 + h) * 65 + pp] = p.c_im[((size_t)(dir * 64 + g) * 16 + h) * 64 + pp];
    }
    __syncthreads();
    {
        const int dir = tid >> 8, tau = (tid >> 4) & 15, h = tid & 15;
        float a[16];
#pragma unroll
        for (int j = 0; j < 16; ++j) a[j] = 0.f;
        for (int pp = 0; pp < 64; ++pp) {
            const float cr = cc_re[(dir * 16 + h) * 65 + pp], ci = cc_im[(dir * 16 + h) * 65 + pp];
            const float pr = pw_re[(dir * 64 + pp) * 17 + tau], pi = pw_im[(dir * 64 + pp) * 17 + tau];
            const float xr = cr * pr - ci * pi, xi = cr * pi + ci * pr;
#pragma unroll
            for (int j = 0; j < 16; ++j) a[j] += xr * bb_re[(dir * 64 + pp) * 16 + j] - xi * bb_im[(dir * 64 + pp) * 16 + j];
        }
#pragma unroll
        for (int j = 0; j < 16; ++j) Kt[tid * 16 + j] = a[j];
    }
    __syncthreads();
    bf16_t* Wst = (bf16_t*)(p.ws + O_WST) + (size_t)g * 256 * 256;
    for (int ch = tid; ch < 8192; ch += NT) {
        const int n = ch >> 5, k0 = (ch & 31) * 8; const int dir = n >> 7, ri = (n >> 6) & 1, pp = n & 63, s = k0 >> 4, h0 = k0 & 15; const int e = dir ? s : 15 - s;
        const float pr = pw_re[(dir * 64 + pp) * 17 + e], pi = pw_im[(dir * 64 + pp) * 17 + e];
        float v[8];
#pragma unroll
        for (int j = 0; j < 8; ++j) { const float br = bb_re[(dir * 64 + pp) * 16 + h0 + j], bi = bb_im[(dir * 64 + pp) * 16 + h0 + j]; v[j] = ri ? (pr * bi + pi * br) : (pr * br - pi * bi); }
        u32x4 w; w.x = cvt_pk_bf16(v[0], v[1]); w.y = cvt_pk_bf16(v[2], v[3]); w.z = cvt_pk_bf16(v[4], v[5]); w.w = cvt_pk_bf16(v[6], v[7]);
        *(u32x4*)(Wst + (size_t)n * 256 + k0) = w;
    }
    bf16_t* Tt = (bf16_t*)(p.ws + O_TT) + (size_t)g * 256 * 512;
    for (int ch = tid; ch < 16384; ch += NT) {
        const int n = ch >> 6, k0 = (ch & 63) * 8; const int t = n >> 4, h = n & 15; float v[8];
        if (k0 < 256) {
            const int s = k0 >> 4, h0 = k0 & 15;
#pragma unroll
            for (int j = 0; j < 8; ++j) {
                float x = 0.f;
                if (s <= t) x += Kt[((0 * 16 + (t - s)) * 16 + h) * 16 + h0 + j];
                if (s >= t) x += Kt[((1 * 16 + (s - t)) * 16 + h) * 16 + h0 + j];
                if (s == t && h == h0 + j) x += p.ssm_d[g * 16 + h];
                v[j] = x;
            }
        } else {
            const int kk = k0 - 256, dir = kk >> 7, ri = (kk >> 6) & 1, p0 = kk & 63; const int e = dir ? 16 - t : t + 1;
#pragma unroll
            for (int j = 0; j < 8; ++j) {
                const int pp = p0 + j;
                const float cr = cc_re[(dir * 16 + h) * 65 + pp], ci = cc_im[(dir * 16 + h) * 65 + pp], pr = pw_re[(dir * 64 + pp) * 17 + e], pi = pw_im[(dir * 64 + pp) * 17 + e];
                v[j] = ri ? -(cr * pi + ci * pr) : (cr * pr - ci * pi);
            }
        }
        u32x4 w; w.x = cvt_pk_bf16(v[0], v[1]); w.y = cvt_pk_bf16(v[2], v[3]); w.z = cvt_pk_bf16(v[4], v[5]); w.w = cvt_pk_bf16(v[6], v[7]);
        *(u32x4*)(Tt + (size_t)n * 512 + k0) = w;
    }
    __syncthreads();
}

__device__ __forceinline__ void p0_adaln_item(const Params& p, int it, LAS float* L) {
    const int tid = otid(); const int l = it / 96, n0 = (it % 96) * 64;
    LAS float* sc = L;
    LAS float* red = L + 5120;
    __syncthreads();
    for (int idx = tid; idx < 5120; idx += NT) { const int r = idx >> 10, k = idx & 1023; const float v = (r < 4) ? p.c[r * 1024 + k] : p.c_ctx[k]; sc[idx] = siluf_(v); }
    __syncthreads();
    const int n = tid & 63, kq = tid >> 6; float a[5] = {0.f, 0.f, 0.f, 0.f, 0.f};
    const float* wp = p.mod_w + (size_t)l * 1024 * 6144 + n0 + n;
    for (int k = kq; k < 1024; k += 128) {
        float w[16];
#pragma unroll
        for (int u = 0; u < 16; ++u) w[u] = __builtin_nontemporal_load(wp + (size_t)(k + 8 * u) * 6144);
#pragma unroll
        for (int u = 0; u < 16; ++u)
#pragma unroll
            for (int r = 0; r < 5; ++r) a[r] += sc[r * 1024 + k + 8 * u] * w[u];
    }
#pragma unroll
    for (int r = 0; r < 5; ++r) red[(kq * 5 + r) * 64 + n] = a[r];
    __syncthreads();
    if (tid < 320) { const int r = tid >> 6, nn = tid & 63; float s = p.mod_b[l * 6144 + n0 + nn];
#pragma unroll
        for (int q = 0; q < 8; ++q) s += red[(q * 5 + r) * 64 + nn];
        ((float*)(p.ws + O_MODS))[(size_t)(l * 5 + r) * 6144 + n0 + nn] = s; }
    __syncthreads();
}

__device__ __forceinline__ void p0_fold_item(const Params& p, int it, LAS float* L) {
    const int tid = otid(); const int grp = it >> 4, kt = it & 15;
    LAS float* w = L;
    LAS float* cT = L + 4160;
    LAS float* sT = L + 4224;
    __syncthreads();
#pragma unroll
    for (int i = 0; i < 8; ++i) { const int idx = tid + i * NT, kk = idx >> 6, j = idx & 63; w[kk * 65 + j] = p.w_in[(size_t)(kt * 64 + kk) * 1280 + grp * 64 + j]; }
    if (tid < 64) { cT[tid] = cospif((float)tid / 32.0f); sT[tid] = sinpif((float)tid / 32.0f); }
    __syncthreads();
    const int kk = tid & 63, q = tid >> 6; bf16_t* WinA = (bf16_t*)(p.ws + O_WINA);
    for (int i = 0; i < 8; ++i) {
        const int n = q + 8 * i; float ac = 0.f, as = 0.f; int ph = 0;
        for (int j = 0; j < 64; ++j) { const float wv = w[kk * 65 + j]; ac += wv * cT[ph]; as += wv * sT[ph]; ph = (ph + n) & 63; }
        WinA[(size_t)(grp * 64 + n) * 1024 + kt * 64 + kk] = f2bf(ac);
        WinA[(size_t)(512 + grp * 64 + n) * 1024 + kt * 64 + kk] = f2bf(as);
    }
    __syncthreads();
}

__device__ __forceinline__ void p0_dft_item(const Params& p, int it, LAS float* L) {
    const int tid = otid();
    __syncthreads();
    for (int i = tid; i < 256; i += NT) L[i] = cospif((float)i / 128.0f);
    __syncthreads();
    if (it == 0) {
        bf16_t* D = (bf16_t*)(p.ws + O_D256);
        for (int idx = tid; idx < 512 * 512; idx += NT) {
            const int row = idx >> 9, col = idx & 511; const int ro = row >> 8, k = row & 255, cs = col >> 8, t = col & 255; const int ph = (k * t) & 255;
            const float C = L[ph], S = L[(ph - 64) & 255];
            const float v = ro == 0 ? (cs == 0 ? C : -S) : (cs == 0 ? -S : -C);
            D[idx] = f2bf(v);
        }
    } else {
        bf16_t* Dc = (bf16_t*)(p.ws + O_DC);
        for (int idx = tid; idx < 256 * 512; idx += NT) {
            const int k = idx >> 9, j = idx & 511, t = j & 255, cs = j >> 8; const int ph = (k * t) & 255;
            Dc[idx] = f2bf((cs ? -L[(ph - 64) & 255] : L[ph]) * (1.0f / 128.0f));
        }
    }
    __syncthreads();
}

constexpr int P0_S5 = 64, P0_ADA = 192, P0_FOLD = 128, P0_TR = 134, P0_DFT = 2, P0_MISC = 1;
constexpr int P0_ITEMS = P0_S5 + P0_ADA + P0_FOLD + P0_TR + P0_DFT + P0_MISC;

__device__ __forceinline__ void p0_transpose_dispatch(const Params& p, int it, LAS float* L) {
    unsigned char* ws = p.ws;
    const float* src; int ld, K, c0; bf16_t* dst; float scale = 1.0f;
    if (it < 16) { const int l = it >> 3; it &= 7; src = p.ffn_d + (size_t)l * FF * 1024; ld = 1024; K = FF; c0 = 128 * it; dst = (bf16_t*)(ws + (l ? O_WD1 : O_WD0)) + (size_t)(128 * it) * FF; }
    else {
        it -= 16;
        if (it < 4) { src = p.w_in; ld = 1280; K = 1024; c0 = 512 + 128 * it; dst = (bf16_t*)(ws + O_WINB) + (size_t)(128 * it) * 1024; scale = 0.125f * 1.4426950408889634f; }
        else if (it < 5) { src = p.w_in; ld = 1280; K = 1024; c0 = 1024; dst = (bf16_t*)(ws + O_WINB) + (size_t)512 * 1024; }
        else if (it < 6) { src = p.w_in; ld = 1280; K = 1024; c0 = 1152; dst = (bf16_t*)(ws + O_WINB) + (size_t)640 * 1024; }
        else if (it < 14) { it -= 6; src = p.w_out; ld = 1024; K = 1024; c0 = 128 * it; dst = (bf16_t*)(ws + O_WOUT) + (size_t)(128 * it) * 1024; }
        else if (it < 14 + 88) {
            it -= 14; const int l = it / 44; it -= l * 44;
            bf16_t* wgu = (bf16_t*)(ws + (l ? O_WGU1 : O_WGU0));
            const int up = it / 22, tile = it % 22;
            src = (up ? p.ffn_u : p.ffn_g) + (size_t)l * 1024 * FF; ld = FF; K = 1024; c0 = 128 * tile; dst = wgu + (size_t)(tile * 256 + up * 128) * 1024;
        } else {
            it -= 102; c0 = 128 * it; const int half = c0 >> 10, j = c0 & 1023;
            src = p.glu_w; ld = 2048; K = 1024; dst = (bf16_t*)(ws + O_GLU) + (size_t)((j >> 7) * 256 + half * 128) * 1024;
        }
    }
    p0_transpose(src, ld, K, c0, dst, scale, L);
}

__device__ __forceinline__ void p0_misc(const Params& p) {
    const int tid = otid();
    float* rc = (float*)(p.ws + O_ROPE); float* rs = rc + 1024;
    for (int i = tid; i < 1024; i += NT) { const int pp = i >> 4, f = i & 15; const float inv = powf(10000.0f, -(float)f / 16.0f); const float ang = (float)pp * inv; float s, c; sincosf(ang, &s, &c); rc[i] = c; rs[i] = s; }
}

__device__ __forceinline__ void p0_dispatch(const Params& p, int it, LAS float* L) {
    int i = it;
    if (i < 64) { p0_s5_item(p, i, L); return; } i -= 64;
    if (i < 16) { p0_transpose_dispatch(p, i, L); return; } i -= 16;
    if (i < 128) { p0_fold_item(p, i, L); return; } i -= 128;
    if (i < 118) { p0_transpose_dispatch(p, 16 + i, L); return; } i -= 118;
    if (i < 192) { p0_adaln_item(p, i, L); return; } i -= 192;
    if (i < 2) { p0_dft_item(p, i, L); return; } i -= 2;
    p0_misc(p);
}
__device__ __forceinline__ void phase_p0(const Params& p, LAS float* L, unsigned* qhead, volatile LAS unsigned* qslot) {
    for (;;) {
        __syncthreads();
        if (threadIdx.x == 0) qslot[0] = __hip_atomic_fetch_add(qhead, 1u, __ATOMIC_RELAXED, __HIP_MEMORY_SCOPE_AGENT);
        __syncthreads();
        const int it = (int)qslot[0];
        if (it >= P0_ITEMS) break;
        p0_dispatch(p, it, L);
    }
}

template <int MODE>
__device__ __forceinline__ void phase_norm(const float* src_lat, const float* src_ctx, int nrows, const float* ng, const float* mods_l, int sh_idx, int sc_idx, bf16_t* dstb, float* dstf,
                                           const bf16_t* part = nullptr, int npart = 0, const float* pgate = nullptr, float* hstore = nullptr, int row_first = 0, const bf16_t* src_latb = nullptr) {
    const int tid_ = otid(); const int lane = tid_ & 63, wv = obid() * 8 + (tid_ >> 6), nw = gridDim.x * 8;
    for (int row = row_first + wv; row < nrows; row += nw) {
        const float* sp; int mr;
        if (row < NLAT) { sp = src_lat + (size_t)row * 1024; mr = row >> 12; } else { sp = src_ctx + (size_t)(row - NLAT) * 1024; mr = 4; }
        f32x4 v[4]; float ss = 0.f;
        if (src_latb && row < NLAT) {
#pragma unroll
            for (int i = 0; i < 4; ++i) { const u32x2 w = *(const u32x2*)(src_latb + (size_t)row * 1024 + i * 256 + lane * 4);
                v[i] = (f32x4){__uint_as_float(w.x << 16), __uint_as_float(w.x & 0xFFFF0000u), __uint_as_float(w.y << 16), __uint_as_float(w.y & 0xFFFF0000u)}; }
        } else {
#pragma unroll
        for (int i = 0; i < 4; ++i) v[i] = *(const f32x4*)(sp + i * 256 + lane * 4);
        }
        if (npart > 0 && row >= NLAT) {
#pragma unroll
            for (int i = 0; i < 4; ++i) {
                const int col = i * 256 + lane * 4; f32x4 s = {0.f, 0.f, 0.f, 0.f};
#pragma unroll 2
                for (int k = 0; k < npart; ++k) { const u32x2 w = *(const u32x2*)(part + ((size_t)k * 1024 + (row - NLAT)) * 1024 + col);
                    s[0] += __uint_as_float(w.x << 16); s[1] += __uint_as_float(w.x & 0xFFFF0000u); s[2] += __uint_as_float(w.y << 16); s[3] += __uint_as_float(w.y & 0xFFFF0000u); }
                v[i] += *(const f32x4*)(pgate + col) * s;
                if (hstore) *(f32x4*)(hstore + (size_t)(row - NLAT) * 1024 + col) = v[i];
            }
        }
#pragma unroll
        for (int i = 0; i < 4; ++i) ss += v[i][0] * v[i][0] + v[i][1] * v[i][1] + v[i][2] * v[i][2] + v[i][3] * v[i][3];
#pragma unroll
        for (int o = 32; o >= 1; o >>= 1) ss += __shfl_xor(ss, o);
        const float rinv = rsqrtf(ss * (1.0f / 1024.0f) + 1e-6f);
#pragma unroll
        for (int i = 0; i < 4; ++i) {
            const int col = i * 256 + lane * 4; const f32x4 gv = *(const f32x4*)(ng + col); f32x4 y;
            if (MODE == 2) {
#pragma unroll
                for (int j = 0; j < 4; ++j) y[j] = v[i][j] * rinv * gv[j];
                *(f32x4*)(dstf + (size_t)row * 1024 + col) = y;
            } else {
                const f32x4 sh = *(const f32x4*)(mods_l + (size_t)mr * 6144 + sh_idx * 1024 + col), sc = *(const f32x4*)(mods_l + (size_t)mr * 6144 + sc_idx * 1024 + col);
#pragma unroll
                for (int j = 0; j < 4; ++j) y[j] = v[i][j] * rinv * gv[j] * (1.0f + sc[j]) + sh[j];
                u32x2 w; w.x = cvt_pk_bf16(y[0], y[1]); w.y = cvt_pk_bf16(y[2], y[3]);
                if (MODE == 0) *(u32x2*)(dstb + (size_t)row * 1024 + col) = w;
                else {
                    int lrow, s;
                    if (row < NLAT) { const int b = row >> 12, t = row & 4095; lrow = b * 256 + (t >> 4); s = t & 15; } else { const int r2 = row - NLAT, b = r2 >> 8, t = r2 & 255; lrow = 1024 + b * 16 + (t >> 4); s = t & 15; }
                    const int g = col >> 4, h2 = col & 15;
                    *(u32x2*)(dstb + ((size_t)g * GROWS + lrow) * 512 + s * 16 + h2) = w;
                }
            }
        }
    }
}

struct AttnFr { bf16x8 k[4]; bf16x8 v[4]; };
__device__ __forceinline__ void attn_load(AttnFr& f, const bf16_t* kp, const bf16_t* vp) {
#pragma unroll
    for (int kk = 0; kk < 4; ++kk) f.k[kk] = *(const bf16x8*)(kp + 16 * kk);
#pragma unroll
    for (int q = 0; q < 4; ++q) f.v[q] = *(const bf16x8*)(vp + q * 512);
}

__device__ __forceinline__ void attn_item(const Params& p, int item) {
    const int lane = otid() & 63, r = lane & 31, h = lane >> 5;
    const bf16_t* Q = (const bf16_t*)(p.ws + O_Q); const bf16_t* Kb = (const bf16_t*)(p.ws + O_K);
    const bf16_t* VT = (const bf16_t*)(p.ws + O_VT); const bf16_t* VTc = (const bf16_t*)(p.ws + O_VTC);
    bf16_t* MIX = (bf16_t*)(p.ws + O_MIX);
    int b, qt, hq, tok0, q0, ntile; bool isctx;
    if (item < 4096) { isctx = false; b = item >> 10; qt = (item >> 3) & 127; hq = item & 7; q0 = qt * 32; tok0 = b * 4096 + q0; ntile = 17; }
    else { const int it = item - 4096; isctx = true; b = it >> 6; qt = (it >> 3) & 7; hq = it & 7; q0 = qt * 32; tok0 = NLAT + b * 256 + q0; ntile = 8; }
    const int kvh = hq >> 2;
    bf16x8 qf[4];
    { const bf16_t* qp = Q + (size_t)(tok0 + r) * 512 + hq * 64 + h * 8;
#pragma unroll
      for (int kk = 0; kk < 4; ++kk) qf[kk] = *(const bf16x8*)(qp + 16 * kk); }
    float mrun = p.sink[hq] * 1.4426950408889634f, lrun = 1.0f;
    f32x16 o0, o1;
#pragma unroll
    for (int i = 0; i < 16; ++i) { o0[i] = 0.f; o1[i] = 0.f; }
    const int qpos = q0 + r;
    auto tile_ptrs = [&](int ti, const bf16_t*& kp, const bf16_t*& vp) {
        if (ti < 8) { kp = Kb + (size_t)(NLAT + b * 256 + 32 * ti + r) * 128 + kvh * 64 + h * 8; vp = VTc + (size_t)((b * 2 + kvh) * 8 + ti) * 2048 + lane * 8; }
        else { const int kbase = q0 - 128 + 32 * (ti - 8); const int kc = kbase < 0 ? 0 : (kbase > 4064 ? 4064 : kbase);
               kp = Kb + (size_t)(b * 4096 + kc + r) * 128 + kvh * 64 + h * 8; vp = VT + (size_t)((b * 2 + kvh) * 128 + (kc >> 5)) * 2048 + lane * 8; }
    };
    AttnFr cur, nxt;
    { const bf16_t *kp, *vp; tile_ptrs(0, kp, vp); attn_load(cur, kp, vp); }
    for (int ti = 0; ti < ntile; ++ti) {
        if (ti + 1 < ntile) { const bf16_t *kp, *vp; tile_ptrs(ti + 1, kp, vp); attn_load(nxt, kp, vp); }
        f32x16 s;
#pragma unroll
        for (int i = 0; i < 16; ++i) s[i] = 0.f;
#pragma unroll
        for (int kk = 0; kk < 4; ++kk) s = __builtin_amdgcn_mfma_f32_32x32x16_bf16(cur.k[kk], qf[kk], s, 0, 0, 0);
        if (ti >= 8) {
            const int kbase = q0 - 128 + 32 * (ti - 8);
            if (ti == 8 || ti == 16 || kbase < 0 || kbase > 4064) {
#pragma unroll
                for (int i = 0; i < 16; ++i) { const int kpos = kbase + (i & 3) + 8 * (i >> 2) + 4 * h; const int d = kpos - qpos; const bool ok = (kpos >= 0) && (kpos < 4096) && (d <= 128) && (d >= -128); s[i] = ok ? s[i] : -1e30f; }
            }
        }
        float mx = s[0];
#pragma unroll
        for (int i = 1; i < 16; ++i) mx = fmaxf(mx, s[i]);
        mx = fmaxf(mx, __shfl_xor(mx, 32));
        const float mnew = fmaxf(mrun, mx), alpha = __builtin_amdgcn_exp2f(mrun - mnew);
        float ps = 0.f; float pv[16];
#pragma unroll
        for (int i = 0; i < 16; ++i) { pv[i] = __builtin_amdgcn_exp2f(s[i] - mnew); ps += pv[i]; }
        ps += __shfl_xor(ps, 32);
        lrun = lrun * alpha + ps;
        if (__builtin_amdgcn_ballot_w64(mnew != mrun) != 0ull) {
#pragma unroll
            for (int i = 0; i < 16; ++i) { o0[i] *= alpha; o1[i] *= alpha; }
        }
        mrun = mnew;
        bf16x8 pf[2];
#pragma unroll
        for (int sidx = 0; sidx < 2; ++sidx) { u32x4 w; w.x = cvt_pk_bf16(pv[8 * sidx + 0], pv[8 * sidx + 1]); w.y = cvt_pk_bf16(pv[8 * sidx + 2], pv[8 * sidx + 3]); w.z = cvt_pk_bf16(pv[8 * sidx + 4], pv[8 * sidx + 5]); w.w = cvt_pk_bf16(pv[8 * sidx + 6], pv[8 * sidx + 7]); pf[sidx] = __builtin_bit_cast(bf16x8, w); }
#pragma unroll
        for (int sidx = 0; sidx < 2; ++sidx) {
            o0 = __builtin_amdgcn_mfma_f32_32x32x16_bf16(cur.v[sidx], pf[sidx], o0, 0, 0, 0);
            o1 = __builtin_amdgcn_mfma_f32_32x32x16_bf16(cur.v[2 + sidx], pf[sidx], o1, 0, 0, 0);
        }
        cur = nxt;
    }
    const float inv = 1.0f / lrun;
    bf16_t* op = MIX + (size_t)(tok0 + r) * 1024 + 512 + hq * 64;
#pragma unroll
    for (int rg = 0; rg < 4; ++rg) {
        const int d0 = 8 * rg + 4 * h;
        u32x2 w0, w1;
        w0.x = cvt_pk_bf16(o0[4 * rg] * inv, o0[4 * rg + 1] * inv); w0.y = cvt_pk_bf16(o0[4 * rg + 2] * inv, o0[4 * rg + 3] * inv);
        w1.x = cvt_pk_bf16(o1[4 * rg] * inv, o1[4 * rg + 1] * inv); w1.y = cvt_pk_bf16(o1[4 * rg + 2] * inv, o1[4 * rg + 3] * inv);
        *(u32x2*)(op + d0) = w0; *(u32x2*)(op + 32 + d0) = w1;
    }
}


__device__ __forceinline__ void phase_dft_combine(const Params& p, LAS float* L) {
    const int tid = otid(); const int G = gridDim.x, bx = obid();
    const bf16_t* I2 = (const bf16_t*)(p.ws + O_I2); bf16_t* MIX = (bf16_t*)(p.ws + O_MIX);
    constexpr float C16[16] = {1.0f, 0.92387953251f, 0.70710678119f, 0.38268343237f, 0.0f, -0.38268343237f, -0.70710678119f, -0.92387953251f, -1.0f, -0.92387953251f, -0.70710678119f, -0.38268343237f, 0.0f, 0.38268343237f, 0.70710678119f, 0.92387953251f};
    constexpr float S16[16] = {0.0f, 0.38268343237f, 0.70710678119f, 0.92387953251f, 1.0f, 0.92387953251f, 0.70710678119f, 0.38268343237f, 0.0f, -0.38268343237f, -0.70710678119f, -0.92387953251f, -1.0f, -0.92387953251f, -0.70710678119f, -0.38268343237f};
    for (int pair = bx; pair < 1024; pair += G) {
        const int b = pair >> 8, kp = pair & 255;
        __syncthreads();
        if (tid < 16) { float s, c; sincospif((float)(kp * tid) / 2048.0f, &s, &c); L[tid] = c; L[16 + tid] = s; }
        __syncthreads();
        const int c = tid;
        const u32x4* pr = (const u32x4*)(I2 + (size_t)kp * 32768 + (size_t)(b * 512 + c) * 16);
        const u32x4* pi = (const u32x4*)(I2 + (size_t)(256 + kp) * 32768 + (size_t)(b * 512 + c) * 16);
        const u32x4 r0 = pr[0], r1 = pr[1], i0 = pi[0], i1 = pi[1];
        const unsigned rw[8] = {r0.x, r0.y, r0.z, r0.w, r1.x, r1.y, r1.z, r1.w}, iw[8] = {i0.x, i0.y, i0.z, i0.w, i1.x, i1.y, i1.z, i1.w};
        float xr[16], xi[16];
#pragma unroll
        for (int r = 0; r < 16; ++r) {
            const float ire = __uint_as_float((r & 1) ? (rw[r >> 1] & 0xFFFF0000u) : (rw[r >> 1] << 16));
            const float iim = __uint_as_float((r & 1) ? (iw[r >> 1] & 0xFFFF0000u) : (iw[r >> 1] << 16));
            const float ct = L[r], st = L[16 + r];
            xr[r] = ire * ct + iim * st; xi[r] = iim * ct - ire * st;
        }
#pragma unroll
        for (int j = 0; j < 16; ++j) {
            float y = 0.f;
#pragma unroll
            for (int r = 0; r < 16; ++r) y += xr[r] * C16[(j * r) & 15] + xi[r] * S16[(j * r) & 15];
            MIX[(size_t)(b * 4096 + kp + 256 * j) * 1024 + c] = f2bf(y * (1.0f / 512.0f));
        }
    }
}

__device__ __forceinline__ void phase_scan(const Params& p) {
    const int tid_ = otid(); const int lane = tid_ & 63, wave = tid_ >> 6;
    const bf16_t* S = (const bf16_t*)(p.ws + O_S); bf16_t* A2 = (bf16_t*)(p.ws + O_A2);
    const int nitems = 512;
    for (int item = obid() + gridDim.x * wave; item < nitems; item += gridDim.x * 8) {
        const int b = item >> 7, g = (item >> 1) & 63, dir = item & 1, pp = lane;
        const float dt = expf(p.log_dt[dir * 64 + g]);
        const float are = p.a_re[(dir * 64 + g) * 64 + pp], aim = p.a_im[(dir * 64 + g) * 64 + pp];
        const float mag = expf(are * dt * 16.0f); float sn, cs; sincosf(aim * dt * 16.0f, &sn, &cs);
        const float ar = mag * cs, ai = mag * sn;
        float hr = 0.f, hi = 0.f;
        const bf16_t* Sg = S + (size_t)g * SROWS * 256 + dir * 128 + pp;
        bf16_t* Ag = A2 + (size_t)g * GROWS * 512 + 256 + dir * 128 + pp;
        for (int i = 0; i < 16; ++i) {
            const int ch = dir ? 15 - i : i; const size_t lrow = 1024 + b * 16 + ch;
            const float sr = __uint_as_float((unsigned)Sg[lrow * 256] << 16), si = __uint_as_float((unsigned)Sg[lrow * 256 + 64] << 16);
            const float nr = ar * hr - ai * hi + sr, ni = ar * hi + ai * hr + si; hr = nr; hi = ni;
        }
        for (int i0 = 0; i0 < 256; i0 += 8) {
            float sr[8], si[8];
#pragma unroll
            for (int j = 0; j < 8; ++j) { const int ch = dir ? 255 - (i0 + j) : (i0 + j); const size_t lrow = b * 256 + ch; sr[j] = __uint_as_float((unsigned)Sg[lrow * 256] << 16); si[j] = __uint_as_float((unsigned)Sg[lrow * 256 + 64] << 16); }
#pragma unroll
            for (int j = 0; j < 8; ++j) {
                const int ch = dir ? 255 - (i0 + j) : (i0 + j); const size_t lrow = b * 256 + ch;
                Ag[lrow * 512] = f2bf(hr); Ag[lrow * 512 + 64] = f2bf(hi);
                const float nr = ar * hr - ai * hi + sr[j], ni = ar * hi + ai * hr + si[j]; hr = nr; hi = ni;
            }
        }
    }
}


#define XB_TMO      128
#define XB_XCNT(j)  (256  + 64 * (j))
#define XB_XSUB(j)  (1280 + 64 * (j))
#define XB_XGEN(j)  (2304 + 64 * (j))
#define XB_TOP      3328
#define XB_TOPGEN   3392
#define XCD_BAR_WORDS 3456
#define XB_SPIN_CAP (1u << 22)
__device__ __forceinline__ unsigned xb_ld(unsigned* p)              { return __hip_atomic_load(p, __ATOMIC_RELAXED, __HIP_MEMORY_SCOPE_AGENT); }
__device__ __forceinline__ unsigned xb_add(unsigned* p, unsigned v) { return __hip_atomic_fetch_add(p, v, __ATOMIC_RELAXED, __HIP_MEMORY_SCOPE_AGENT); }
__device__ __forceinline__ unsigned xb_xcc_id() { return (unsigned)__builtin_amdgcn_s_getreg((3 << 11) | 20) & 0xFu; }
#define XB_SPIN(cond, bar) do { unsigned _sp = 0; while (cond) { __builtin_amdgcn_s_sleep(1); \
    if ((++_sp & 255u) == 0u) { if (xb_ld(&(bar)[XB_TMO])) break; if (_sp > XB_SPIN_CAP) { atomicAdd(&(bar)[XB_TMO], 1u); break; } } } } while (0)
__device__ __forceinline__ unsigned xcd_barrier_complete(unsigned* bar, unsigned x) {
    const unsigned G = gridDim.x;
    unsigned sum, cnt, mine, sp = 0u;
    for (;;) {
        sum = 0u; cnt = 0u; mine = 0u;
        for (unsigned j = 0; j < 16; ++j) { const unsigned c = xb_ld(&bar[XB_XCNT(j)]); sum += c; cnt += (c > 0u) ? 1u : 0u; mine = (j == x) ? c : mine; }
        if (sum == G) break;
        __builtin_amdgcn_s_sleep(1);
        if ((++sp & 255u) == 0u) { if (xb_ld(&bar[XB_TMO])) break; if (sp > XB_SPIN_CAP) { atomicAdd(&bar[XB_TMO], 1u); break; } }
    }
    const unsigned nloc = mine > 0u ? mine : 1u, nx = cnt > 0u ? cnt : 1u;
    return nloc | (nx << 16);
}
__device__ __forceinline__ void xcd_barrier(unsigned* bar, volatile LAS unsigned* st) {
    asm volatile("s_waitcnt vmcnt(0)" ::: "memory");
    __syncthreads();
    if (threadIdx.x == 0) {
        __builtin_amdgcn_s_waitcnt(0);
        const unsigned x = xb_xcc_id();
        unsigned nloc = st[0], nx = st[1];
        if (nloc == 0u) { const unsigned pk = xcd_barrier_complete(bar, x); nloc = pk & 0xFFFFu; nx = pk >> 16; st[0] = nloc; st[1] = nx; }
        const unsigned old = xb_add(&bar[XB_XSUB(x)], 1u);
        const unsigned gen = old / nloc;
        if (old + 1u == (gen + 1u) * nloc) {
            __builtin_amdgcn_fence(__ATOMIC_RELEASE, "agent");
            asm volatile("s_waitcnt vmcnt(0)" ::: "memory");
            const unsigned og = xb_add(&bar[XB_TOP], 1u);
            const unsigned tg = og / nx;
            if (og + 1u == (tg + 1u) * nx) xb_add(&bar[XB_TOPGEN], 1u);
            else XB_SPIN(xb_ld(&bar[XB_TOPGEN]) == tg, bar);
            __builtin_amdgcn_fence(__ATOMIC_ACQUIRE, "agent");
            xb_add(&bar[XB_XGEN(x)], 1u);
            asm volatile("s_waitcnt vmcnt(0)" ::: "memory");
        } else {
            XB_SPIN(xb_ld(&bar[XB_XGEN(x)]) == gen, bar);
            __builtin_amdgcn_fence(__ATOMIC_ACQUIRE, "agent");
            asm volatile("s_waitcnt vmcnt(0)" ::: "memory");
        }
    }
    __syncthreads();
}

__global__ void __launch_bounds__(NT) fwd_megakernel(Params p) {
    extern __shared__ __attribute__((aligned(16))) unsigned char shm[];
    cg::grid_group grid = cg::this_grid();
    LAS unsigned char* lds = (LAS unsigned char*)shm;
    LAS float* L = (LAS float*)shm;
    unsigned char* ws = p.ws;
    const int G = gridDim.x;
    float* mods = (float*)(ws + O_MODS);
    float* hctx = (float*)(ws + O_HCTX);
    bf16_t* XN = (bf16_t*)(ws + O_XN);
    bf16_t* ACT = (bf16_t*)(ws + O_ACT);
    const float* mods1 = mods + 5 * 6144;
    unsigned* bar = (unsigned*)(ws + O_BAR);
    volatile LAS unsigned* bst = (volatile LAS unsigned*)(lds + pg8::STAGE_BYTES);
    if (threadIdx.x < 4) bst[threadIdx.x] = 0u;
    __syncthreads();
    if (threadIdx.x == 0) (void)xb_add(&bar[XB_XCNT(xb_xcc_id())], 1u);
#define GRID_BAR() xcd_barrier(bar, bst)

    {
    phase_p0(p, L, bar + 0, bst + 2);
    }
    grid.sync();
    {
    phase_norm<0>(p.x, p.ctx, NTOK, p.norm_g + 0, mods, 0, 1, XN, nullptr);
    }
    GRID_BAR();
    {
    const int bx = obid();
    {
        const bf16_t* WinA = (const bf16_t*)(ws + O_WINA);
        bf16_t *ZT = (bf16_t*)(ws + O_ZT), *ZTc = (bf16_t*)(ws + O_ZTC), *VT = (bf16_t*)(ws + O_VT), *VTc = (bf16_t*)(ws + O_VTC);
        { pg8::Gemm g1{WinA, XN, 1024, 1024, 16384}; pg8::Sched s1; s1.init(4, 64, G, bx, 3, 1024, 16384);
          EpiInA e1{ZT, ZTc, 0, 1}; pg8::gemm_phase(lds, g1, s1, e1); }
        { pg8::Gemm gb{XN, (const bf16_t*)(ws + O_WINB), 1024, 1024, 1024}; pg8::Sched sb; sb.init(68, 3, G, bx, 0, 1024, 1024);
          EpiInB eb{(bf16_t*)(ws + O_Q), (bf16_t*)(ws + O_K), (const float*)(ws + O_ROPE), (const float*)(ws + O_ROPE) + 1024, VT, VTc}; pg8::gemm_phase(lds, gb, sb, eb); }
        { pg8::Gemm g3{WinA, XN + (size_t)NLAT * 1024, 1024, 1024, 1024}; pg8::Sched s3; s3.init(4, 4, G, (bx + G - (204 % G)) % G, 0, 1024, 1024);
          EpiInA e3{ZT, ZTc, NLAT, 0}; pg8::gemm_phase(lds, g3, s3, e3); }
    }
    }
    GRID_BAR();
    {
    const int bx = obid();
    {
        { pg8::Gemm gd{(const bf16_t*)(ws + O_D256), (const bf16_t*)(ws + O_ZT), 512, 512, 512}; pg8::Sched sd; sd.init(2, 128, G, bx, 0, 512, 512);
          EpiI2 ed{(bf16_t*)(ws + O_I2)}; pg8::gemm_phase(lds, gd, sd, ed); }
        const int wv = bx * 8 + (otid() >> 6), nw = G * 8;
        for (int item = wv; item < 4352; item += nw) attn_item(p, item);
        __syncthreads();
        { pg8::Gemm gc{(const bf16_t*)(ws + O_DC), (const bf16_t*)(ws + O_ZTC), 512, 512, 512}; pg8::Sched sc; sc.init(1, 8, G, (bx + 8) % G, 0, 512, 512);
          EpiDft ec{(bf16_t*)(ws + O_MIX), 1}; pg8::gemm_phase(lds, gc, sc, ec); }
    }
    }
    GRID_BAR();
    phase_dft_combine(p, L);
    GRID_BAR();
    {
    const int bx = obid();
    {
        const bf16_t* MIX = (const bf16_t*)(ws + O_MIX);
        pg8::Gemm g{MIX, (const bf16_t*)(ws + O_WOUT), 1024, 1024, 1024}; pg8::Sched s; s.init(64, 4, G, bx, 0, 1024, 1024);
        if (G == 256) {
            EpiResNorm e{p.x, (bf16_t*)(ws + O_H1B), mods + 2 * 1024, p.norm_g + 1024, mods, XN, (float*)(ws + O_XSS), (unsigned*)(ws + O_PCNT) + 32, bar + XB_TMO};
            pg8::gemm_phase<EpiResNorm, true>(lds, g, s, e);
            __syncthreads();
        } else {
            EpiRes e{p.x, p.ctx, p.out, hctx, mods + 2 * 1024};
            pg8::gemm_phase(lds, g, s, e);
        }
        pg8::Gemm gc{MIX + (size_t)NLAT * 1024, (const bf16_t*)(ws + O_WOUT), 256, 1024, 1024}; pg8::Sched sc; sc.init(16, 4, G, bx, 2, 1024, 1024);
        EpiPart ec{(bf16_t*)(ws + O_XNP)};
        pg8::gemm_phase<EpiPart, false>(lds, gc, sc, ec);
    }
    }
    GRID_BAR();
    {
    phase_norm<0>(p.out, p.ctx, NTOK, p.norm_g + 1024, mods, 3, 4, XN, nullptr, (const bf16_t*)(ws + O_XNP), 4, mods + 4 * 6144 + 2 * 1024, hctx, G == 256 ? NLAT : 0);
    }
    GRID_BAR();
    {
    const int bx = obid();
    {
        pg8::Gemm g{XN, (const bf16_t*)(ws + O_WGU0), 1024, 1024, 1024}; pg8::Sched s; s.init(68, 22, G, bx, 0, 1024, 1024);
        EpiSwiglu e{ACT};
        pg8::gemm_phase(lds, g, s, e);
    }
    }
    GRID_BAR();
    {
    const int bx = obid();
    {
        pg8::Gemm g{ACT, (const bf16_t*)(ws + O_WD0), FF, FF, FF}; pg8::Sched s; s.init(64, 4, G, bx, 0, FF, FF);
        if (G == 256) { EpiResB e{(const bf16_t*)(ws + O_H1B), nullptr, mods + 5 * 1024}; pg8::gemm_phase(lds, g, s, e); }
        else { EpiRes e{p.out, hctx, p.out, hctx, mods + 5 * 1024}; pg8::gemm_phase(lds, g, s, e); }
        pg8::Gemm gc{ACT + (size_t)NLAT * FF, (const bf16_t*)(ws + O_WD0), 256, FF, FF}; pg8::Sched sc; sc.init(16, 11, G, bx, 2, FF, FF);
        EpiPart ec{(bf16_t*)(ws + O_PART)};
        pg8::gemm_phase<EpiPart, false>(lds, gc, sc, ec);
    }
    }
    GRID_BAR();
    {
    phase_norm<1>(p.out, hctx, NTOK, p.norm_g + 2048, mods1, 0, 1, (bf16_t*)(ws + O_A2), nullptr, (const bf16_t*)(ws + O_PART), 11, mods + 4 * 6144 + 5 * 1024, nullptr, 0, G == 256 ? (const bf16_t*)(ws + O_H1B) : nullptr);
    }
    GRID_BAR();
    {
    const int bx = obid();
    {
        pg8::Gemm g{(const bf16_t*)(ws + O_A2), (const bf16_t*)(ws + O_WST), 256, 512, 256}; pg8::Sched s; s.init(5, 64, G, bx, 1, 512, 256);
        EpiState e{(bf16_t*)(ws + O_S)};
        pg8::gemm_phase<EpiState, false>(lds, g, s, e);
    }
    }
    GRID_BAR();
    {
    phase_scan(p);
    }
    GRID_BAR();
    {
    const int bx = obid();
    {
        pg8::Gemm g{(const bf16_t*)(ws + O_A2), (const bf16_t*)(ws + O_TT), 512, 512, 512}; pg8::Sched s; s.init(4, 64, G, bx, 1, 512, 512);
        EpiSout e{(bf16_t*)(ws + O_GY)};
        pg8::gemm_phase(lds, g, s, e);
    }
    }
    GRID_BAR();
    {
    const int bx = obid();
    {
        pg8::Gemm g{(const bf16_t*)(ws + O_GY), (const bf16_t*)(ws + O_GLU), 1024, 1024, 1024};
        if (G == 256) {
            EpiGluNorm e{p.out, mods1 + 2 * 1024, p.norm_g + 3072, mods1, XN, (float*)(ws + O_XSS8), (unsigned*)(ws + O_PCNT) + 16, bar + XB_TMO, (const bf16_t*)(ws + O_H1B)};
            pg8::Sched s; s.init(64, 8, G, bx, 4, 1024, 1024); s.nwg = 256;
            pg8::gemm_phase<EpiGluNorm, true>(lds, g, s, e);
            __syncthreads();
            pg8::Sched s2; s2.init(64, 8, G, bx, 4, 1024, 1024); s2.base = 256;
            pg8::gemm_phase<EpiGluNorm, true>(lds, g, s2, e);
        } else {
            pg8::Sched s; s.init(64, 8, G, bx, 0, 1024, 1024);
            EpiGlu e{p.out, mods1 + 2 * 1024};
            pg8::gemm_phase(lds, g, s, e);
        }
    }
    }
    GRID_BAR();
    if (G != 256) {
    phase_norm<0>(p.out, hctx, NLAT, p.norm_g + 3072, mods1, 3, 4, XN, nullptr);
    GRID_BAR();
    }
    {
    const int bx = obid();
    {
        pg8::Gemm g{XN, (const bf16_t*)(ws + O_WGU1), 1024, 1024, 1024}; pg8::Sched s; s.init(64, 22, G, bx, 0, 1024, 1024);
        EpiSwiglu e{ACT};
        pg8::gemm_phase(lds, g, s, e);
    }
    }
    GRID_BAR();
    {
    const int bx = obid();
    {
        pg8::Gemm g{ACT, (const bf16_t*)(ws + O_WD1), FF, FF, FF}; pg8::Sched s; s.init(64, 4, G, bx, 0, FF, FF);
        if (G == 256) {
            EpiResFinal e{p.out, p.out, mods1 + 5 * 1024, p.final_g, (float*)(ws + O_XSS), (unsigned*)(ws + O_PCNT), bar + XB_TMO};
            pg8::gemm_phase<EpiResFinal, true>(lds, g, s, e);
        } else {
            EpiRes e{p.out, hctx, p.out, hctx, mods1 + 5 * 1024};
            pg8::gemm_phase(lds, g, s, e);
        }
    }
    }
    if (G != 256) {
    GRID_BAR();
    phase_norm<2>(p.out, hctx, NLAT, p.final_g, nullptr, 0, 0, nullptr, p.out);
    }
}

extern "C" void kernel_launch(void* const* d_in, const int* in_sizes, int n_in, void* d_out, int out_size, void* d_ws, size_t ws_size, hipStream_t stream) {
    constexpr int kLds = pg8::STAGE_BYTES + 16;
    static int grid_blocks = 0;
    if (grid_blocks == 0) {
        if (n_in != 23 || ws_size < WS_NEED) { fprintf(stderr, "kernel_launch: unexpected n_in %d or workspace %zu < %zu\n", n_in, ws_size, (size_t)WS_NEED); grid_blocks = -1; return; }
        int dev = 0, cus = 0, per_cu = 0;
        hipGetDevice(&dev);
        hipDeviceGetAttribute(&cus, hipDeviceAttributeMultiprocessorCount, dev);
        hipFuncSetAttribute((const void*)fwd_megakernel, hipFuncAttributeMaxDynamicSharedMemorySize, kLds);
        hipOccupancyMaxActiveBlocksPerMultiprocessor(&per_cu, (const void*)fwd_megakernel, NT, kLds);
        if (per_cu < 1) { fprintf(stderr, "kernel_launch: occupancy query says %d blocks/CU\n", per_cu); per_cu = 1; }
        grid_blocks = cus;
        (void)hipGetLastError();
    }
    if (grid_blocks < 0) return;
    if (hipMemsetAsync((char*)d_ws + O_BAR, 0, 16384 + 64 * 256, stream) != hipSuccess) { fprintf(stderr, "kernel_launch: memset of barrier words failed\n"); return; }
    Params p{};
    p.x = (const float*)d_in[0]; p.c = (const float*)d_in[1]; p.ctx = (const float*)d_in[2]; p.c_ctx = (const float*)d_in[3];
    p.mod_w = (const float*)d_in[4]; p.mod_b = (const float*)d_in[5]; p.norm_g = (const float*)d_in[6];
    p.ffn_g = (const float*)d_in[7]; p.ffn_u = (const float*)d_in[8]; p.ffn_d = (const float*)d_in[9];
    p.w_in = (const float*)d_in[10]; p.w_out = (const float*)d_in[11]; p.sink = (const float*)d_in[12];
    p.a_re = (const float*)d_in[13]; p.a_im = (const float*)d_in[14]; p.log_dt = (const float*)d_in[15];
    p.b_re = (const float*)d_in[16]; p.b_im = (const float*)d_in[17]; p.c_re = (const float*)d_in[18]; p.c_im = (const float*)d_in[19];
    p.ssm_d = (const float*)d_in[20]; p.glu_w = (const float*)d_in[21]; p.final_g = (const float*)d_in[22];
    p.out = (float*)d_out; p.ws = (unsigned char*)d_ws;
    void* args[] = {&p};
    hipError_t e = hipLaunchCooperativeKernel((const void*)fwd_megakernel, dim3(grid_blocks), dim3(NT), args, kLds, stream);
    if (e != hipSuccess) fprintf(stderr, "cooperative launch failed: %s (grid %d)\n", hipGetErrorString(e), grid_blocks);
}
```

```cpp
#include <hip/hip_runtime.h>
#include <hip/hip_cooperative_groups.h>
#include <cstdio>
namespace cg = cooperative_groups;

#define LAS __attribute__((address_space(3)))
typedef unsigned short bf16_t;
typedef short bf16x8 __attribute__((ext_vector_type(8)));
typedef float f32x4 __attribute__((ext_vector_type(4)));
typedef float f32x16 __attribute__((ext_vector_type(16)));
typedef unsigned u32x4 __attribute__((ext_vector_type(4)));
typedef unsigned u32x2 __attribute__((ext_vector_type(2)));

constexpr int NT = 512;
constexpr int DM_ = 1024, SEQ_ = 4096, NB_ = 4, CTXL = 256, FF = 2816;
constexpr int NLAT = NB_ * SEQ_;
constexpr int NCTX = NB_ * CTXL;
constexpr int NTOK = NLAT + NCTX;
constexpr int GROWS = 1088;
constexpr int SROWS = 1280;

constexpr size_t MiB = 1u << 20;
constexpr size_t O_WINA = 0;
constexpr size_t O_WINB = O_WINA + 1280ull * 1024 * 2;
constexpr size_t O_WOUT = O_WINB + 768ull * 1024 * 2;
constexpr size_t O_WGU0 = O_WOUT + 1024ull * 1024 * 2;
constexpr size_t O_WD0 = O_WGU0 + 5632ull * 1024 * 2;
constexpr size_t O_WGU1 = O_WD0 + 1024ull * 2816 * 2;
constexpr size_t O_WD1 = O_WGU1 + 5632ull * 1024 * 2;
constexpr size_t O_GLU = O_WD1 + 1024ull * 2816 * 2;
constexpr size_t O_WST = O_GLU + 2048ull * 1024 * 2;
constexpr size_t O_TT = O_WST + 64ull * 256 * 256 * 2;
constexpr size_t O_MODS = O_TT + 64ull * 256 * 512 * 2;
constexpr size_t O_ROPE = O_MODS + 2ull * 5 * 6144 * 4;
constexpr size_t O_DC = O_ROPE + 2ull * 1024 * 4;
constexpr size_t O_HCTX = O_DC + 256ull * 512 * 2;
constexpr size_t O_VTC = O_HCTX + 1024ull * 1024 * 4;
constexpr size_t O_BAR = O_VTC + 4ull * 128 * 256 * 2;
constexpr size_t O_PCNT = O_BAR + 16384;
constexpr size_t O_D256 = O_PCNT + 64ull * 256;
constexpr size_t O_XSS = O_D256 + 512ull * 512 * 2;
constexpr size_t O_RA = 73 * MiB;
static_assert(O_XSS + 16384ull * 4 * 4 <= O_RA, "R_W overflow");
constexpr size_t O_XN = O_RA;
constexpr size_t O_MIX = O_RA + 34 * MiB;
constexpr size_t O_I2 = O_RA + 68 * MiB;
constexpr size_t O_XNP = O_I2;
constexpr size_t O_ZT = O_RA + 100 * MiB;
constexpr size_t O_ZTC = O_RA + 132 * MiB;
constexpr size_t O_Q = O_RA + 134 * MiB;
constexpr size_t O_K = O_RA + 151 * MiB;
constexpr size_t O_VT = O_K + 17408ull * 128 * 2;
constexpr size_t O_ACT = O_RA + 34 * MiB;
constexpr size_t O_A2 = O_RA;
constexpr size_t O_S = O_RA + 69 * MiB;
constexpr size_t O_GY = O_RA + 69 * MiB;
constexpr size_t O_XSS8 = O_RA + 102 * MiB;
constexpr size_t O_H1B = O_RA + 128 * MiB;
constexpr size_t O_PART = O_RA + 161 * MiB;
constexpr size_t WS_NEED = O_RA + 183 * MiB;
static_assert(WS_NEED <= 256 * MiB, "workspace budget");

struct Params {
    const float* x; const float* c; const float* ctx; const float* c_ctx; const float* mod_w; const float* mod_b; const float* norm_g;
    const float* ffn_g; const float* ffn_u; const float* ffn_d; const float* w_in; const float* w_out; const float* sink;
    const float* a_re; const float* a_im; const float* log_dt; const float* b_re; const float* b_im; const float* c_re; const float* c_im;
    const float* ssm_d; const float* glu_w; const float* final_g;
    float* out; unsigned char* ws;
};

__device__ __forceinline__ int otid() { int t = threadIdx.x; asm volatile("" : "+v"(t)); return t; }
__device__ __forceinline__ int obid() { int t = blockIdx.x; asm volatile("" : "+s"(t)); return t; }
__device__ __forceinline__ unsigned cvt_pk_bf16(float lo, float hi) { unsigned r; asm volatile("v_cvt_pk_bf16_f32 %0, %1, %2" : "=v"(r) : "v"(lo), "v"(hi)); return r; }
__device__ __forceinline__ bf16_t f2bf(float f) { unsigned u = __float_as_uint(f); u += 0x7FFFu + ((u >> 16) & 1u); return (bf16_t)(u >> 16); }
__device__ __forceinline__ float sigmoidf_(float v) { return __builtin_amdgcn_rcpf(1.0f + __builtin_amdgcn_exp2f(-1.4426950408889634f * v)); }
__device__ __forceinline__ float siluf_(float v) { return v * sigmoidf_(v); }
__device__ __forceinline__ float gelu_tanh(float v) { const float u = 0.7978845608028654f * (v + 0.044715f * v * v * v); return v * sigmoidf_(2.0f * u); }
__device__ __forceinline__ u32x4 pack8(const f32x4 a, const f32x4 b) { u32x4 w; w.x = cvt_pk_bf16(a[0], a[1]); w.y = cvt_pk_bf16(a[2], a[3]); w.z = cvt_pk_bf16(b[0], b[1]); w.w = cvt_pk_bf16(b[2], b[3]); return w; }

namespace pg8 {
constexpr int BM = 256, BK = 64, HALF = 128, HTB = HALF * BK * 2, STAGE_BYTES = 8 * HTB, NXCD = 8, WGM = 8;
__device__ __forceinline__ int lds_byte(int r, int c) { const int st = (r >> 4) * 2 + (c >> 5), rr = r & 15, cc = c & 31, ob = rr * 64 + cc * 2; return st * 1024 + (ob ^ (((ob >> 9) & 1) << 5)); }
__device__ __forceinline__ void stage_rc(int b, int& R, int& C) { const int st = b / 1024, sb = b % 1024, swz = sb ^ (((sb >> 9) & 1) << 5); R = (st >> 1) * 16 + swz / 64; C = (st & 1) * 32 + (swz % 64) / 2; }
__device__ __forceinline__ int perm32(int rho) { const int n = rho >> 4, i = rho & 15; return 8 * (i >> 2) + 4 * n + (i & 3); }

struct Unit { int arow, brow, pm, pn, kofs; size_t aoff, boff; };
struct Gemm { const bf16_t* A; const bf16_t* Bt; int K, lda, ldb; };

struct Sched {
    int nM, nN, nwg, G, c, mode, lda, ldb, base;
    __device__ void init(int nM_, int nN_, int G_, int c_, int mode_, int lda_, int ldb_) { nM = nM_; nN = nN_; nwg = nM_ * nN_; G = G_; c = c_; mode = mode_; lda = lda_; ldb = ldb_; base = 0; }
    __device__ bool next(int i, Unit& u) const {
        const long L = (long)base + (long)i * G + c; if (L >= nwg) return false;
        if (mode == 4) {
            { const int x = (int)L & 7, o = ((int)L & 255) >> 3; u.pm = ((int)L >> 8) * 32 + x * 4 + (o >> 3); u.pn = o & 7; }
            u.arow = u.pm * BM; u.brow = u.pn * BM; u.kofs = 0;
            u.aoff = (size_t)u.arow * lda; u.boff = (size_t)u.brow * ldb; return true;
        }
        if (mode == 0 || mode == 3) {
            int wgid = (int)L; { const int q = nwg / NXCD, r = nwg % NXCD, xcd = wgid % NXCD, off = wgid / NXCD; wgid = (xcd < r ? xcd * (q + 1) : r * (q + 1) + (xcd - r) * q) + off; }
            const int nig = WGM * nN, gid = wgid / nig, fm = gid * WGM, gsz = (nM - fm) < WGM ? (nM - fm) : WGM;
            u.pm = fm + ((wgid % nig) % gsz); u.pn = (wgid % nig) / gsz; u.arow = u.pm * BM; u.brow = u.pn * BM; u.kofs = 0;
        } else if (mode == 1) {
            const int g = (int)L / nM, mi = (int)L % nM; u.pm = mi; u.pn = g; u.arow = g * GROWS + mi * BM; u.brow = g * BM; u.kofs = 0;
        } else {
            const int tile = (int)L % nM, ks = (int)L / nM; u.pm = tile >> 2; u.pn = tile & 3; u.arow = u.pm * BM; u.brow = u.pn * BM; u.kofs = ks * 256;
        }
        u.aoff = (size_t)u.arow * lda + u.kofs;
        u.boff = (mode == 3) ? (size_t)((u.pn >> 4) * 4096 + (u.pn & 15)) * 1024 : (size_t)u.brow * ldb + u.kofs;
        return true;
    }
};

template <class T, class = void> struct epi_after_drain { static constexpr bool value = false; };
template <class T> struct epi_after_drain<T, decltype((void)T::AFTER_DRAIN)> { static constexpr bool value = T::AFTER_DRAIN; };
#ifndef GP_ALIGN
#define GP_ALIGN true
#endif
#ifndef GP_SP2
#define GP_SP2 true
#endif
template <class Epi, bool ALIGN_EPI = GP_ALIGN, bool SP2 = GP_SP2>
__device__ __forceinline__ void gemm_phase(LAS unsigned char* lds, const Gemm g, const Sched& S, const Epi& E) {
    const int tid = otid(), wid = __builtin_amdgcn_readfirstlane(tid >> 6), lane = tid & 63, wr = wid >> 2, wc = wid & 3, fr = lane & 15, fq = lane >> 4;
    const int K = g.K, nt = K / BK;
    unsigned voffA[2], voffB[2];
#pragma unroll
    for (int i = 0; i < 2; ++i) { int R, C; stage_rc(tid * 16 + i * 8192, R, C); const int Rb = (R & ~31) + perm32(R & 31);
        voffA[i] = (unsigned)(R * g.lda + C) * 2u; voffB[i] = (unsigned)(Rb * g.ldb + C) * 2u; }
    const size_t kstep = (size_t)(BK * 2);
    const size_t hstepA = (size_t)HALF * g.lda * 2, hstepB = (size_t)HALF * g.ldb * 2;
    const unsigned ldsw = (unsigned)wid * 1024u;
    const int aoff = lds_byte(wr * 64 + fr, fq * 8), boff = lds_byte(wc * 32 + fr, fq * 8);
#define PG8_SA(b, h) (((b) * 2 + (h)) * HTB)
#define PG8_SB(b, h) ((4 + (b) * 2 + (h)) * HTB)
#define PG8_STAGE(bufoff, gbase, voff) do { _Pragma("unroll") for (int _i = 0; _i < 2; ++_i) \
        __builtin_amdgcn_global_load_lds((const unsigned*)((const char*)(gbase) + (voff)[_i]), (LAS unsigned*)(lds + (bufoff) + ldsw + _i * 8192), 16, 0, 0); } while (0)
#define PG8_LDA(dst, b, h) do { _Pragma("unroll") for (int m = 0; m < 4; ++m) _Pragma("unroll") for (int k = 0; k < 2; ++k) dst[m][k] = *(const LAS bf16x8*)(lds + PG8_SA(b, h) + aoff + m * 2048 + k * 1024); } while (0)
#define PG8_LDB(dst, b, h) do { _Pragma("unroll") for (int n = 0; n < 2; ++n) _Pragma("unroll") for (int k = 0; k < 2; ++k) dst[n][k] = *(const LAS bf16x8*)(lds + PG8_SB(b, h) + boff + n * 2048 + k * 1024); } while (0)
#define PG8_MMA(ai, bj, At, Bt) do { __builtin_amdgcn_s_setprio(1); _Pragma("unroll") for (int m = 0; m < 4; ++m) _Pragma("unroll") for (int n = 0; n < 2; ++n) _Pragma("unroll") for (int k = 0; k < 2; ++k) \
        acc[ai][bj][m][n] = __builtin_amdgcn_mfma_f32_16x16x32_bf16(Bt[n][k], At[m][k], acc[ai][bj][m][n], 0, 0, 0); __builtin_amdgcn_s_setprio(0); } while (0)
#define PG8_WAIT_V(n) asm volatile("s_waitcnt vmcnt(" #n ")" ::: "memory")
#define PG8_WAIT_L(n) asm volatile("s_waitcnt lgkmcnt(" #n ")" ::: "memory")
#define PG8_BAR __builtin_amdgcn_s_barrier()
#define PG8_SCHED __builtin_amdgcn_sched_barrier(0)
    Unit cur, nxt; int ui = 0;
    if (!S.next(0, cur)) return;
    f32x4 acc[2][2][4][2];
#pragma unroll
    for (int a = 0; a < 2; ++a)
#pragma unroll
        for (int b = 0; b < 2; ++b)
#pragma unroll
            for (int m = 0; m < 4; ++m)
#pragma unroll
                for (int n = 0; n < 2; ++n) acc[a][b][m][n] = (f32x4){0.f, 0.f, 0.f, 0.f};
    bf16x8 At[4][2], B0[2][2], B1[2][2];
    const char* cA = (const char*)g.A + cur.aoff * 2; const char* cB = (const char*)g.Bt + cur.boff * 2;
    if constexpr (SP2) {
        PG8_STAGE(PG8_SB(0, 0), cB, voffB); PG8_STAGE(PG8_SB(0, 1), cB + hstepB, voffB); PG8_STAGE(PG8_SA(0, 0), cA, voffA); PG8_STAGE(PG8_SA(0, 1), cA + hstepA, voffA);
        if (wr == 1) PG8_BAR;
        PG8_WAIT_V(2); PG8_BAR;
        PG8_STAGE(PG8_SB(1, 0), cB + kstep, voffB); PG8_STAGE(PG8_SA(1, 0), cA + kstep, voffA); PG8_STAGE(PG8_SB(1, 1), cB + hstepB + kstep, voffB);
        PG8_WAIT_V(6); PG8_BAR;
    } else {
        PG8_STAGE(PG8_SB(0, 0), cB, voffB); PG8_STAGE(PG8_SA(0, 0), cA, voffA); PG8_STAGE(PG8_SB(0, 1), cB + hstepB, voffB); PG8_STAGE(PG8_SA(0, 1), cA + hstepA, voffA);
        if (wr == 1) PG8_BAR;
        PG8_WAIT_V(4); PG8_BAR;
        PG8_STAGE(PG8_SB(1, 0), cB + kstep, voffB); PG8_STAGE(PG8_SA(1, 0), cA + kstep, voffA); PG8_STAGE(PG8_SB(1, 1), cB + hstepB + kstep, voffB);
        PG8_WAIT_V(6); PG8_BAR;
    }
    for (;;) {
        const bool has_next = S.next(ui + 1, nxt);
        const char* nA = has_next ? (const char*)g.A + nxt.aoff * 2 : cA; const char* nB = has_next ? (const char*)g.Bt + nxt.boff * 2 : cB;
        for (int t = 0; t < nt; t += 2) {
            const bool last = (t == nt - 2);
            const char* a1 = cA + (size_t)(t + 1) * kstep;
            const char* a2 = last ? nA : cA + (size_t)(t + 2) * kstep; const char* b2 = last ? nB : cB + (size_t)(t + 2) * kstep;
            const char* a3 = a2 + kstep; const char* b3 = b2 + kstep;
            if constexpr (SP2) {
            PG8_LDB(B0, 0, 0); PG8_LDB(B1, 0, 1); PG8_SCHED; PG8_LDA(At, 0, 0); PG8_STAGE(PG8_SA(1, 1), a1 + hstepA, voffA);
            PG8_WAIT_V(8); PG8_WAIT_L(0); PG8_BAR; PG8_MMA(0, 0, At, B0); PG8_MMA(0, 1, At, B1); PG8_BAR; PG8_SCHED;
            PG8_LDA(At, 0, 1); PG8_STAGE(PG8_SB(0, 0), b2, voffB); PG8_STAGE(PG8_SB(0, 1), b2 + hstepB, voffB); PG8_STAGE(PG8_SA(0, 0), a2, voffA);
            PG8_WAIT_V(8); PG8_WAIT_L(0); PG8_BAR; PG8_MMA(1, 0, At, B0); PG8_MMA(1, 1, At, B1); PG8_BAR; PG8_SCHED;
            PG8_LDB(B0, 1, 0); PG8_LDB(B1, 1, 1); PG8_SCHED; PG8_LDA(At, 1, 0); PG8_STAGE(PG8_SA(0, 1), a2 + hstepA, voffA);
            PG8_WAIT_V(8); PG8_WAIT_L(0); PG8_BAR; PG8_MMA(0, 0, At, B0); PG8_MMA(0, 1, At, B1); PG8_BAR; PG8_SCHED;
            PG8_LDA(At, 1, 1); PG8_STAGE(PG8_SB(1, 0), b3, voffB); PG8_STAGE(PG8_SB(1, 1), b3 + hstepB, voffB); PG8_STAGE(PG8_SA(1, 0), a3, voffA);
            PG8_WAIT_V(8); PG8_WAIT_L(0); PG8_BAR; PG8_MMA(1, 0, At, B0); PG8_MMA(1, 1, At, B1); PG8_BAR; PG8_SCHED;
            } else {
            PG8_LDB(B0, 0, 0); PG8_SCHED; PG8_LDA(At, 0, 0); PG8_STAGE(PG8_SA(1, 1), a1 + hstepA, voffA);
            PG8_WAIT_L(8); PG8_BAR; PG8_WAIT_L(0); PG8_MMA(0, 0, At, B0); PG8_BAR; PG8_SCHED;
            PG8_LDB(B1, 0, 1); PG8_STAGE(PG8_SB(0, 0), b2, voffB);
            PG8_BAR; PG8_WAIT_L(0); PG8_MMA(0, 1, At, B1); PG8_BAR;
            PG8_LDA(At, 0, 1); PG8_STAGE(PG8_SA(0, 0), a2, voffA);
            PG8_BAR; PG8_WAIT_L(0); PG8_MMA(1, 0, At, B0); PG8_BAR; PG8_SCHED;
            PG8_STAGE(PG8_SB(0, 1), b2 + hstepB, voffB);
            PG8_WAIT_V(6); PG8_BAR; PG8_MMA(1, 1, At, B1); PG8_BAR;
            PG8_LDB(B0, 1, 0); PG8_SCHED; PG8_LDA(At, 1, 0); PG8_STAGE(PG8_SA(0, 1), a2 + hstepA, voffA);
            PG8_WAIT_L(8); PG8_BAR; PG8_WAIT_L(0); PG8_MMA(0, 0, At, B0); PG8_BAR; PG8_SCHED;
            PG8_LDB(B1, 1, 1); PG8_STAGE(PG8_SB(1, 0), b3, voffB);
            PG8_BAR; PG8_WAIT_L(0); PG8_MMA(0, 1, At, B1); PG8_BAR;
            PG8_LDA(At, 1, 1); PG8_STAGE(PG8_SA(1, 0), a3, voffA);
            PG8_BAR; PG8_WAIT_L(0); PG8_MMA(1, 0, At, B0); PG8_BAR; PG8_SCHED;
            PG8_STAGE(PG8_SB(1, 1), b3 + hstepB, voffB);
            PG8_WAIT_V(6); PG8_BAR; PG8_MMA(1, 1, At, B1); PG8_BAR;
                    }
        }
        if constexpr (ALIGN_EPI) { if (wr == 0) PG8_BAR; }
        if constexpr (!epi_after_drain<Epi>::value) E(acc, cur, wr, wc, fr, fq);
        if (!has_next) break;
#pragma unroll
        for (int a = 0; a < 2; ++a)
#pragma unroll
            for (int b = 0; b < 2; ++b)
#pragma unroll
                for (int m = 0; m < 4; ++m)
#pragma unroll
                    for (int n = 0; n < 2; ++n) acc[a][b][m][n] = (f32x4){0.f, 0.f, 0.f, 0.f};
        cur = nxt; cA = nA; cB = nB; ++ui;
        if constexpr (ALIGN_EPI) { if (wr == 1) PG8_BAR; }
    }
    PG8_WAIT_V(0);
    if constexpr (!ALIGN_EPI) { if (wr == 0) PG8_BAR; }
    PG8_BAR;
    if constexpr (epi_after_drain<Epi>::value) E.fused(acc, cur, wr, wc, fr, fq, lds, wid, lane);
#undef PG8_SA
#undef PG8_SB
#undef PG8_STAGE
#undef PG8_LDA
#undef PG8_LDB
#undef PG8_MMA
#undef PG8_WAIT_V
#undef PG8_WAIT_L
#undef PG8_BAR
#undef PG8_SCHED
}
}
using pg8::Unit;
typedef f32x4 Acc[2][2][4][2];

struct EpiInA {
    bf16_t *ZT, *ZTc; int tk0, perm;
    __device__ __forceinline__ void operator()(const Acc& acc, const Unit& u, int wr, int wc, int fr, int fq) const {
#pragma unroll
        for (int ai = 0; ai < 2; ++ai)
#pragma unroll
            for (int m = 0; m < 4; ++m) {
                const int r = u.arow + ai * 128 + wr * 64 + m * 16 + fr;
                const int c = r & 511, cs = r >> 9;
#pragma unroll
                for (int bj = 0; bj < 2; ++bj) {
                    const int tk = tk0 + u.brow + bj * 128 + wc * 32 + fq * 8;
                    bf16_t* dst;
                    if (perm) { const int b = tk >> 12, rr = (tk >> 8) & 15, tp = tk & 255; dst = ZT + ((size_t)((b * 512 + c) * 16 + rr) * 512 + cs * 256 + tp); }
                    else { const int b = (tk - NLAT) >> 8, t = tk & 255; dst = ZTc + ((size_t)(b * 512 + c) * 512 + cs * 256 + t); }
                    *(u32x4*)dst = pack8(acc[ai][bj][m][0], acc[ai][bj][m][1]);
                }
            }
    }
};
struct EpiInB {
    bf16_t *Q, *Kb; const float *ropeC, *ropeS; bf16_t *VT, *VTc;
    __device__ __forceinline__ void operator()(const Acc& acc, const Unit& u, int wr, int wc, int fr, int fq) const {
#pragma unroll
        for (int ai = 0; ai < 2; ++ai)
#pragma unroll
            for (int m = 0; m < 4; ++m) {
                const int tok = u.arow + ai * 128 + wr * 64 + m * 16 + fr;
                const bool lat = tok < NLAT; const int pos = tok & 4095, prow = pos >> 6, pcol = pos & 63;
#pragma unroll
                for (int bj = 0; bj < 2; ++bj) {
                    const int col = u.brow + bj * 128 + wc * 32 + fq * 8;
                    f32x4 v0 = acc[ai][bj][m][0], v1 = acc[ai][bj][m][1];
                    if (col >= 640) {
                        const int dv = col - 640, kvh = dv >> 6, d = dv & 63, dt = d >> 5, rl0 = d & 31;
                        int b, t; if (lat) { b = tok >> 12; t = tok & 4095; } else { b = (tok - NLAT) >> 8; t = tok & 255; }
                        const int tile = t >> 5, s = (t >> 4) & 1, k16 = t & 15, hh = (k16 >> 2) & 1, j = ((k16 >> 3) << 2) | (k16 & 3);
                        bf16_t* vb = (lat ? VT + (size_t)((b * 2 + kvh) * 128 + tile) * 2048 : VTc + (size_t)((b * 2 + kvh) * 8 + tile) * 2048) + (dt * 2 + s) * 512 + (hh * 32 + rl0) * 8 + j;
                        const u32x4 w = pack8(v0, v1);
                        vb[0] = (bf16_t)(w.x & 0xFFFFu); vb[8] = (bf16_t)(w.x >> 16); vb[16] = (bf16_t)(w.y & 0xFFFFu); vb[24] = (bf16_t)(w.y >> 16);
                        vb[32] = (bf16_t)(w.z & 0xFFFFu); vb[40] = (bf16_t)(w.z >> 16); vb[48] = (bf16_t)(w.w & 0xFFFFu); vb[56] = (bf16_t)(w.w >> 16);
                        continue;
                    }
                    if (lat) {
                        const int i0 = (col & 63) >> 1, pp = (i0 < 16) ? prow : pcol, f0 = i0 & 15;
                        const f32x4 cs = *(const f32x4*)(ropeC + pp * 16 + f0), sn = *(const f32x4*)(ropeS + pp * 16 + f0);
                        f32x4 w0, w1;
                        w0[0] = v0[0] * cs[0] - v0[1] * sn[0]; w0[1] = v0[0] * sn[0] + v0[1] * cs[0];
                        w0[2] = v0[2] * cs[1] - v0[3] * sn[1]; w0[3] = v0[2] * sn[1] + v0[3] * cs[1];
                        w1[0] = v1[0] * cs[2] - v1[1] * sn[2]; w1[1] = v1[0] * sn[2] + v1[1] * cs[2];
                        w1[2] = v1[2] * cs[3] - v1[3] * sn[3]; w1[3] = v1[2] * sn[3] + v1[3] * cs[3];
                        v0 = w0; v1 = w1;
                    }
                    bf16_t* dst = (col < 512) ? Q + (size_t)tok * 512 + col : Kb + (size_t)tok * 128 + (col - 512);
                    *(u32x4*)dst = pack8(v0, v1);
                }
            }
    }
};
struct EpiDft {
    bf16_t* MIX; int isctx;
    __device__ __forceinline__ void operator()(const Acc& acc, const Unit& u, int wr, int wc, int fr, int fq) const {
#pragma unroll
        for (int ai = 0; ai < 2; ++ai)
#pragma unroll
            for (int m = 0; m < 4; ++m) {
                const int k = u.arow + ai * 128 + wr * 64 + m * 16 + fr;
#pragma unroll
                for (int bj = 0; bj < 2; ++bj) {
                    const int col = u.brow + bj * 128 + wc * 32 + fq * 8; const int b = col >> 9, c = col & 511;
                    const size_t trow = isctx ? (size_t)(NLAT + b * 256 + k) : (size_t)(b * 4096 + k);
                    *(u32x4*)(MIX + trow * 1024 + c) = pack8(acc[ai][bj][m][0], acc[ai][bj][m][1]);
                }
            }
    }
};
struct EpiI2 {
    bf16_t* I2;
    __device__ __forceinline__ void operator()(const Acc& acc, const Unit& u, int wr, int wc, int fr, int fq) const {
#pragma unroll
        for (int ai = 0; ai < 2; ++ai)
#pragma unroll
            for (int m = 0; m < 4; ++m) {
                const int row = u.arow + ai * 128 + wr * 64 + m * 16 + fr;
#pragma unroll
                for (int bj = 0; bj < 2; ++bj) {
                    const int col = u.brow + bj * 128 + wc * 32 + fq * 8;
                    *(u32x4*)(I2 + (size_t)row * 32768 + col) = pack8(acc[ai][bj][m][0], acc[ai][bj][m][1]);
                }
            }
    }
};
struct EpiRes {
    const float *in_lat, *in_ctx; float *out_lat, *out_ctx; const float* gate;
    __device__ __forceinline__ void operator()(const Acc& acc, const Unit& u, int wr, int wc, int fr, int fq) const {
        const int row0 = u.arow + wr * 64 + fr, col0 = u.brow + wc * 32 + fq * 8;
        const bool lat = row0 < NLAT;
        const int b = lat ? (row0 >> 12) : 4;
        const float* ip = lat ? in_lat + (size_t)row0 * 1024 + col0 : in_ctx + (size_t)(row0 - NLAT) * 1024 + col0;
        float* op = lat ? out_lat + (size_t)row0 * 1024 + col0 : out_ctx + (size_t)(row0 - NLAT) * 1024 + col0;
        const float* gp = gate + b * 6144 + col0;
        f32x4 gv[2][2];
#pragma unroll
        for (int bj = 0; bj < 2; ++bj)
#pragma unroll
            for (int n = 0; n < 2; ++n) gv[bj][n] = *(const f32x4*)(gp + bj * 128 + 4 * n);
#pragma unroll
        for (int ai = 0; ai < 2; ++ai)
#pragma unroll
            for (int mh = 0; mh < 2; ++mh) {
                f32x4 hv[2][2][2];
#pragma unroll
                for (int mm = 0; mm < 2; ++mm)
#pragma unroll
                    for (int bj = 0; bj < 2; ++bj)
#pragma unroll
                        for (int n = 0; n < 2; ++n) hv[mm][bj][n] = *(const f32x4*)(ip + (size_t)(ai * 128 + (mh * 2 + mm) * 16) * 1024 + bj * 128 + 4 * n);
#pragma unroll
                for (int mm = 0; mm < 2; ++mm)
#pragma unroll
                    for (int bj = 0; bj < 2; ++bj)
#pragma unroll
                        for (int n = 0; n < 2; ++n) *(f32x4*)(op + (size_t)(ai * 128 + (mh * 2 + mm) * 16) * 1024 + bj * 128 + 4 * n) = hv[mm][bj][n] + gv[bj][n] * acc[ai][bj][mh * 2 + mm][n];
            }
    }
};
struct EpiResFinal {
    static constexpr bool AFTER_DRAIN = true;
    const bf16_t* Hb; float* out; const float* gate; const float* fg; float* xss; unsigned* pcnt; unsigned* tmo;
    __device__ __forceinline__ void fused(Acc& acc, const Unit& u, int wr, int wc, int fr, int fq, LAS unsigned char* lds, int wid, int lane) const {
        LAS float* P = (LAS float*)lds;
        LAS float* S = (LAS float*)(lds + 8192);
        const int row0 = u.arow + wr * 64 + fr, col0 = u.brow + wc * 32 + fq * 8;
        const bf16_t* ip = Hb + (size_t)row0 * 1024 + col0; float* op = out + (size_t)row0 * 1024 + col0;
        const float* gp = gate + (row0 >> 12) * 6144 + col0;
        f32x4 gv[2][2];
#pragma unroll
        for (int bj = 0; bj < 2; ++bj)
#pragma unroll
            for (int n = 0; n < 2; ++n) gv[bj][n] = *(const f32x4*)(gp + bj * 128 + 4 * n);
#pragma unroll
        for (int ai = 0; ai < 2; ++ai)
#pragma unroll
            for (int m = 0; m < 4; ++m) {
                float s = 0.f;
#pragma unroll
                for (int bj = 0; bj < 2; ++bj) {
                    const u32x4 hw = *(const u32x4*)(ip + (size_t)(ai * 128 + m * 16) * 1024 + bj * 128);
                    const f32x4 hv2[2] = {{__uint_as_float(hw.x << 16), __uint_as_float(hw.x & 0xFFFF0000u), __uint_as_float(hw.y << 16), __uint_as_float(hw.y & 0xFFFF0000u)},
                                          {__uint_as_float(hw.z << 16), __uint_as_float(hw.z & 0xFFFF0000u), __uint_as_float(hw.w << 16), __uint_as_float(hw.w & 0xFFFF0000u)}};
#pragma unroll
                    for (int n = 0; n < 2; ++n) {
                        const f32x4 hv = hv2[n];
                        const f32x4 h = hv + gv[bj][n] * acc[ai][bj][m][n]; acc[ai][bj][m][n] = h;
                        s += (h[0] * h[0] + h[1] * h[1]) + (h[2] * h[2] + h[3] * h[3]);
                    }
                }
                s += __shfl_xor(s, 16); s += __shfl_xor(s, 32);
                if (fq == 0) P[(ai * 128 + wr * 64 + m * 16 + fr) * 4 + wc] = s;
            }
        asm volatile("s_waitcnt lgkmcnt(0)" ::: "memory"); __builtin_amdgcn_s_barrier(); asm volatile("" ::: "memory");
        const int row = wid * 32 + (lane & 31);
        if (lane < 32) {
            const float t = (P[row * 4 + 0] + P[row * 4 + 1]) + (P[row * 4 + 2] + P[row * 4 + 3]);
            __hip_atomic_store((unsigned*)xss + ((size_t)(u.arow + row) * 4 + u.pn), __float_as_uint(t), __ATOMIC_RELAXED, __HIP_MEMORY_SCOPE_AGENT);
        }
        asm volatile("s_waitcnt vmcnt(0)" ::: "memory");
        if (lane == 0) __hip_atomic_fetch_add(pcnt + 64 * u.pm, 1u, __ATOMIC_RELAXED, __HIP_MEMORY_SCOPE_AGENT);
        if (wid == 0) {
            unsigned sp = 0;
            while ((unsigned)__builtin_amdgcn_readfirstlane(__hip_atomic_load(pcnt + 64 * u.pm, __ATOMIC_RELAXED, __HIP_MEMORY_SCOPE_AGENT)) < 32u) {
                __builtin_amdgcn_s_sleep(2);
                if ((++sp & 1023u) == 0u) { if (__hip_atomic_load(tmo, __ATOMIC_RELAXED, __HIP_MEMORY_SCOPE_AGENT) != 0u) break; if (sp > (1u << 22)) { if (lane == 0) atomicAdd(tmo, 1u); break; } }
            }
            __builtin_amdgcn_fence(__ATOMIC_ACQUIRE, "agent");
        }
        asm volatile("s_waitcnt vmcnt(0) lgkmcnt(0)" ::: "memory"); __builtin_amdgcn_s_barrier(); asm volatile("" ::: "memory");
        if (lane < 32) {
            const unsigned* slot = (const unsigned*)xss + (size_t)(u.arow + row) * 4; float t = 0.f;
#pragma unroll
            for (int q = 0; q < 4; ++q) t += __uint_as_float(__hip_atomic_load(slot + q, __ATOMIC_RELAXED, __HIP_MEMORY_SCOPE_AGENT));
            S[row] = rsqrtf(t * (1.0f / 1024.0f) + 1e-6f);
        }
        asm volatile("s_waitcnt lgkmcnt(0)" ::: "memory"); __builtin_amdgcn_s_barrier(); asm volatile("" ::: "memory");
        f32x4 fv[2][2];
#pragma unroll
        for (int bj = 0; bj < 2; ++bj)
#pragma unroll
            for (int n = 0; n < 2; ++n) fv[bj][n] = *(const f32x4*)(fg + col0 + bj * 128 + 4 * n);
#pragma unroll
        for (int ai = 0; ai < 2; ++ai)
#pragma unroll
            for (int m = 0; m < 4; ++m) {
                const float rinv = S[ai * 128 + wr * 64 + m * 16 + fr];
#pragma unroll
                for (int bj = 0; bj < 2; ++bj)
#pragma unroll
                    for (int n = 0; n < 2; ++n) *(f32x4*)(op + (size_t)(ai * 128 + m * 16) * 1024 + bj * 128 + 4 * n) = acc[ai][bj][m][n] * rinv * fv[bj][n];
            }
    }
};
struct EpiResNorm {
    static constexpr bool AFTER_DRAIN = true;
    const float* X; bf16_t* Hb; const float* gate; const float* ng; const float* mods_l; bf16_t* XNo; float* xss; unsigned* pcnt; unsigned* tmo;
    __device__ __forceinline__ void fused(Acc& acc, const Unit& u, int wr, int wc, int fr, int fq, LAS unsigned char* lds, int wid, int lane) const {
        LAS float* P = (LAS float*)lds; LAS float* S = (LAS float*)(lds + 8192);
        const int row0 = u.arow + wr * 64 + fr, col0 = u.brow + wc * 32 + fq * 8, b = row0 >> 12;
        const float* ip = X + (size_t)row0 * 1024 + col0; bf16_t* op = Hb + (size_t)row0 * 1024 + col0;
        {
            const float* gp = gate + b * 6144 + col0; f32x4 gv[2][2];
#pragma unroll
            for (int bj = 0; bj < 2; ++bj)
#pragma unroll
                for (int n = 0; n < 2; ++n) gv[bj][n] = *(const f32x4*)(gp + bj * 128 + 4 * n);
#pragma unroll
            for (int ai = 0; ai < 2; ++ai)
#pragma unroll
                for (int m = 0; m < 4; ++m) {
                    float s = 0.f;
#pragma unroll
                    for (int bj = 0; bj < 2; ++bj)
#pragma unroll
                        for (int n = 0; n < 2; ++n) {
                            const f32x4 hv = *(const f32x4*)(ip + (size_t)(ai * 128 + m * 16) * 1024 + bj * 128 + 4 * n);
                            const f32x4 h = hv + gv[bj][n] * acc[ai][bj][m][n]; acc[ai][bj][m][n] = h;
                            s += (h[0] * h[0] + h[1] * h[1]) + (h[2] * h[2] + h[3] * h[3]);
                        }
#pragma unroll
                    for (int bj = 0; bj < 2; ++bj) *(u32x4*)(op + (size_t)(ai * 128 + m * 16) * 1024 + bj * 128) = pack8(acc[ai][bj][m][0], acc[ai][bj][m][1]);
                    s += __shfl_xor(s, 16); s += __shfl_xor(s, 32);
                    if (fq == 0) P[(ai * 128 + wr * 64 + m * 16 + fr) * 4 + wc] = s;
                }
        }
        asm volatile("s_waitcnt lgkmcnt(0)" ::: "memory"); __builtin_amdgcn_s_barrier(); asm volatile("" ::: "memory");
        const int row = wid * 32 + (lane & 31);
        if (lane < 32) {
            const float t = (P[row * 4 + 0] + P[row * 4 + 1]) + (P[row * 4 + 2] + P[row * 4 + 3]);
            __hip_atomic_store((unsigned*)xss + ((size_t)(u.arow + row) * 4 + u.pn), __float_as_uint(t), __ATOMIC_RELAXED, __HIP_MEMORY_SCOPE_AGENT);
        }
        asm volatile("s_waitcnt vmcnt(0)" ::: "memory");
        if (lane == 0) __hip_atomic_fetch_add(pcnt + 64 * u.pm, 1u, __ATOMIC_RELAXED, __HIP_MEMORY_SCOPE_AGENT);
        if (wid == 0) {
            unsigned sp = 0;
            while ((unsigned)__builtin_amdgcn_readfirstlane(__hip_atomic_load(pcnt + 64 * u.pm, __ATOMIC_RELAXED, __HIP_MEMORY_SCOPE_AGENT)) < 32u) {
                __builtin_amdgcn_s_sleep(2);
                if ((++sp & 1023u) == 0u) { if (__hip_atomic_load(tmo, __ATOMIC_RELAXED, __HIP_MEMORY_SCOPE_AGENT) != 0u) break; if (sp > (1u << 22)) { if (lane == 0) atomicAdd(tmo, 1u); break; } }
            }
            __builtin_amdgcn_fence(__ATOMIC_ACQUIRE, "agent");
        }
        asm volatile("s_waitcnt vmcnt(0) lgkmcnt(0)" ::: "memory"); __builtin_amdgcn_s_barrier(); asm volatile("" ::: "memory");
        if (lane < 32) {
            const unsigned* slot = (const unsigned*)xss + (size_t)(u.arow + row) * 4; float t = 0.f;
#pragma unroll
            for (int q = 0; q < 4; ++q) t += __uint_as_float(__hip_atomic_load(slot + q, __ATOMIC_RELAXED, __HIP_MEMORY_SCOPE_AGENT));
            S[row] = rsqrtf(t * (1.0f / 1024.0f) + 1e-6f);
        }
        asm volatile("s_waitcnt lgkmcnt(0)" ::: "memory"); __builtin_amdgcn_s_barrier(); asm volatile("" ::: "memory");
        bf16_t* xp = XNo + (size_t)row0 * 1024 + col0;
#pragma unroll
        for (int bj = 0; bj < 2; ++bj) {
            f32x4 mv[2], sv[2];
#pragma unroll
            for (int n = 0; n < 2; ++n) { const int c = col0 + bj * 128 + 4 * n; const f32x4 g4 = *(const f32x4*)(ng + c), s4 = *(const f32x4*)(mods_l + (size_t)b * 6144 + 4 * 1024 + c); sv[n] = *(const f32x4*)(mods_l + (size_t)b * 6144 + 3 * 1024 + c);
#pragma unroll
                for (int j = 0; j < 4; ++j) mv[n][j] = g4[j] * (1.0f + s4[j]); }
#pragma unroll
            for (int ai = 0; ai < 2; ++ai)
#pragma unroll
                for (int m = 0; m < 4; ++m) {
                    const float rinv = S[ai * 128 + wr * 64 + m * 16 + fr];
                    const f32x4 y0 = acc[ai][bj][m][0] * rinv * mv[0] + sv[0], y1 = acc[ai][bj][m][1] * rinv * mv[1] + sv[1];
                    *(u32x4*)(xp + (size_t)(ai * 128 + m * 16) * 1024 + bj * 128) = pack8(y0, y1);
                }
        }
    }
};
struct EpiResB {
    const bf16_t* Hb; float* out; const float* gate;
    __device__ __forceinline__ void operator()(const Acc& acc, const Unit& u, int wr, int wc, int fr, int fq) const {
        const int row0 = u.arow + wr * 64 + fr, col0 = u.brow + wc * 32 + fq * 8, b = row0 >> 12;
        const bf16_t* ip = Hb + (size_t)row0 * 1024 + col0; float* op = out + (size_t)row0 * 1024 + col0;
        const float* gp = gate + b * 6144 + col0;
        f32x4 gv[2][2];
#pragma unroll
        for (int bj = 0; bj < 2; ++bj)
#pragma unroll
            for (int n = 0; n < 2; ++n) gv[bj][n] = *(const f32x4*)(gp + bj * 128 + 4 * n);
#pragma unroll
        for (int ai = 0; ai < 2; ++ai) {
            u32x4 hw[4][2];
#pragma unroll
            for (int m = 0; m < 4; ++m)
#pragma unroll
                for (int bj = 0; bj < 2; ++bj) hw[m][bj] = *(const u32x4*)(ip + (size_t)(ai * 128 + m * 16) * 1024 + bj * 128);
#pragma unroll
            for (int m = 0; m < 4; ++m)
#pragma unroll
                for (int bj = 0; bj < 2; ++bj) {
                    const u32x4 w = hw[m][bj];
                    const f32x4 h0 = {__uint_as_float(w.x << 16), __uint_as_float(w.x & 0xFFFF0000u), __uint_as_float(w.y << 16), __uint_as_float(w.y & 0xFFFF0000u)};
                    const f32x4 h1 = {__uint_as_float(w.z << 16), __uint_as_float(w.z & 0xFFFF0000u), __uint_as_float(w.w << 16), __uint_as_float(w.w & 0xFFFF0000u)};
                    const f32x4 o0 = h0 + gv[bj][0] * acc[ai][bj][m][0], o1 = h1 + gv[bj][1] * acc[ai][bj][m][1];
                    if (out) { float* q = op + (size_t)(ai * 128 + m * 16) * 1024 + bj * 128; *(f32x4*)q = o0; *(f32x4*)(q + 4) = o1; }
                    else *(u32x4*)(const_cast<bf16_t*>(ip) + (size_t)(ai * 128 + m * 16) * 1024 + bj * 128) = pack8(o0, o1);
                }
        }
    }
};
struct EpiPart {
    bf16_t* slab;
    __device__ __forceinline__ void operator()(const Acc& acc, const Unit& u, int wr, int wc, int fr, int fq) const {
        bf16_t* base = slab + (size_t)(u.kofs >> 8) * 1024 * 1024;
#pragma unroll
        for (int ai = 0; ai < 2; ++ai)
#pragma unroll
            for (int m = 0; m < 4; ++m) {
                const int row = u.arow + ai * 128 + wr * 64 + m * 16 + fr;
                bf16_t* op = base + (size_t)row * 1024;
#pragma unroll
                for (int bj = 0; bj < 2; ++bj) *(u32x4*)(op + u.brow + bj * 128 + wc * 32 + fq * 8) = pack8(acc[ai][bj][m][0], acc[ai][bj][m][1]);
            }
    }
};
struct EpiSwiglu {
    bf16_t* ACT;
    __device__ __forceinline__ void operator()(const Acc& acc, const Unit& u, int wr, int wc, int fr, int fq) const {
#pragma unroll
        for (int ai = 0; ai < 2; ++ai)
#pragma unroll
            for (int m = 0; m < 4; ++m) {
                const int row = u.arow + ai * 128 + wr * 64 + m * 16 + fr;
                const int col = u.pn * 128 + wc * 32 + fq * 8;
                f32x4 o0, o1;
#pragma unroll
                for (int j = 0; j < 4; ++j) { o0[j] = siluf_(acc[ai][0][m][0][j]) * acc[ai][1][m][0][j]; o1[j] = siluf_(acc[ai][0][m][1][j]) * acc[ai][1][m][1][j]; }
                *(u32x4*)(ACT + (size_t)row * FF + col) = pack8(o0, o1);
            }
    }
};
struct EpiGlu {
    float* H; const float* gate;
    __device__ __forceinline__ void operator()(const Acc& acc, const Unit& u, int wr, int wc, int fr, int fq) const {
        const int b = u.arow >> 12; const int col = u.pn * 128 + wc * 32 + fq * 8;
        const float* gp = gate + b * 6144 + col;
        float* hp0 = H + (size_t)(u.arow + wr * 64 + fr) * 1024 + col;
        f32x4 gv[2];
#pragma unroll
        for (int n = 0; n < 2; ++n) gv[n] = *(const f32x4*)(gp + 4 * n);
#pragma unroll
        for (int ai = 0; ai < 2; ++ai) {
            f32x4 hv[4][2];
#pragma unroll
            for (int m = 0; m < 4; ++m)
#pragma unroll
                for (int n = 0; n < 2; ++n) hv[m][n] = *(const f32x4*)(hp0 + (size_t)(ai * 128 + m * 16) * 1024 + 4 * n);
#pragma unroll
            for (int m = 0; m < 4; ++m)
#pragma unroll
                for (int n = 0; n < 2; ++n) {
                    f32x4 o;
#pragma unroll
                    for (int j = 0; j < 4; ++j) o[j] = hv[m][n][j] + gv[n][j] * (acc[ai][0][m][n][j] * sigmoidf_(acc[ai][1][m][n][j]));
                    *(f32x4*)(hp0 + (size_t)(ai * 128 + m * 16) * 1024 + 4 * n) = o;
                }
        }
    }
};
struct EpiGluNorm {
    static constexpr bool AFTER_DRAIN = true;
    float* H; const float* gate; const float* ng; const float* mods_l; bf16_t* XNo; float* xss; unsigned* pcnt; unsigned* tmo; const bf16_t* Hb;
    __device__ __forceinline__ void fused(Acc& acc, const Unit& u, int wr, int wc, int fr, int fq, LAS unsigned char* lds, int wid, int lane) const {
        LAS float* P = (LAS float*)lds; LAS float* S = (LAS float*)(lds + 8192);
        const int row0 = u.arow + wr * 64 + fr, col = u.pn * 128 + wc * 32 + fq * 8, b = row0 >> 12;
        float* hp = H + (size_t)row0 * 1024 + col; const bf16_t* hb = Hb + (size_t)row0 * 1024 + col;
        {
            const float* gp = gate + b * 6144 + col; f32x4 gv[2];
#pragma unroll
            for (int n = 0; n < 2; ++n) gv[n] = *(const f32x4*)(gp + 4 * n);
#pragma unroll
            for (int ai = 0; ai < 2; ++ai)
#pragma unroll
                for (int m = 0; m < 4; ++m) {
                    float s = 0.f;
                    const u32x4 hw = *(const u32x4*)(hb + (size_t)(ai * 128 + m * 16) * 1024);
                    const f32x4 hv2[2] = {{__uint_as_float(hw.x << 16), __uint_as_float(hw.x & 0xFFFF0000u), __uint_as_float(hw.y << 16), __uint_as_float(hw.y & 0xFFFF0000u)},
                                          {__uint_as_float(hw.z << 16), __uint_as_float(hw.z & 0xFFFF0000u), __uint_as_float(hw.w << 16), __uint_as_float(hw.w & 0xFFFF0000u)}};
#pragma unroll
                    for (int n = 0; n < 2; ++n) {
                        const f32x4 hv = hv2[n]; f32x4 o;
#pragma unroll
                        for (int j = 0; j < 4; ++j) o[j] = hv[j] + gv[n][j] * (acc[ai][0][m][n][j] * sigmoidf_(acc[ai][1][m][n][j]));
                        acc[ai][0][m][n] = o;
                        s += (o[0] * o[0] + o[1] * o[1]) + (o[2] * o[2] + o[3] * o[3]);
                    }
                    *(u32x4*)(const_cast<bf16_t*>(hb) + (size_t)(ai * 128 + m * 16) * 1024) = pack8(acc[ai][0][m][0], acc[ai][0][m][1]);
                    s += __shfl_xor(s, 16); s += __shfl_xor(s, 32);
                    if (fq == 0) P[(ai * 128 + wr * 64 + m * 16 + fr) * 4 + wc] = s;
                }
        }
        asm volatile("s_waitcnt lgkmcnt(0)" ::: "memory"); __builtin_amdgcn_s_barrier(); asm volatile("" ::: "memory");
        const int row = wid * 32 + (lane & 31);
        if (lane < 32) {
            const float t = (P[row * 4 + 0] + P[row * 4 + 1]) + (P[row * 4 + 2] + P[row * 4 + 3]);
            __hip_atomic_store((unsigned*)xss + ((size_t)(u.arow + row) * 8 + u.pn), __float_as_uint(t), __ATOMIC_RELAXED, __HIP_MEMORY_SCOPE_AGENT);
        }
        asm volatile("s_waitcnt vmcnt(0)" ::: "memory");
        if (lane == 0) __hip_atomic_fetch_add(pcnt + 64 * u.pm, 1u, __ATOMIC_RELAXED, __HIP_MEMORY_SCOPE_AGENT);
        if (wid == 0) {
            unsigned sp = 0;
            while ((unsigned)__builtin_amdgcn_readfirstlane(__hip_atomic_load(pcnt + 64 * u.pm, __ATOMIC_RELAXED, __HIP_MEMORY_SCOPE_AGENT)) < 64u) {
                __builtin_amdgcn_s_sleep(2);
                if ((++sp & 1023u) == 0u) { if (__hip_atomic_load(tmo, __ATOMIC_RELAXED, __HIP_MEMORY_SCOPE_AGENT) != 0u) break; if (sp > (1u << 22)) { if (lane == 0) atomicAdd(tmo, 1u); break; } }
            }
            __builtin_amdgcn_fence(__ATOMIC_ACQUIRE, "agent");
        }
        asm volatile("s_waitcnt vmcnt(0) lgkmcnt(0)" ::: "memory"); __builtin_amdgcn_s_barrier(); asm volatile("" ::: "memory");
        if (lane < 32) {
            const unsigned* slot = (const unsigned*)xss + (size_t)(u.arow + row) * 8; float t = 0.f;
#pragma unroll
            for (int q = 0; q < 8; ++q) t += __uint_as_float(__hip_atomic_load(slot + q, __ATOMIC_RELAXED, __HIP_MEMORY_SCOPE_AGENT));
            S[row] = rsqrtf(t * (1.0f / 1024.0f) + 1e-6f);
        }
        asm volatile("s_waitcnt lgkmcnt(0)" ::: "memory"); __builtin_amdgcn_s_barrier(); asm volatile("" ::: "memory");
        f32x4 mv[2], sv[2];
#pragma unroll
        for (int n = 0; n < 2; ++n) { const int c = col + 4 * n; const f32x4 g4 = *(const f32x4*)(ng + c), s4 = *(const f32x4*)(mods_l + (size_t)b * 6144 + 4 * 1024 + c); sv[n] = *(const f32x4*)(mods_l + (size_t)b * 6144 + 3 * 1024 + c);
#pragma unroll
            for (int j = 0; j < 4; ++j) mv[n][j] = g4[j] * (1.0f + s4[j]); }
        bf16_t* xp = XNo + (size_t)row0 * 1024 + col;
#pragma unroll
        for (int ai = 0; ai < 2; ++ai)
#pragma unroll
            for (int m = 0; m < 4; ++m) {
                const float rinv = S[ai * 128 + wr * 64 + m * 16 + fr];
                const f32x4 y0 = acc[ai][0][m][0] * rinv * mv[0] + sv[0], y1 = acc[ai][0][m][1] * rinv * mv[1] + sv[1];
                *(u32x4*)(xp + (size_t)(ai * 128 + m * 16) * 1024) = pack8(y0, y1);
            }
    }
};
struct EpiState {
    bf16_t* S;
    __device__ __forceinline__ void operator()(const Acc& acc, const Unit& u, int wr, int wc, int fr, int fq) const {
        bf16_t* base = S + (size_t)u.pn * SROWS * 256;
#pragma unroll
        for (int ai = 0; ai < 2; ++ai)
#pragma unroll
            for (int m = 0; m < 4; ++m) {
                const int lrow = u.pm * 256 + ai * 128 + wr * 64 + m * 16 + fr;
                bf16_t* op = base + (size_t)lrow * 256;
#pragma unroll
                for (int bj = 0; bj < 2; ++bj) *(u32x4*)(op + bj * 128 + wc * 32 + fq * 8) = pack8(acc[ai][bj][m][0], acc[ai][bj][m][1]);
            }
    }
};
struct EpiSout {
    bf16_t* GY;
    __device__ __forceinline__ void operator()(const Acc& acc, const Unit& u, int wr, int wc, int fr, int fq) const {
#pragma unroll
        for (int ai = 0; ai < 2; ++ai)
#pragma unroll
            for (int m = 0; m < 4; ++m) {
                const int lrow = u.pm * 256 + ai * 128 + wr * 64 + m * 16 + fr;
                const int b = lrow >> 8, ch = lrow & 255;
#pragma unroll
                for (int bj = 0; bj < 2; ++bj) {
                    const int n = bj * 128 + wc * 32 + fq * 8; const int t = n >> 4, h0 = n & 15;
                    f32x4 o0, o1;
#pragma unroll
                    for (int j = 0; j < 4; ++j) { o0[j] = gelu_tanh(acc[ai][bj][m][0][j]); o1[j] = gelu_tanh(acc[ai][bj][m][1][j]); }
                    *(u32x4*)(GY + (size_t)(b * 4096 + ch * 16 + t) * 1024 + u.pn * 16 + h0) = pack8(o0, o1);
                }
            }
    }
};

__device__ __forceinline__ void p0_transpose(const float* src, int ld, int K, int c0, bf16_t* dst, float scale, LAS float* tile) {
    const int tid = otid();
    const int lkk = tid >> 7, lcc = tid & 127;
    float r[16];
#pragma unroll
    for (int i = 0; i < 16; ++i) r[i] = __builtin_nontemporal_load(src + (size_t)(lkk + 4 * i) * ld + c0 + lcc);
    for (int k0 = 0; k0 < K; k0 += 64) {
        __syncthreads();
#pragma unroll
        for (int i = 0; i < 16; ++i) tile[(lkk + 4 * i) * 129 + lcc] = r[i];
        if (k0 + 64 < K) {
#pragma unroll
            for (int i = 0; i < 16; ++i) r[i] = __builtin_nontemporal_load(src + (size_t)(k0 + 64 + lkk + 4 * i) * ld + c0 + lcc);
        }
        __syncthreads();
        { const int cc = tid >> 2, kk0 = (tid & 3) * 16; float v[16];
#pragma unroll
          for (int j = 0; j < 16; ++j) v[j] = tile[(kk0 + j) * 129 + cc] * scale;
          u32x4 w0, w1; w0.x = cvt_pk_bf16(v[0], v[1]); w0.y = cvt_pk_bf16(v[2], v[3]); w0.z = cvt_pk_bf16(v[4], v[5]); w0.w = cvt_pk_bf16(v[6], v[7]);
          w1.x = cvt_pk_bf16(v[8], v[9]); w1.y = cvt_pk_bf16(v[10], v[11]); w1.z = cvt_pk_bf16(v[12], v[13]); w1.w = cvt_pk_bf16(v[14], v[15]);
          bf16_t* dp = dst + (size_t)cc * K + k0 + kk0; *(u32x4*)dp = w0; *(u32x4*)(dp + 8) = w1; }
    }
    __syncthreads();
}

__device__ __forceinline__ void p0_s5_item(const Params& p, int g, LAS float* L) {
    const int tid = otid();
    LAS float* pw_re = L;
    LAS float* pw_im = L + 2176;
    LAS float* bb_re = L + 4352;
    LAS float* bb_im = L + 6400;
    LAS float* cc_re = L + 8448;
    LAS float* cc_im = L + 10528;
    LAS float* Kt = L + 12608;
    __syncthreads();
    for (int idx = tid; idx < 2176; idx += NT) {
        const int dir = idx / 1088, rem = idx - dir * 1088, pp = rem / 17, tau = rem - pp * 17;
        const float dt = expf(p.log_dt[dir * 64 + g]);
        const float are = p.a_re[(dir * 64 + g) * 64 + pp], aim = p.a_im[(dir * 64 + g) * 64 + pp];
        const float mag = expf(are * dt * (float)tau); float s, c; sincosf(aim * dt * (float)tau, &s, &c);
        pw_re[idx] = mag * c; pw_im[idx] = mag * s;
    }
    __syncthreads();
    if (tid < 128) {
        const int dir = tid >> 6, pp = tid & 63;
        const float are = p.a_re[(dir * 64 + g) * 64 + pp], aim = p.a_im[(dir * 64 + g) * 64 + pp];
        const float abr = pw_re[(dir * 64 + pp) * 17 + 1], abi = pw_im[(dir * 64 + pp) * 17 + 1];
        const float nr = abr - 1.0f, ni = abi, den = are * are + aim * aim;
        const float fre = (nr * are + ni * aim) / den, fim = (ni * are - nr * aim) / den;
        for (int h = 0; h < 16; ++h) {
            const float br = p.b_re[((size_t)(dir * 64 + g) * 64 + pp) * 16 + h], bi = p.b_im[((size_t)(dir * 64 + g) * 64 + pp) * 16 + h];
            bb_re[(dir * 64 + pp) * 16 + h] = fre * br - fim * bi; bb_im[(dir * 64 + pp) * 16 + h] = fre * bi + fim * br;
        }
    }
    for (int idx = tid; idx < 2048; idx += NT) {
        const int dir = idx >> 10, h = (idx >> 6) & 15, pp = idx & 63;
        cc_re[(dir * 16 + h) * 65 + pp] = p.c_re[((size_t)(dir * 64 + g) * 16 + h) * 64 + pp]; cc_im[(dir * 16 + h) * 65 + pp] = p.c_im[((size_t)(dir * 64 + g) * 16 + h) * 64 + pp];
    }
    __syncthreads();
    {
        const int dir = tid >> 8, tau = (tid >> 4) & 15, h = tid & 15;
        float a[16];
#pragma unroll
        for (int j = 0; j < 16; ++j) a[j] = 0.f;
        for (int pp = 0; pp < 64; ++pp) {
            const float cr = cc_re[(dir * 16 + h) * 65 + pp], ci = cc_im[(dir * 16 + h) * 65 + pp];
            const float pr = pw_re[(dir * 64 + pp) * 17 + tau], pi = pw_im[(dir * 64 + pp) * 17 + tau];
            const float xr = cr * pr - ci * pi, xi = cr * pi + ci * pr;
#pragma unroll
            for (int j = 0; j < 16; ++j) a[j] += xr * bb_re[(dir * 64 + pp) * 16 + j] - xi * bb_im[(dir * 64 + pp) * 16 + j];
        }
#pragma unroll
        for (int j = 0; j < 16; ++j) Kt[tid * 16 + j] = a[j];
    }
    __syncthreads();
    bf16_t* Wst = (bf16_t*)(p.ws + O_WST) + (size_t)g * 256 * 256;
    for (int ch = tid; ch < 8192; ch += NT) {
        const int n = ch >> 5, k0 = (ch & 31) * 8; const int dir = n >> 7, ri = (n >> 6) & 1, pp = n & 63, s = k0 >> 4, h0 = k0 & 15; const int e = dir ? s : 15 - s;
        const float pr = pw_re[(dir * 64 + pp) * 17 + e], pi = pw_im[(dir * 64 + pp) * 17 + e];
        float v[8];
#pragma unroll
        for (int j = 0; j < 8; ++j) { const float br = bb_re[(dir * 64 + pp) * 16 + h0 + j], bi = bb_im[(dir * 64 + pp) * 16 + h0 + j]; v[j] = ri ? (pr * bi + pi * br) : (pr * br - pi * bi); }
        u32x4 w; w.x = cvt_pk_bf16(v[0], v[1]); w.y = cvt_pk_bf16(v[2], v[3]); w.z = cvt_pk_bf16(v[4], v[5]); w.w = cvt_pk_bf16(v[6], v[7]);
        *(u32x4*)(Wst + (size_t)n * 256 + k0) = w;
    }
    bf16_t* Tt = (bf16_t*)(p.ws + O_TT) + (size_t)g * 256 * 512;
    for (int ch = tid; ch < 16384; ch += NT) {
        const int n = ch >> 6, k0 = (ch & 63) * 8; const int t = n >> 4, h = n & 15; float v[8];
        if (k0 < 256) {
            const int s = k0 >> 4, h0 = k0 & 15;
#pragma unroll
            for (int j = 0; j < 8; ++j) {
                float x = 0.f;
                if (s <= t) x += Kt[((0 * 16 + (t - s)) * 16 + h) * 16 + h0 + j];
                if (s >= t) x += Kt[((1 * 16 + (s - t)) * 16 + h) * 16 + h0 + j];
                if (s == t && h == h0 + j) x += p.ssm_d[g * 16 + h];
                v[j] = x;
            }
        } else {
            const int kk = k0 - 256, dir = kk >> 7, ri = (kk >> 6) & 1, p0 = kk & 63; const int e = dir ? 16 - t : t + 1;
#pragma unroll
            for (int j = 0; j < 8; ++j) {
                const int pp = p0 + j;
                const float cr = cc_re[(dir * 16 + h) * 65 + pp], ci = cc_im[(dir * 16 + h) * 65 + pp], pr = pw_re[(dir * 64 + pp) * 17 + e], pi = pw_im[(dir * 64 + pp) * 17 + e];
                v[j] = ri ? -(cr * pi + ci * pr) : (cr * pr - ci * pi);
            }
        }
        u32x4 w; w.x = cvt_pk_bf16(v[0], v[1]); w.y = cvt_pk_bf16(v[2], v[3]); w.z = cvt_pk_bf16(v[4], v[5]); w.w = cvt_pk_bf16(v[6], v[7]);
        *(u32x4*)(Tt + (size_t)n * 512 + k0) = w;
    }
    __syncthreads();
}

__device__ __forceinline__ void p0_adaln_item(const Params& p, int it, LAS float* L) {
    const int tid = otid(); const int l = it / 96, n0 = (it % 96) * 64;
    LAS float* sc = L;
    LAS float* red = L + 5120;
    __syncthreads();
    for (int idx = tid; idx < 5120; idx += NT) { const int r = idx >> 10, k = idx & 1023; const float v = (r < 4) ? p.c[r * 1024 + k] : p.c_ctx[k]; sc[idx] = siluf_(v); }
    __syncthreads();
    const int n = tid & 63, kq = tid >> 6; float a[5] = {0.f, 0.f, 0.f, 0.f, 0.f};
    const float* wp = p.mod_w + (size_t)l * 1024 * 6144 + n0 + n;
    for (int k = kq; k < 1024; k += 128) {
        float w[16];
#pragma unroll
        for (int u = 0; u < 16; ++u) w[u] = __builtin_nontemporal_load(wp + (size_t)(k + 8 * u) * 6144);
#pragma unroll
        for (int u = 0; u < 16; ++u)
#pragma unroll
            for (int r = 0; r < 5; ++r) a[r] += sc[r * 1024 + k + 8 * u] * w[u];
    }
#pragma unroll
    for (int r = 0; r < 5; ++r) red[(kq * 5 + r) * 64 + n] = a[r];
    __syncthreads();
    if (tid < 320) { const int r = tid >> 6, nn = tid & 63; float s = p.mod_b[l * 6144 + n0 + nn];
#pragma unroll
        for (int q = 0; q < 8; ++q) s += red[(q * 5 + r) * 64 + nn];
        ((float*)(p.ws + O_MODS))[(size_t)(l * 5 + r) * 6144 + n0 + nn] = s; }
    __syncthreads();
}

__device__ __forceinline__ void p0_fold_item(const Params& p, int it, LAS float* L) {
    const int tid = otid(); const int grp = it >> 4, kt = it & 15;
    LAS float* w = L;
    LAS float* cT = L + 4160;
    LAS float* sT = L + 4224;
    __syncthreads();
#pragma unroll
    for (int i = 0; i < 8; ++i) { const int idx = tid + i * NT, kk = idx >> 6, j = idx & 63; w[kk * 65 + j] = p.w_in[(size_t)(kt * 64 + kk) * 1280 + grp * 64 + j]; }
    if (tid < 64) { cT[tid] = cospif((float)tid / 32.0f); sT[tid] = sinpif((float)tid / 32.0f); }
    __syncthreads();
    const int kk = tid & 63, q = tid >> 6; bf16_t* WinA = (bf16_t*)(p.ws + O_WINA);
    for (int i = 0; i < 8; ++i) {
        const int n = q + 8 * i; float ac = 0.f, as = 0.f; int ph = 0;
        for (int j = 0; j < 64; ++j) { const float wv = w[kk * 65 + j]; ac += wv * cT[ph]; as += wv * sT[ph]; ph = (ph + n) & 63; }
        WinA[(size_t)(grp * 64 + n) * 1024 + kt * 64 + kk] = f2bf(ac);
        WinA[(size_t)(512 + grp * 64 + n) * 1024 + kt * 64 + kk] = f2bf(as);
    }
    __syncthreads();
}

__device__ __forceinline__ void p0_dft_item(const Params& p, int it, LAS float* L) {
    const int tid = otid();
    __syncthreads();
    for (int i = tid; i < 256; i += NT) L[i] = cospif((float)i / 128.0f);
    __syncthreads();
    if (it == 0) {
        bf16_t* D = (bf16_t*)(p.ws + O_D256);
        for (int idx = tid; idx < 512 * 512; idx += NT) {
            const int row = idx >> 9, col = idx & 511; const int ro = row >> 8, k = row & 255, cs = col >> 8, t = col & 255; const int ph = (k * t) & 255;
            const float C = L[ph], S = L[(ph - 64) & 255];
            const float v = ro == 0 ? (cs == 0 ? C : -S) : (cs == 0 ? -S : -C);
            D[idx] = f2bf(v);
        }
    } else {
        bf16_t* Dc = (bf16_t*)(p.ws + O_DC);
        for (int idx = tid; idx < 256 * 512; idx += NT) {
            const int k = idx >> 9, j = idx & 511, t = j & 255, cs = j >> 8; const int ph = (k * t) & 255;
            Dc[idx] = f2bf((cs ? -L[(ph - 64) & 255] : L[ph]) * (1.0f / 128.0f));
        }
    }
    __syncthreads();
}

constexpr int P0_S5 = 64, P0_ADA = 192, P0_FOLD = 128, P0_TR = 134, P0_DFT = 2, P0_MISC = 1;
constexpr int P0_ITEMS = P0_S5 + P0_ADA + P0_FOLD + P0_TR + P0_DFT + P0_MISC;

__device__ __forceinline__ void p0_transpose_dispatch(const Params& p, int it, LAS float* L) {
    unsigned char* ws = p.ws;
    const float* src; int ld, K, c0; bf16_t* dst; float scale = 1.0f;
    if (it < 16) { const int l = it >> 3; it &= 7; src = p.ffn_d + (size_t)l * FF * 1024; ld = 1024; K = FF; c0 = 128 * it; dst = (bf16_t*)(ws + (l ? O_WD1 : O_WD0)) + (size_t)(128 * it) * FF; }
    else {
        it -= 16;
        if (it < 4) { src = p.w_in; ld = 1280; K = 1024; c0 = 512 + 128 * it; dst = (bf16_t*)(ws + O_WINB) + (size_t)(128 * it) * 1024; scale = 0.125f * 1.4426950408889634f; }
        else if (it < 5) { src = p.w_in; ld = 1280; K = 1024; c0 = 1024; dst = (bf16_t*)(ws + O_WINB) + (size_t)512 * 1024; }
        else if (it < 6) { src = p.w_in; ld = 1280; K = 1024; c0 = 1152; dst = (bf16_t*)(ws + O_WINB) + (size_t)640 * 1024; }
        else if (it < 14) { it -= 6; src = p.w_out; ld = 1024; K = 1024; c0 = 128 * it; dst = (bf16_t*)(ws + O_WOUT) + (size_t)(128 * it) * 1024; }
        else if (it < 14 + 88) {
            it -= 14; const int l = it / 44; it -= l * 44;
            bf16_t* wgu = (bf16_t*)(ws + (l ? O_WGU1 : O_WGU0));
            const int up = it / 22, tile = it % 22;
            src = (up ? p.ffn_u : p.ffn_g) + (size_t)l * 1024 * FF; ld = FF; K = 1024; c0 = 128 * tile; dst = wgu + (size_t)(tile * 256 + up * 128) * 1024;
        } else {
            it -= 102; c0 = 128 * it; const int half = c0 >> 10, j = c0 & 1023;
            src = p.glu_w; ld = 2048; K = 1024; dst = (bf16_t*)(ws + O_GLU) + (size_t)((j >> 7) * 256 + half * 128) * 1024;
        }
    }
    p0_transpose(src, ld, K, c0, dst, scale, L);
}

__device__ __forceinline__ void p0_misc(const Params& p) {
    const int tid = otid();
    float* rc = (float*)(p.ws + O_ROPE); float* rs = rc + 1024;
    for (int i = tid; i < 1024; i += NT) { const int pp = i >> 4, f = i & 15; const float inv = powf(10000.0f, -(float)f / 16.0f); const float ang = (float)pp * inv; float s, c; sincosf(ang, &s, &c); rc[i] = c; rs[i] = s; }
}

__device__ __forceinline__ void p0_dispatch(const Params& p, int it, LAS float* L) {
    int i = it;
    if (i < 64) { p0_s5_item(p, i, L); return; } i -= 64;
    if (i < 16) { p0_transpose_dispatch(p, i, L); return; } i -= 16;
    if (i < 128) { p0_fold_item(p, i, L); return; } i -= 128;
    if (i < 118) { p0_transpose_dispatch(p, 16 + i, L); return; } i -= 118;
    if (i < 192) { p0_adaln_item(p, i, L); return; } i -= 192;
    if (i < 2) { p0_dft_item(p, i, L); return; } i -= 2;
    p0_misc(p);
}
__device__ __forceinline__ void phase_p0(const Params& p, LAS float* L, unsigned* qhead, volatile LAS unsigned* qslot) {
    for (;;) {
        __syncthreads();
        if (threadIdx.x == 0) qslot[0] = __hip_atomic_fetch_add(qhead, 1u, __ATOMIC_RELAXED, __HIP_MEMORY_SCOPE_AGENT);
        __syncthreads();
        const int it = (int)qslot[0];
        if (it >= P0_ITEMS) break;
        p0_dispatch(p, it, L);
    }
}

template <int MODE>
__device__ __forceinline__ void phase_norm(const float* src_lat, const float* src_ctx, int nrows, const float* ng, const float* mods_l, int sh_idx, int sc_idx, bf16_t* dstb, float* dstf,
                                           const bf16_t* part = nullptr, int npart = 0, const float* pgate = nullptr, float* hstore = nullptr, int row_first = 0, const bf16_t* src_latb = nullptr) {
    const int tid_ = otid(); const int lane = tid_ & 63, wv = obid() * 8 + (tid_ >> 6), nw = gridDim.x * 8;
    for (int row = row_first + wv; row < nrows; row += nw) {
        const float* sp; int mr;
        if (row < NLAT) { sp = src_lat + (size_t)row * 1024; mr = row >> 12; } else { sp = src_ctx + (size_t)(row - NLAT) * 1024; mr = 4; }
        f32x4 v[4]; float ss = 0.f;
        if (src_latb && row < NLAT) {
#pragma unroll
            for (int i = 0; i < 4; ++i) { const u32x2 w = *(const u32x2*)(src_latb + (size_t)row * 1024 + i * 256 + lane * 4);
                v[i] = (f32x4){__uint_as_float(w.x << 16), __uint_as_float(w.x & 0xFFFF0000u), __uint_as_float(w.y << 16), __uint_as_float(w.y & 0xFFFF0000u)}; }
        } else {
#pragma unroll
        for (int i = 0; i < 4; ++i) v[i] = *(const f32x4*)(sp + i * 256 + lane * 4);
        }
        if (npart > 0 && row >= NLAT) {
#pragma unroll
            for (int i = 0; i < 4; ++i) {
                const int col = i * 256 + lane * 4; f32x4 s = {0.f, 0.f, 0.f, 0.f};
#pragma unroll 2
                for (int k = 0; k < npart; ++k) { const u32x2 w = *(const u32x2*)(part + ((size_t)k * 1024 + (row - NLAT)) * 1024 + col);
                    s[0] += __uint_as_float(w.x << 16); s[1] += __uint_as_float(w.x & 0xFFFF0000u); s[2] += __uint_as_float(w.y << 16); s[3] += __uint_as_float(w.y & 0xFFFF0000u); }
                v[i] += *(const f32x4*)(pgate + col) * s;
                if (hstore) *(f32x4*)(hstore + (size_t)(row - NLAT) * 1024 + col) = v[i];
            }
        }
#pragma unroll
        for (int i = 0; i < 4; ++i) ss += v[i][0] * v[i][0] + v[i][1] * v[i][1] + v[i][2] * v[i][2] + v[i][3] * v[i][3];
#pragma unroll
        for (int o = 32; o >= 1; o >>= 1) ss += __shfl_xor(ss, o);
        const float rinv = rsqrtf(ss * (1.0f / 1024.0f) + 1e-6f);
#pragma unroll
        for (int i = 0; i < 4; ++i) {
            const int col = i * 256 + lane * 4; const f32x4 gv = *(const f32x4*)(ng + col); f32x4 y;
            if (MODE == 2) {
#pragma unroll
                for (int j = 0; j < 4; ++j) y[j] = v[i][j] * rinv * gv[j];
                *(f32x4*)(dstf + (size_t)row * 1024 + col) = y;
            } else {
                const f32x4 sh = *(const f32x4*)(mods_l + (size_t)mr * 6144 + sh_idx * 1024 + col), sc = *(const f32x4*)(mods_l + (size_t)mr * 6144 + sc_idx * 1024 + col);
#pragma unroll
                for (int j = 0; j < 4; ++j) y[j] = v[i][j] * rinv * gv[j] * (1.0f + sc[j]) + sh[j];
                u32x2 w; w.x = cvt_pk_bf16(y[0], y[1]); w.y = cvt_pk_bf16(y[2], y[3]);
                if (MODE == 0) *(u32x2*)(dstb + (size_t)row * 1024 + col) = w;
                else {
                    int lrow, s;
                    if (row < NLAT) { const int b = row >> 12, t = row & 4095; lrow = b * 256 + (t >> 4); s = t & 15; } else { const int r2 = row - NLAT, b = r2 >> 8, t = r2 & 255; lrow = 1024 + b * 16 + (t >> 4); s = t & 15; }
                    const int g = col >> 4, h2 = col & 15;
                    *(u32x2*)(dstb + ((size_t)g * GROWS + lrow) * 512 + s * 16 + h2) = w;
                }
            }
        }
    }
}

struct AttnFr { bf16x8 k[4]; bf16x8 v[4]; };
__device__ __forceinline__ void attn_load(AttnFr& f, const bf16_t* kp, const bf16_t* vp) {
#pragma unroll
    for (int kk = 0; kk < 4; ++kk) f.k[kk] = *(const bf16x8*)(kp + 16 * kk);
#pragma unroll
    for (int q = 0; q < 4; ++q) f.v[q] = *(const bf16x8*)(vp + q * 512);
}

__device__ __forceinline__ void attn_item(const Params& p, int item) {
    const int lane = otid() & 63, r = lane & 31, h = lane >> 5;
    const bf16_t* Q = (const bf16_t*)(p.ws + O_Q); const bf16_t* Kb = (const bf16_t*)(p.ws + O_K);
    const bf16_t* VT = (const bf16_t*)(p.ws + O_VT); const bf16_t* VTc = (const bf16_t*)(p.ws + O_VTC);
    bf16_t* MIX = (bf16_t*)(p.ws + O_MIX);
    int b, qt, hq, tok0, q0, ntile; bool isctx;
    if (item < 4096) { isctx = false; b = item >> 10; qt = (item >> 3) & 127; hq = item & 7; q0 = qt * 32; tok0 = b * 4096 + q0; ntile = 17; }
    else { const int it = item - 4096; isctx = true; b = it >> 6; qt = (it >> 3) & 7; hq = it & 7; q0 = qt * 32; tok0 = NLAT + b * 256 + q0; ntile = 8; }
    const int kvh = hq >> 2;
    bf16x8 qf[4];
    { const bf16_t* qp = Q + (size_t)(tok0 + r) * 512 + hq * 64 + h * 8;
#pragma unroll
      for (int kk = 0; kk < 4; ++kk) qf[kk] = *(const bf16x8*)(qp + 16 * kk); }
    float mrun = p.sink[hq] * 1.4426950408889634f, lrun = 1.0f;
    f32x16 o0, o1;
#pragma unroll
    for (int i = 0; i < 16; ++i) { o0[i] = 0.f; o1[i] = 0.f; }
    const int qpos = q0 + r;
    auto tile_ptrs = [&](int ti, const bf16_t*& kp, const bf16_t*& vp) {
        if (ti < 8) { kp = Kb + (size_t)(NLAT + b * 256 + 32 * ti + r) * 128 + kvh * 64 + h * 8; vp = VTc + (size_t)((b * 2 + kvh) * 8 + ti) * 2048 + lane * 8; }
        else { const int kbase = q0 - 128 + 32 * (ti - 8); const int kc = kbase < 0 ? 0 : (kbase > 4064 ? 4064 : kbase);
               kp = Kb + (size_t)(b * 4096 + kc + r) * 128 + kvh * 64 + h * 8; vp = VT + (size_t)((b * 2 + kvh) * 128 + (kc >> 5)) * 2048 + lane * 8; }
    };
    AttnFr cur, nxt;
    { const bf16_t *kp, *vp; tile_ptrs(0, kp, vp); attn_load(cur, kp, vp); }
    for (int ti = 0; ti < ntile; ++ti) {
        if (ti + 1 < ntile) { const bf16_t *kp, *vp; tile_ptrs(ti + 1, kp, vp); attn_load(nxt, kp, vp); }
        f32x16 s;
#pragma unroll
        for (int i = 0; i < 16; ++i) s[i] = 0.f;
#pragma unroll
        for (int kk = 0; kk < 4; ++kk) s = __builtin_amdgcn_mfma_f32_32x32x16_bf16(cur.k[kk], qf[kk], s, 0, 0, 0);
        if (ti >= 8) {
            const int kbase = q0 - 128 + 32 * (ti - 8);
            if (ti == 8 || ti == 16 || kbase < 0 || kbase > 4064) {
#pragma unroll
                for (int i = 0; i < 16; ++i) { const int kpos = kbase + (i & 3) + 8 * (i >> 2) + 4 * h; const int d = kpos - qpos; const bool ok = (kpos >= 0) && (kpos < 4096) && (d <= 128) && (d >= -128); s[i] = ok ? s[i] : -1e30f; }
            }
        }
        float mx = s[0];
#pragma unroll
        for (int i = 1; i < 16; ++i) mx = fmaxf(mx, s[i]);
        mx = fmaxf(mx, __shfl_xor(mx, 32));
        const float mnew = fmaxf(mrun, mx), alpha = __builtin_amdgcn_exp2f(mrun - mnew);
        float ps = 0.f; float pv[16];
#pragma unroll
        for (int i = 0; i < 16; ++i) { pv[i] = __builtin_amdgcn_exp2f(s[i] - mnew); ps += pv[i]; }
        ps += __shfl_xor(ps, 32);
        lrun = lrun * alpha + ps;
        if (__builtin_amdgcn_ballot_w64(mnew != mrun) != 0ull) {
#pragma unroll
            for (int i = 0; i < 16; ++i) { o0[i] *= alpha; o1[i] *= alpha; }
        }
        mrun = mnew;
        bf16x8 pf[2];
#pragma unroll
        for (int sidx = 0; sidx < 2; ++sidx) { u32x4 w; w.x = cvt_pk_bf16(pv[8 * sidx + 0], pv[8 * sidx + 1]); w.y = cvt_pk_bf16(pv[8 * sidx + 2], pv[8 * sidx + 3]); w.z = cvt_pk_bf16(pv[8 * sidx + 4], pv[8 * sidx + 5]); w.w = cvt_pk_bf16(pv[8 * sidx + 6], pv[8 * sidx + 7]); pf[sidx] = __builtin_bit_cast(bf16x8, w); }
#pragma unroll
        for (int sidx = 0; sidx < 2; ++sidx) {
            o0 = __builtin_amdgcn_mfma_f32_32x32x16_bf16(cur.v[sidx], pf[sidx], o0, 0, 0, 0);
            o1 = __builtin_amdgcn_mfma_f32_32x32x16_bf16(cur.v[2 + sidx], pf[sidx], o1, 0, 0, 0);
        }
        cur = nxt;
    }
    const float inv = 1.0f / lrun;
    bf16_t* op = MIX + (size_t)(tok0 + r) * 1024 + 512 + hq * 64;
#pragma unroll
    for (int rg = 0; rg < 4; ++rg) {
        const int d0 = 8 * rg + 4 * h;
        u32x2 w0, w1;
        w0.x = cvt_pk_bf16(o0[4 * rg] * inv, o0[4 * rg + 1] * inv); w0.y = cvt_pk_bf16(o0[4 * rg + 2] * inv, o0[4 * rg + 3] * inv);
        w1.x = cvt_pk_bf16(o1[4 * rg] * inv, o1[4 * rg + 1] * inv); w1.y = cvt_pk_bf16(o1[4 * rg + 2] * inv, o1[4 * rg + 3] * inv);
        *(u32x2*)(op + d0) = w0; *(u32x2*)(op + 32 + d0) = w1;
    }
}


__device__ __forceinline__ void phase_dft_combine(const Params& p, LAS float* L) {
    const int tid = otid(); const int G = gridDim.x, bx = obid();
    const bf16_t* I2 = (const bf16_t*)(p.ws + O_I2); bf16_t* MIX = (bf16_t*)(p.ws + O_MIX);
    constexpr float C16[16] = {1.0f, 0.92387953251f, 0.70710678119f, 0.38268343237f, 0.0f, -0.38268343237f, -0.70710678119f, -0.92387953251f, -1.0f, -0.92387953251f, -0.70710678119f, -0.38268343237f, 0.0f, 0.38268343237f, 0.70710678119f, 0.92387953251f};
    constexpr float S16[16] = {0.0f, 0.38268343237f, 0.70710678119f, 0.92387953251f, 1.0f, 0.92387953251f, 0.70710678119f, 0.38268343237f, 0.0f, -0.38268343237f, -0.70710678119f, -0.92387953251f, -1.0f, -0.92387953251f, -0.70710678119f, -0.38268343237f};
    for (int pair = bx; pair < 1024; pair += G) {
        const int b = pair >> 8, kp = pair & 255;
        __syncthreads();
        if (tid < 16) { float s, c; sincospif((float)(kp * tid) / 2048.0f, &s, &c); L[tid] = c; L[16 + tid] = s; }
        __syncthreads();
        const int c = tid;
        const u32x4* pr = (const u32x4*)(I2 + (size_t)kp * 32768 + (size_t)(b * 512 + c) * 16);
        const u32x4* pi = (const u32x4*)(I2 + (size_t)(256 + kp) * 32768 + (size_t)(b * 512 + c) * 16);
        const u32x4 r0 = pr[0], r1 = pr[1], i0 = pi[0], i1 = pi[1];
        const unsigned rw[8] = {r0.x, r0.y, r0.z, r0.w, r1.x, r1.y, r1.z, r1.w}, iw[8] = {i0.x, i0.y, i0.z, i0.w, i1.x, i1.y, i1.z, i1.w};
        float xr[16], xi[16];
#pragma unroll
        for (int r = 0; r < 16; ++r) {
            const float ire = __uint_as_float((r & 1) ? (rw[r >> 1] & 0xFFFF0000u) : (rw[r >> 1] << 16));
            const float iim = __uint_as_float((r & 1) ? (iw[r >> 1] & 0xFFFF0000u) : (iw[r >> 1] << 16));
            const float ct = L[r], st = L[16 + r];
            xr[r] = ire * ct + iim * st; xi[r] = iim * ct - ire * st;
        }
#pragma unroll
        for (int j = 0; j < 16; ++j) {
            float y = 0.f;
#pragma unroll
            for (int r = 0; r < 16; ++r) y += xr[r] * C16[(j * r) & 15] + xi[r] * S16[(j * r) & 15];
            MIX[(size_t)(b * 4096 + kp + 256 * j) * 1024 + c] = f2bf(y * (1.0f / 512.0f));
        }
    }
}

__device__ __forceinline__ void phase_scan(const Params& p) {
    const int tid_ = otid(); const int lane = tid_ & 63, wave = tid_ >> 6;
    const bf16_t* S = (const bf16_t*)(p.ws + O_S); bf16_t* A2 = (bf16_t*)(p.ws + O_A2);
    const int nitems = 512;
    for (int item = obid() + gridDim.x * wave; item < nitems; item += gridDim.x * 8) {
        const int b = item >> 7, g = (item >> 1) & 63, dir = item & 1, pp = lane;
        const float dt = expf(p.log_dt[dir * 64 + g]);
        const float are = p.a_re[(dir * 64 + g) * 64 + pp], aim = p.a_im[(dir * 64 + g) * 64 + pp];
        const float mag = expf(are * dt * 16.0f); float sn, cs; sincosf(aim * dt * 16.0f, &sn, &cs);
        const float ar = mag * cs, ai = mag * sn;
        float hr = 0.f, hi = 0.f;
        const bf16_t* Sg = S + (size_t)g * SROWS * 256 + dir * 128 + pp;
        bf16_t* Ag = A2 + (size_t)g * GROWS * 512 + 256 + dir * 128 + pp;
        for (int i = 0; i < 16; ++i) {
            const int ch = dir ? 15 - i : i; const size_t lrow = 1024 + b * 16 + ch;
            const float sr = __uint_as_float((unsigned)Sg[lrow * 256] << 16), si = __uint_as_float((unsigned)Sg[lrow * 256 + 64] << 16);
            const float nr = ar * hr - ai * hi + sr, ni = ar * hi + ai * hr + si; hr = nr; hi = ni;
        }
        for (int i0 = 0; i0 < 256; i0 += 8) {
            float sr[8], si[8];
#pragma unroll
            for (int j = 0; j < 8; ++j) { const int ch = dir ? 255 - (i0 + j) : (i0 + j); const size_t lrow = b * 256 + ch; sr[j] = __uint_as_float((unsigned)Sg[lrow * 256] << 16); si[j] = __uint_as_float((unsigned)Sg[lrow * 256 + 64] << 16); }
#pragma unroll
            for (int j = 0; j < 8; ++j) {
                const int ch = dir ? 255 - (i0 + j) : (i0 + j); const size_t lrow = b * 256 + ch;
                Ag[lrow * 512] = f2bf(hr); Ag[lrow * 512 + 64] = f2bf(hi);
                const float nr = ar * hr - ai * hi + sr[j], ni = ar * hi + ai * hr + si[j]; hr = nr; hi = ni;
            }
        }
    }
}


#define XB_TMO      128
#define XB_XCNT(j)  (256  + 64 * (j))
#define XB_XSUB(j)  (1280 + 64 * (j))
#define XB_XGEN(j)  (2304 + 64 * (j))
#define XB_TOP      3328
#define XB_TOPGEN   3392
#define XCD_BAR_WORDS 3456
#define XB_SPIN_CAP (1u << 22)
__device__ __forceinline__ unsigned xb_ld(unsigned* p)              { return __hip_atomic_load(p, __ATOMIC_RELAXED, __HIP_MEMORY_SCOPE_AGENT); }
__device__ __forceinline__ unsigned xb_add(unsigned* p, unsigned v) { return __hip_atomic_fetch_add(p, v, __ATOMIC_RELAXED, __HIP_MEMORY_SCOPE_AGENT); }
__device__ __forceinline__ unsigned xb_xcc_id() { return (unsigned)__builtin_amdgcn_s_getreg((3 << 11) | 20) & 0xFu; }
#define XB_SPIN(cond, bar) do { unsigned _sp = 0; while (cond) { __builtin_amdgcn_s_sleep(1); \
    if ((++_sp & 255u) == 0u) { if (xb_ld(&(bar)[XB_TMO])) break; if (_sp > XB_SPIN_CAP) { atomicAdd(&(bar)[XB_TMO], 1u); break; } } } } while (0)
__device__ __forceinline__ unsigned xcd_barrier_complete(unsigned* bar, unsigned x) {
    const unsigned G = gridDim.x;
    unsigned sum, cnt, mine, sp = 0u;
    for (;;) {
        sum = 0u; cnt = 0u; mine = 0u;
        for (unsigned j = 0; j < 16; ++j) { const unsigned c = xb_ld(&bar[XB_XCNT(j)]); sum += c; cnt += (c > 0u) ? 1u : 0u; mine = (j == x) ? c : mine; }
        if (sum == G) break;
        __builtin_amdgcn_s_sleep(1);
        if ((++sp & 255u) == 0u) { if (xb_ld(&bar[XB_TMO])) break; if (sp > XB_SPIN_CAP) { atomicAdd(&bar[XB_TMO], 1u); break; } }
    }
    const unsigned nloc = mine > 0u ? mine : 1u, nx = cnt > 0u ? cnt : 1u;
    return nloc | (nx << 16);
}
__device__ __forceinline__ void xcd_barrier(unsigned* bar, volatile LAS unsigned* st) {
    asm volatile("s_waitcnt vmcnt(0)" ::: "memory");
    __syncthreads();
    if (threadIdx.x == 0) {
        __builtin_amdgcn_s_waitcnt(0);
        const unsigned x = xb_xcc_id();
        unsigned nloc = st[0], nx = st[1];
        if (nloc == 0u) { const unsigned pk = xcd_barrier_complete(bar, x); nloc = pk & 0xFFFFu; nx = pk >> 16; st[0] = nloc; st[1] = nx; }
        const unsigned old = xb_add(&bar[XB_XSUB(x)], 1u);
        const unsigned gen = old / nloc;
        if (old + 1u == (gen + 1u) * nloc) {
            __builtin_amdgcn_fence(__ATOMIC_RELEASE, "agent");
            asm volatile("s_waitcnt vmcnt(0)" ::: "memory");
            const unsigned og = xb_add(&bar[XB_TOP], 1u);
            const unsigned tg = og / nx;
            if (og + 1u == (tg + 1u) * nx) xb_add(&bar[XB_TOPGEN], 1u);
            else XB_SPIN(xb_ld(&bar[XB_TOPGEN]) == tg, bar);
            __builtin_amdgcn_fence(__ATOMIC_ACQUIRE, "agent");
            xb_add(&bar[XB_XGEN(x)], 1u);
            asm volatile("s_waitcnt vmcnt(0)" ::: "memory");
        } else {
            XB_SPIN(xb_ld(&bar[XB_XGEN(x)]) == gen, bar);
            __builtin_amdgcn_fence(__ATOMIC_ACQUIRE, "agent");
            asm volatile("s_waitcnt vmcnt(0)" ::: "memory");
        }
    }
    __syncthreads();
}

__global__ void __launch_bounds__(NT) fwd_megakernel(Params p) {
    extern __shared__ __attribute__((aligned(16))) unsigned char shm[];
    cg::grid_group grid = cg::this_grid();
    LAS unsigned char* lds = (LAS unsigned char*)shm;
    LAS float* L = (LAS float*)shm;
    unsigned char* ws = p.ws;
    const int G = gridDim.x;
    float* mods = (float*)(ws + O_MODS);
    float* hctx = (float*)(ws + O_HCTX);
    bf16_t* XN = (bf16_t*)(ws + O_XN);
    bf16_t* ACT = (bf16_t*)(ws + O_ACT);
    const float* mods1 = mods + 5 * 6144;
    unsigned* bar = (unsigned*)(ws + O_BAR);
    volatile LAS unsigned* bst = (volatile LAS unsigned*)(lds + pg8::STAGE_BYTES);
    if (threadIdx.x < 4) bst[threadIdx.x] = 0u;
    __syncthreads();
    if (threadIdx.x == 0) (void)xb_add(&bar[XB_XCNT(xb_xcc_id())], 1u);
#define GRID_BAR() xcd_barrier(bar, bst)

    {
    phase_p0(p, L, bar + 0, bst + 2);
    }
    grid.sync();
    {
    phase_norm<0>(p.x, p.ctx, NTOK, p.norm_g + 0, mods, 0, 1, XN, nullptr);
    }
    GRID_BAR();
    {
    const int bx = obid();
    {
        const bf16_t* WinA = (const bf16_t*)(ws + O_WINA);
        bf16_t *ZT = (bf16_t*)(ws + O_ZT), *ZTc = (bf16_t*)(ws + O_ZTC), *VT = (bf16_t*)(ws + O_VT), *VTc = (bf16_t*)(ws + O_VTC);
        { pg8::Gemm g1{WinA, XN, 1024, 1024, 16384}; pg8::Sched s1; s1.init(4, 64, G, bx, 3, 1024, 16384);
          EpiInA e1{ZT, ZTc, 0, 1}; pg8::gemm_phase(lds, g1, s1, e1); }
        { pg8::Gemm gb{XN, (const bf16_t*)(ws + O_WINB), 1024, 1024, 1024}; pg8::Sched sb; sb.init(68, 3, G, bx, 0, 1024, 1024);
          EpiInB eb{(bf16_t*)(ws + O_Q), (bf16_t*)(ws + O_K), (const float*)(ws + O_ROPE), (const float*)(ws + O_ROPE) + 1024, VT, VTc}; pg8::gemm_phase(lds, gb, sb, eb); }
        { pg8::Gemm g3{WinA, XN + (size_t)NLAT * 1024, 1024, 1024, 1024}; pg8::Sched s3; s3.init(4, 4, G, (bx + G - (204 % G)) % G, 0, 1024, 1024);
          EpiInA e3{ZT, ZTc, NLAT, 0}; pg8::gemm_phase(lds, g3, s3, e3); }
    }
    }
    GRID_BAR();
    {
    const int bx = obid();
    {
        { pg8::Gemm gd{(const bf16_t*)(ws + O_D256), (const bf16_t*)(ws + O_ZT), 512, 512, 512}; pg8::Sched sd; sd.init(2, 128, G, bx, 0, 512, 512);
          EpiI2 ed{(bf16_t*)(ws + O_I2)}; pg8::gemm_phase(lds, gd, sd, ed); }
        const int wv = bx * 8 + (otid() >> 6), nw = G * 8;
        for (int item = wv; item < 4352; item += nw) attn_item(p, item);
        __syncthreads();
        { pg8::Gemm gc{(const bf16_t*)(ws + O_DC), (const bf16_t*)(ws + O_ZTC), 512, 512, 512}; pg8::Sched sc; sc.init(1, 8, G, (bx + 8) % G, 0, 512, 512);
          EpiDft ec{(bf16_t*)(ws + O_MIX), 1}; pg8::gemm_phase(lds, gc, sc, ec); }
    }
    }
    GRID_BAR();
    phase_dft_combine(p, L);
    GRID_BAR();
    {
    const int bx = obid();
    {
        const bf16_t* MIX = (const bf16_t*)(ws + O_MIX);
        pg8::Gemm g{MIX, (const bf16_t*)(ws + O_WOUT), 1024, 1024, 1024}; pg8::Sched s; s.init(64, 4, G, bx, 0, 1024, 1024);
        if (G == 256) {
            EpiResNorm e{p.x, (bf16_t*)(ws + O_H1B), mods + 2 * 1024, p.norm_g + 1024, mods, XN, (float*)(ws + O_XSS), (unsigned*)(ws + O_PCNT) + 32, bar + XB_TMO};
            pg8::gemm_phase<EpiResNorm, true>(lds, g, s, e);
            __syncthreads();
        } else {
            EpiRes e{p.x, p.ctx, p.out, hctx, mods + 2 * 1024};
            pg8::gemm_phase(lds, g, s, e);
        }
        pg8::Gemm gc{MIX + (size_t)NLAT * 1024, (const bf16_t*)(ws + O_WOUT), 256, 1024, 1024}; pg8::Sched sc; sc.init(16, 4, G, bx, 2, 1024, 1024);
        EpiPart ec{(bf16_t*)(ws + O_XNP)};
        pg8::gemm_phase<EpiPart, false>(lds, gc, sc, ec);
    }
    }
    GRID_BAR();
    {
    phase_norm<0>(p.out, p.ctx, NTOK, p.norm_g + 1024, mods, 3, 4, XN, nullptr, (const bf16_t*)(ws + O_XNP), 4, mods + 4 * 6144 + 2 * 1024, hctx, G == 256 ? NLAT : 0);
    }
    GRID_BAR();
    {
    const int bx = obid();
    {
        pg8::Gemm g{XN, (const bf16_t*)(ws + O_WGU0), 1024, 1024, 1024}; pg8::Sched s; s.init(68, 22, G, bx, 0, 1024, 1024);
        EpiSwiglu e{ACT};
        pg8::gemm_phase(lds, g, s, e);
    }
    }
    GRID_BAR();
    {
    const int bx = obid();
    {
        pg8::Gemm g{ACT, (const bf16_t*)(ws + O_WD0), FF, FF, FF}; pg8::Sched s; s.init(64, 4, G, bx, 0, FF, FF);
        if (G == 256) { EpiResB e{(const bf16_t*)(ws + O_H1B), nullptr, mods + 5 * 1024}; pg8::gemm_phase(lds, g, s, e); }
        else { EpiRes e{p.out, hctx, p.out, hctx, mods + 5 * 1024}; pg8::gemm_phase(lds, g, s, e); }
        pg8::Gemm gc{ACT + (size_t)NLAT * FF, (const bf16_t*)(ws + O_WD0), 256, FF, FF}; pg8::Sched sc; sc.init(16, 11, G, bx, 2, FF, FF);
        EpiPart ec{(bf16_t*)(ws + O_PART)};
        pg8::gemm_phase<EpiPart, false>(lds, gc, sc, ec);
    }
    }
    GRID_BAR();
    {
    phase_norm<1>(p.out, hctx, NTOK, p.norm_g + 2048, mods1, 0, 1, (bf16_t*)(ws + O_A2), nullptr, (const bf16_t*)(ws + O_PART), 11, mods + 4 * 6144 + 5 * 1024, nullptr, 0, G == 256 ? (const bf16_t*)(ws + O_H1B) : nullptr);
    }
    GRID_BAR();
    {
    const int bx = obid();
    {
        pg8::Gemm g{(const bf16_t*)(ws + O_A2), (const bf16_t*)(ws + O_WST), 256, 512, 256}; pg8::Sched s; s.init(5, 64, G, bx, 1, 512, 256);
        EpiState e{(bf16_t*)(ws + O_S)};
        pg8::gemm_phase<EpiState, false>(lds, g, s, e);
    }
    }
    GRID_BAR();
    {
    phase_scan(p);
    }
    GRID_BAR();
    {
    const int bx = obid();
    {
        pg8::Gemm g{(const bf16_t*)(ws + O_A2), (const bf16_t*)(ws + O_TT), 512, 512, 512}; pg8::Sched s; s.init(4, 64, G, bx, 1, 512, 512);
        EpiSout e{(bf16_t*)(ws + O_GY)};
        pg8::gemm_phase(lds, g, s, e);
    }
    }
    GRID_BAR();
    {
    const int bx = obid();
    {
        pg8::Gemm g{(const bf16_t*)(ws + O_GY), (const bf16_t*)(ws + O_GLU), 1024, 1024, 1024};
        if (G == 256) {
            EpiGluNorm e{p.out, mods1 + 2 * 1024, p.norm_g + 3072, mods1, XN, (float*)(ws + O_XSS8), (unsigned*)(ws + O_PCNT) + 16, bar + XB_TMO, (const bf16_t*)(ws + O_H1B)};
            pg8::Sched s; s.init(64, 8, G, bx, 4, 1024, 1024); s.nwg = 256;
            pg8::gemm_phase<EpiGluNorm, true>(lds, g, s, e);
            __syncthreads();
            pg8::Sched s2; s2.init(64, 8, G, bx, 4, 1024, 1024); s2.base = 256;
            pg8::gemm_phase<EpiGluNorm, true>(lds, g, s2, e);
        } else {
            pg8::Sched s; s.init(64, 8, G, bx, 0, 1024, 1024);
            EpiGlu e{p.out, mods1 + 2 * 1024};
            pg8::gemm_phase(lds, g, s, e);
        }
    }
    }
    GRID_BAR();
    if (G != 256) {
    phase_norm<0>(p.out, hctx, NLAT, p.norm_g + 3072, mods1, 3, 4, XN, nullptr);
    GRID_BAR();
    }
    {
    const int bx = obid();
    {
        pg8::Gemm g{XN, (const bf16_t*)(ws + O_WGU1), 1024, 1024, 1024}; pg8::Sched s; s.init(64, 22, G, bx, 0, 1024, 1024);
        EpiSwiglu e{ACT};
        pg8::gemm_phase(lds, g, s, e);
    }
    }
    GRID_BAR();
    {
    const int bx = obid();
    {
        pg8::Gemm g{ACT, (const bf16_t*)(ws + O_WD1), FF, FF, FF}; pg8::Sched s; s.init(64, 4, G, bx, 0, FF, FF);
        if (G == 256) {
            EpiResFinal e{(const bf16_t*)(ws + O_H1B), p.out, mods1 + 5 * 1024, p.final_g, (float*)(ws + O_XSS), (unsigned*)(ws + O_PCNT), bar + XB_TMO};
            pg8::gemm_phase<EpiResFinal, true>(lds, g, s, e);
        } else {
            EpiRes e{p.out, hctx, p.out, hctx, mods1 + 5 * 1024};
            pg8::gemm_phase(lds, g, s, e);
        }
    }
    }
    if (G != 256) {
    GRID_BAR();
    phase_norm<2>(p.out, hctx, NLAT, p.final_g, nullptr, 0, 0, nullptr, p.out);
    }
}

extern "C" void kernel_launch(void* const* d_in, const int* in_sizes, int n_in, void* d_out, int out_size, void* d_ws, size_t ws_size, hipStream_t stream) {
    constexpr int kLds = pg8::STAGE_BYTES + 16;
    static int grid_blocks = 0;
    if (grid_blocks == 0) {
        if (n_in != 23 || ws_size < WS_NEED) { fprintf(stderr, "kernel_launch: unexpected n_in %d or workspace %zu < %zu\n", n_in, ws_size, (size_t)WS_NEED); grid_blocks = -1; return; }
        int dev = 0, cus = 0, per_cu = 0;
        hipGetDevice(&dev);
        hipDeviceGetAttribute(&cus, hipDeviceAttributeMultiprocessorCount, dev);
        hipFuncSetAttribute((const void*)fwd_megakernel, hipFuncAttributeMaxDynamicSharedMemorySize, kLds);
        hipOccupancyMaxActiveBlocksPerMultiprocessor(&per_cu, (const void*)fwd_megakernel, NT, kLds);
        if (per_cu < 1) { fprintf(stderr, "kernel_launch: occupancy query says %d blocks/CU\n", per_cu); per_cu = 1; }
        grid_blocks = cus;
        (void)hipGetLastError();
    }
    if (grid_blocks < 0) return;
    if (hipMemsetAsync((char*)d_ws + O_BAR, 0, 16384 + 64 * 256, stream) != hipSuccess) { fprintf(stderr, "kernel_launch: memset of barrier words failed\n"); return; }
    Params p{};
    p.x = (const float*)d_in[0]; p.c = (const float*)d_in[1]; p.ctx = (const float*)d_in[2]; p.c_ctx = (const float*)d_in[3];
    p.mod_w = (const float*)d_in[4]; p.mod_b = (const float*)d_in[5]; p.norm_g = (const float*)d_in[6];
    p.ffn_g = (const float*)d_in[7]; p.ffn_u = (const float*)d_in[8]; p.ffn_d = (const float*)d_in[9];
    p.w_in = (const float*)d_in[10]; p.w_out = (const float*)d_in[11]; p.sink = (const float*)d_in[12];
    p.a_re = (const float*)d_in[13]; p.a_im = (const float*)d_in[14]; p.log_dt = (const float*)d_in[15];
    p.b_re = (const float*)d_in[16]; p.b_im = (const float*)d_in[17]; p.c_re = (const float*)d_in[18]; p.c_im = (const float*)d_in[19];
    p.ssm_d = (const float*)d_in[20]; p.glu_w = (const float*)d_in[21]; p.final_g = (const float*)d_in[22];
    p.out = (float*)d_out; p.ws = (unsigned char*)d_ws;
    void* args[] = {&p};
    hipError_t e = hipLaunchCooperativeKernel((const void*)fwd_megakernel, dim3(grid_blocks), dim3(NT), args, kLds, stream);
    if (e != hipSuccess) fprintf(stderr, "cooperative launch failed: %s (grid %d)\n", hipGetErrorString(e), grid_blocks);
}
```
